# Optimizing an MI355X kernel written in HIP

```python
import jax, jax.numpy as jnp
from jax import lax
import numpy as np

D_MODEL = 1024
BATCH = 2
SEQ = 8192
DEPTH = 4
DEC_BATCH = 128
DEC_SEQ = 8
PAST_LEN = 8192
PAGE_SIZE = 128

HEAD_DIM = 64
N_HEADS = D_MODEL // HEAD_DIM
N_KV_HEADS = 4
GQA_GROUP = N_HEADS // N_KV_HEADS
ATTN_W = N_HEADS * HEAD_DIM
KV_W = N_KV_HEADS * HEAD_DIM
WINDOW = 128
BLOCK = 128
CHUNK = 128
GMLP_CH = 128
GMLP_GROUPS = 6
GMLP_W = GMLP_GROUPS * GMLP_CH
D_FF = 2816
CONV_W = 3
EPS = 1e-5
NEG = -1e30
IN_SIZES = (ATTN_W, KV_W, KV_W, GMLP_W, GMLP_W, D_MODEL, D_MODEL)
IN_COLS = ATTN_W + 2 * KV_W + 2 * GMLP_W + 2 * D_MODEL

kernel_name = 'hybrid_swa_sink_gmlp_convffn_step'


def rmsnorm(x, g):
    xf = x.astype(jnp.float32)
    y = xf * lax.rsqrt(jnp.mean(xf * xf, axis=-1, keepdims=True) + EPS)
    return (y * g.astype(jnp.float32)).astype(x.dtype)


def layernorm(x, g, b):
    xf = x.astype(jnp.float32)
    mu = jnp.mean(xf, axis=-1, keepdims=True)
    var = jnp.mean(jnp.square(xf - mu), axis=-1, keepdims=True)
    y = (xf - mu) * lax.rsqrt(var + EPS)
    return (y * g.astype(jnp.float32) + b.astype(jnp.float32)).astype(x.dtype)


def split_in(z):
    idx = [int(i) for i in np.cumsum(IN_SIZES)[:-1]]
    return jnp.split(z, idx, axis=-1)


def sink_attention(q, k, v, mask, sinks):
    s = jnp.einsum('...qhgd,...khd->...hgqk', q.astype(jnp.float32), k.astype(jnp.float32))
    s = jnp.where(mask, s * (HEAD_DIM ** -0.5), NEG)
    sink = jnp.broadcast_to(sinks.astype(jnp.float32).reshape(N_KV_HEADS, GQA_GROUP, 1, 1),
                            s.shape[:-1] + (1,))
    m = jnp.maximum(jnp.max(s, axis=-1, keepdims=True), sink)
    p = jnp.exp(s - m)
    denom = jnp.sum(p, axis=-1, keepdims=True) + jnp.exp(sink - m)
    o = jnp.einsum('...hgqk,...khd->...qhgd', p / denom, v.astype(jnp.float32))
    return o.astype(v.dtype)


def attn_prompt(q, k, v, sinks):
    B, T = q.shape[:2]
    nb = T // BLOCK
    qb = q.reshape(B, nb, BLOCK, N_KV_HEADS, GQA_GROUP, HEAD_DIM)
    kb = k.reshape(B, nb, BLOCK, N_KV_HEADS, HEAD_DIM)
    vb = v.reshape(B, nb, BLOCK, N_KV_HEADS, HEAD_DIM)
    pad = ((0, 0), (1, 0), (0, 0), (0, 0), (0, 0))
    kk = jnp.concatenate([jnp.pad(kb, pad)[:, :-1], kb], axis=2)
    vv = jnp.concatenate([jnp.pad(vb, pad)[:, :-1], vb], axis=2)
    diff = jnp.arange(BLOCK)[:, None] + BLOCK - jnp.arange(2 * BLOCK)[None, :]
    band = (diff >= 0) & (diff < WINDOW)
    valid = (jnp.arange(nb)[:, None] > 0) | (jnp.arange(2 * BLOCK)[None, :] >= BLOCK)
    mask = band[None] & valid[:, None, :]
    o = sink_attention(qb, kk, vv, mask[:, None, None], sinks)
    return o.reshape(B, T, ATTN_W), k[:, T - WINDOW:], v[:, T - WINDOW:]


def attn_sample(q, k, v, buf_k, buf_v, sinks):
    B, T = q.shape[:2]
    L = buf_k.shape[1]
    kk = jnp.concatenate([buf_k, k], axis=1)
    vv = jnp.concatenate([buf_v, v], axis=1)
    diff = jnp.arange(T)[:, None] + L - jnp.arange(L + T)[None, :]
    mask = (diff >= 0) & (diff < WINDOW)
    o = sink_attention(q, kk, vv, mask, sinks)
    return o.reshape(B, T, ATTN_W), kk[:, T:], vv[:, T:]


def spatial_gating(u, vn, ws, bs):
    B, T = u.shape[:2]
    C = min(T, CHUNK)
    nc = T // C
    w = jnp.where(jnp.tril(jnp.ones((C, C), dtype=bool)), ws[:, :C, :C], 0.0)
    vb = vn.reshape(B, nc, C, GMLP_GROUPS, GMLP_CH)
    mix = jnp.einsum('gts,bnsgc->bntgc', w, vb) + bs[:, :C].T[:, :, None]
    return u * mix.reshape(B, T, GMLP_W)


def conv_ffn(h, w_up, conv_w, conv_b, w_down, prev):
    z = h @ w_up
    T = z.shape[1]
    zp = jnp.concatenate([prev, z], axis=1)
    c = conv_b + sum(zp[:, j:j + T] * conv_w[j] for j in range(CONV_W))
    a, b = jnp.split(c, 2, axis=-1)
    return (jax.nn.gelu(a) * b) @ w_down, zp[:, T:]


def layer(x, norm_mix, w_in, sinks, ln_g, ln_b, ws, bs, w_pa, w_pb, w_out,
          norm_ffn, w_up, conv_w, conv_b, w_down, win_k, win_v, conv_prev):
    B, T, _ = x.shape
    h = rmsnorm(x, norm_mix)
    q, k, v, gu, gv, ga, gb = split_in(h @ w_in)
    q = q.reshape(B, T, N_KV_HEADS, GQA_GROUP, HEAD_DIM)
    k = k.reshape(B, T, N_KV_HEADS, HEAD_DIM)
    v = v.reshape(B, T, N_KV_HEADS, HEAD_DIM)
    if win_k is None:
        o, nk, nv = attn_prompt(q, k, v, sinks)
    else:
        o, nk, nv = attn_sample(q, k, v, win_k, win_v, sinks)
    vn = layernorm(jax.nn.gelu(gv), ln_g, ln_b)
    s = spatial_gating(jax.nn.gelu(gu), vn, ws, bs)
    merged = jax.nn.sigmoid(ga) * (o @ w_pa) + jax.nn.sigmoid(gb) * (s @ w_pb)
    x = x + merged @ w_out
    f, nconv = conv_ffn(rmsnorm(x, norm_ffn), w_up, conv_w, conv_b, w_down, conv_prev)
    return x + f, nk, nv, nconv, vn


def setup_inputs(seed: int = 0) -> dict:
    key = jax.random.key(seed)
    ks = jax.random.split(key, 24)
    f32 = jnp.float32

    def nrm(k, shape, scale):
        return jax.random.normal(k, shape, f32) * scale

    win_buf = min(WINDOW, PAST_LEN)
    return {
        'x_prompt': nrm(ks[0], (BATCH, SEQ, D_MODEL), 1.0),
        'x_sample': nrm(ks[1], (DEC_BATCH, DEC_SEQ, D_MODEL), 1.0),
        'cache_win_k': nrm(ks[2], (DEPTH, DEC_BATCH, win_buf, N_KV_HEADS, HEAD_DIM), 1.0),
        'cache_win_v': nrm(ks[3], (DEPTH, DEC_BATCH, win_buf, N_KV_HEADS, HEAD_DIM), 1.0),
        'state_conv': nrm(ks[4], (DEPTH, DEC_BATCH, CONV_W - 1, 2 * D_FF), 1.0),
        'norm_mix': 1.0 + nrm(ks[5], (DEPTH, D_MODEL), 0.02),
        'w_in': nrm(ks[6], (DEPTH, D_MODEL, IN_COLS), D_MODEL ** -0.5),
        'sinks': nrm(ks[7], (DEPTH, N_HEADS), 1.0),
        'gmlp_ln_g': 1.0 + nrm(ks[8], (DEPTH, GMLP_W), 0.02),
        'gmlp_ln_b': nrm(ks[9], (DEPTH, GMLP_W), 0.02),
        'gmlp_ws': nrm(ks[10], (DEPTH, GMLP_GROUPS, CHUNK, CHUNK), CHUNK ** -0.5),
        'gmlp_bs': 1.0 + nrm(ks[11], (DEPTH, GMLP_GROUPS, CHUNK), 0.05),
        'w_branch_attn': nrm(ks[12], (DEPTH, ATTN_W, D_MODEL), ATTN_W ** -0.5),
        'w_branch_gmlp': nrm(ks[13], (DEPTH, GMLP_W, D_MODEL), GMLP_W ** -0.5),
        'w_out': nrm(ks[14], (DEPTH, D_MODEL, D_MODEL), D_MODEL ** -0.5),
        'norm_ffn': 1.0 + nrm(ks[15], (DEPTH, D_MODEL), 0.02),
        'w_up': nrm(ks[16], (DEPTH, D_MODEL, 2 * D_FF), D_MODEL ** -0.5),
        'conv_w': nrm(ks[17], (DEPTH, CONV_W, 2 * D_FF), CONV_W ** -0.5),
        'conv_b': nrm(ks[18], (DEPTH, 2 * D_FF), 0.02),
        'w_down': nrm(ks[19], (DEPTH, D_FF, D_MODEL), D_FF ** -0.5),
        'norm_final': 1.0 + nrm(ks[20], (D_MODEL,), 0.02),
    }


def reference(x_prompt, x_sample, cache_win_k, cache_win_v, state_conv,
              norm_mix, w_in, sinks, gmlp_ln_g, gmlp_ln_b, gmlp_ws, gmlp_bs,
              w_branch_attn, w_branch_gmlp, w_out, norm_ffn, w_up, conv_w, conv_b,
              w_down, norm_final):
    xp, xs = x_prompt, x_sample
    conv0 = jnp.zeros((x_prompt.shape[0], CONV_W - 1, 2 * D_FF), x_prompt.dtype)
    kp_l, vp_l, cp_l, ks_l, vs_l, cs_l, gv_l = [], [], [], [], [], [], []
    for l in range(DEPTH):
        params = (norm_mix[l], w_in[l], sinks[l], gmlp_ln_g[l], gmlp_ln_b[l], gmlp_ws[l],
                  gmlp_bs[l], w_branch_attn[l], w_branch_gmlp[l], w_out[l], norm_ffn[l],
                  w_up[l], conv_w[l], conv_b[l], w_down[l])
        xp, kp, vp, cp, _ = layer(xp, *params, None, None, conv0)
        xs, kss, vss, css, gvs = layer(xs, *params, cache_win_k[l], cache_win_v[l], state_conv[l])
        kp_l.append(kp); vp_l.append(vp); cp_l.append(cp)
        ks_l.append(kss); vs_l.append(vss); cs_l.append(css); gv_l.append(gvs)
    y_prompt = rmsnorm(xp, norm_final)
    y_sample = rmsnorm(xs, norm_final)
    return (y_prompt, y_sample, jnp.stack(kp_l), jnp.stack(vp_l), jnp.stack(cp_l),
            jnp.stack(ks_l), jnp.stack(vs_l), jnp.stack(cs_l), jnp.stack(gv_l))
```

```cpp
#include <hip/hip_runtime.h>
#include <cstdio>
#include <cstdint>

#ifndef MK_ONE_LAUNCH
#define MK_ONE_LAUNCH 0
#endif

#define LAS __attribute__((address_space(3)))
#define GAS __attribute__((address_space(1)))
typedef unsigned short bf16_t;
typedef short bf16x8 __attribute__((ext_vector_type(8)));
typedef short s16x4 __attribute__((ext_vector_type(4)));
typedef float f32x2 __attribute__((ext_vector_type(2)));
typedef float f32x4 __attribute__((ext_vector_type(4)));
typedef float f32x16 __attribute__((ext_vector_type(16)));
typedef unsigned u32x2 __attribute__((ext_vector_type(2)));
typedef unsigned u32x4 __attribute__((ext_vector_type(4)));
typedef __bf16 bf16x2_t __attribute__((ext_vector_type(2)));

constexpr int DM = 1024, NB = 2, SEQ = 8192, DEPTH = 4, SB = 128, ST = 8, WIN = 128;
constexpr int MP = NB * SEQ, MS = SB * ST, M = MP + MS;
constexpr int NIN = 5120, C_Q = 0, C_K = 1024, C_V = 1280, C_GU = 1536, C_GV = 2304, C_GA = 3072, C_GB = 4096;
constexpr int KM = 1792, NUP = 5632, DFF = 2816, GW = 768;
constexpr float EPS = 1e-5f, LOG2E = 1.4426950408889634f, C2 = 0.125f * 1.4426950408889634f, NEGBIG = -1e30f;
constexpr int NPH = 30;

constexpr size_t O_Y = 0, O_WKP = 17825792, O_WVP = 18087936, O_CVP = 18350080, O_WKS = 18440192, O_WVS = 35217408, O_CVS = 51994624, O_GVS = 57761792, O_END = 60907520;

constexpr size_t MiB = 1u << 20;
constexpr size_t WS_CTL = 0, CTL_ZERO_BYTES = 64 * 1024, WS_XSQ = 1 * MiB, WS_GVST = 2 * MiB, WS_WSB = 4 * MiB, WS_WIN = 8 * MiB, WS_WM = 48 * MiB, WS_WOUT = 62 * MiB,
                 WS_WUP = 70 * MiB, WS_WDN = 114 * MiB, WS_XB = 136 * MiB, WS_RA = 170 * MiB, WS_RB = 357 * MiB, WS_MG = WS_RB + 60 * MiB, WS_END = 451 * MiB;
static_assert((size_t)M * NUP * 2 <= WS_RB - WS_RA && (size_t)M * DFF * 2 <= WS_END - WS_RB && (size_t)M * KM * 2 <= 60 * MiB && WS_MG + (size_t)M * DM * 2 <= WS_END, "ws map");

constexpr int RING_OFF = 0, RING_BYTES = 131072, RED_OFF = RING_BYTES, RED_BYTES = 4096, LDSCTL_OFF = RED_OFF + RED_BYTES, MISC_OFF = LDSCTL_OFF + 320, LDS_BYTES = 147456;

__device__ __forceinline__ unsigned cvtpk(float lo, float hi) { f32x2 v = {lo, hi}; bf16x2_t b = __builtin_convertvector(v, bf16x2_t); return __builtin_bit_cast(unsigned, b); }
__device__ __forceinline__ float bflo(unsigned u) { return __uint_as_float(u << 16); }
__device__ __forceinline__ float bfhi(unsigned u) { return __uint_as_float(u & 0xffff0000u); }
__device__ __forceinline__ float gelu_t(float x) { const float t = x * (-2.302208198f + -0.1029432398f * x * x); return x * __builtin_amdgcn_rcpf(1.0f + __builtin_amdgcn_exp2f(t)); }
__device__ __forceinline__ float sigm(float x) { return __builtin_amdgcn_rcpf(1.0f + __builtin_amdgcn_exp2f(-LOG2E * x)); }
__device__ __forceinline__ int crow(int r, int hi) { return (r & 3) + 8 * (r >> 2) + 4 * hi; }

namespace pg8 {
#define PG8_LAS __attribute__((address_space(3)))
constexpr int BM = 256, BK = 64, HALF = 128, HTB = HALF * BK * 2  , STAGE_BYTES = 8 * HTB, NXCD = 8, WGM = 8;
__host__ __device__ __forceinline__ int lds_byte(int r, int c) { const int st = (r >> 4) * 2 + (c >> 5), rr = r & 15, cc = c & 31, ob = rr * 64 + cc * 2; return st * 1024 + (ob ^ (((ob >> 9) & 1) << 5)); }
__host__ __device__ __forceinline__ void stage_rc(int b, int& R, int& C) { const int st = b / 1024, sb = b % 1024, swz = sb ^ (((sb >> 9) & 1) << 5); R = (st >> 1) * 16 + swz / 64; C = (st & 1) * 32 + (swz % 64) / 2; }
__host__ __device__ __forceinline__ int perm32(int rho) { const int n = rho >> 4, i = rho & 15; return 8 * (i >> 2) + 4 * n + (i & 3); }

struct Unit { int pm, pn; };
struct Gemm { const bf16_t* A; const bf16_t* Bt; int M, N, K; };
struct StaticOrder {
    int nM, nN, nwg, G, c;
    __host__ __device__ void init(int M_, int N_, int G_, int c_) { nM = M_ / BM; nN = N_ / BM; nwg = nM * nN; G = G_; c = c_; }
    __host__ __device__ bool next(int i, Unit& u) const {
        const long L = (long)i * G + c; if (L >= nwg) return false;
        int wgid = (int)L; { const int q = nwg / NXCD, r = nwg % NXCD, xcd = wgid % NXCD, off = wgid / NXCD; wgid = (xcd < r ? xcd * (q + 1) : r * (q + 1) + (xcd - r) * q) + off; }
        const int nig = WGM * nN, gid = wgid / nig, fm = gid * WGM, gsz = (nM - fm) < WGM ? (nM - fm) : WGM;
        u.pm = fm + ((wgid % nig) % gsz); u.pn = (wgid % nig) / gsz; return true;
    }
};


struct EpiAct {
    static constexpr bool PERM = true; static constexpr int MID_T = -1;
    bf16_t* O; int ldc; const float* xsq; float* gvst; int mode;
    __device__ __forceinline__ void mid(f32x4 (&)[2][2][4][2], const Unit&, int, int, int, int) const {}
    template <int KIND> __device__ __forceinline__ void body(const f32x4 (&acc)[2][2][4][2], const Unit& u, int wr, int wc, int fr, int fq) const {
        asm volatile("" : "+v"(fr), "+v"(fq));
        const int row0 = u.pm * BM + wr * 64 + fr, col0 = u.pn * BM + wc * 32 + 8 * fq;
#pragma unroll
        for (int ai = 0; ai < 2; ++ai)
#pragma unroll
            for (int m = 0; m < 4; ++m) {
                const int row = row0 + ai * HALF + m * 16;
                const f32x4 ps = *(const f32x4*)(xsq + (size_t)row * 4);
                float rs = __builtin_amdgcn_rsqf(((ps[0] + ps[1]) + (ps[2] + ps[3])) * (1.0f / DM) + EPS);
                if (KIND == 0) rs *= C2;
                float s1 = 0.f, s2 = 0.f;
                bf16_t* rowp = O + (size_t)row * ldc + col0;
#pragma unroll
                for (int bj = 0; bj < 2; ++bj) {
                    float v[8];
#pragma unroll
                    for (int e = 0; e < 8; ++e) { float x = acc[ai][bj][m][e >> 2][e & 3] * rs;
                        if (KIND == 2 || KIND == 3) x = gelu_t(x);
                        if (KIND == 4) x = sigm(x);
                        v[e] = x; }
                    u32x4 w; w.x = cvtpk(v[0], v[1]); w.y = cvtpk(v[2], v[3]); w.z = cvtpk(v[4], v[5]); w.w = cvtpk(v[6], v[7]);
                    if (KIND == 3) {
#pragma unroll
                        for (int e = 0; e < 4; ++e) { const unsigned q = e == 0 ? w.x : e == 1 ? w.y : e == 2 ? w.z : w.w; const float a = bflo(q), b = bfhi(q); s1 += a + b; s2 += a * a + b * b; } }
                    *(u32x4*)(rowp + bj * HALF) = w;
                }
                if (KIND == 3) {
                    s1 += __shfl_xor(s1, 16); s1 += __shfl_xor(s1, 32); s2 += __shfl_xor(s2, 16); s2 += __shfl_xor(s2, 32);
                    if (fq == 0) *(f32x2*)(gvst + (size_t)row * 24 + ((u.pn - 9) * 4 + wc) * 2) = (f32x2){s1, s2};
                }
            }
    }
    __device__ __forceinline__ void run(f32x4 (&acc)[2][2][4][2], const Unit& u, int wr, int wc, int fr, int fq, PG8_LAS unsigned char*, int) const {
        if (mode == 0) { body<1>(acc, u, wr, wc, fr, fq); return; }
        const int pn = u.pn;
        if (pn < 4) body<0>(acc, u, wr, wc, fr, fq);
        else if (pn < 6) body<1>(acc, u, wr, wc, fr, fq);
        else if (pn < 9) body<2>(acc, u, wr, wc, fr, fq);
        else if (pn < 12) body<3>(acc, u, wr, wc, fr, fq);
        else body<4>(acc, u, wr, wc, fr, fq);
    }
};

struct EpiMerge {
    static constexpr bool PERM = true; static constexpr int MID_T = 16;
    const bf16_t* Z; bf16_t* O;
    __device__ __forceinline__ void mid(f32x4 (&acc)[2][2][4][2], const Unit& u, int wr, int wc, int fr, int fq) const {
        asm volatile("" : "+v"(fr), "+v"(fq));
        const int row0 = u.pm * BM + wr * 64 + fr, col0 = u.pn * BM + wc * 32 + 8 * fq;
#pragma unroll
        for (int ai = 0; ai < 2; ++ai)
#pragma unroll
            for (int m = 0; m < 4; ++m) {
                const bf16_t* zr = Z + (size_t)(row0 + ai * HALF + m * 16) * NIN + col0;
#pragma unroll
                for (int bj = 0; bj < 2; ++bj) {
                    const u32x4 a = *(const u32x4*)(zr + C_GA + bj * HALF), b = *(const u32x4*)(zr + C_GB + bj * HALF);
#pragma unroll
                    for (int e = 0; e < 4; ++e) { const unsigned qa = e == 0 ? a.x : e == 1 ? a.y : e == 2 ? a.z : a.w, qb = e == 0 ? b.x : e == 1 ? b.y : e == 2 ? b.z : b.w;
                        const float r0 = bflo(qa) * __builtin_amdgcn_rcpf(fmaxf(bflo(qb), 1e-30f)), r1 = bfhi(qa) * __builtin_amdgcn_rcpf(fmaxf(bfhi(qb), 1e-30f));
                        acc[ai][bj][m][e >> 1][(e & 1) * 2] *= r0; acc[ai][bj][m][e >> 1][(e & 1) * 2 + 1] *= r1; }
                }
                asm volatile("" : "+v"(acc[ai][0][m][0]), "+v"(acc[ai][0][m][1]), "+v"(acc[ai][1][m][0]), "+v"(acc[ai][1][m][1]));
                asm volatile("" ::: "memory");
            }
    }
    __device__ __forceinline__ void run(f32x4 (&acc)[2][2][4][2], const Unit& u, int wr, int wc, int fr, int fq, PG8_LAS unsigned char*, int) const {
        asm volatile("" : "+v"(fr), "+v"(fq));
        const int row0 = u.pm * BM + wr * 64 + fr, col0 = u.pn * BM + wc * 32 + 8 * fq;
#pragma unroll
        for (int ai = 0; ai < 2; ++ai)
#pragma unroll
            for (int m = 0; m < 4; ++m) {
                const int row = row0 + ai * HALF + m * 16;
                const bf16_t* zr = Z + (size_t)row * NIN + C_GB + col0;
#pragma unroll
                for (int bj = 0; bj < 2; ++bj) {
                    const u32x4 b = *(const u32x4*)(zr + bj * HALF);
                    float v[8];
#pragma unroll
                    for (int e = 0; e < 4; ++e) { const unsigned qb = e == 0 ? b.x : e == 1 ? b.y : e == 2 ? b.z : b.w;
                        v[2 * e] = acc[ai][bj][m][e >> 1][(e & 1) * 2] * fmaxf(bflo(qb), 1e-30f); v[2 * e + 1] = acc[ai][bj][m][e >> 1][(e & 1) * 2 + 1] * fmaxf(bfhi(qb), 1e-30f); }
                    u32x4 w; w.x = cvtpk(v[0], v[1]); w.y = cvtpk(v[2], v[3]); w.z = cvtpk(v[4], v[5]); w.w = cvtpk(v[6], v[7]);
                    *(u32x4*)(O + (size_t)row * DM + col0 + bj * HALF) = w;
                }
            }
    }
};

struct EpiResid {
    static constexpr bool PERM = false; static constexpr int MID_T = -1;
    float* X; bf16_t* XB; float* xsq;
    __device__ __forceinline__ void mid(f32x4 (&)[2][2][4][2], const Unit&, int, int, int, int) const {}
    __device__ __forceinline__ void run(f32x4 (&acc)[2][2][4][2], const Unit& u, int wr, int wc, int fr, int fq, PG8_LAS unsigned char* red, int tid) const {
        asm volatile("" : "+v"(fr), "+v"(fq), "+v"(tid));
        const int row0 = u.pm * BM + wr * 64 + fr, col0 = u.pn * BM + wc * 32 + 4 * fq;
        PG8_LAS float* R = (PG8_LAS float*)red;
#pragma unroll
        for (int ai = 0; ai < 2; ++ai)
#pragma unroll
            for (int m = 0; m < 4; ++m) {
                const size_t off = (size_t)(row0 + ai * HALF + m * 16) * DM + col0;
                float ss = 0.f;
#pragma unroll
                for (int bj = 0; bj < 2; ++bj)
#pragma unroll
                    for (int n = 0; n < 2; ++n) {
                        const f32x4 xo = *(const f32x4*)(X + off + bj * HALF + n * 16);
                        const f32x4 xn = xo + acc[ai][bj][m][n];
                        *(f32x4*)(X + off + bj * HALF + n * 16) = xn;
                        u32x2 w; w.x = cvtpk(xn[0], xn[1]); w.y = cvtpk(xn[2], xn[3]);
                        *(u32x2*)(XB + off + bj * HALF + n * 16) = w;
                        ss += (xn[0] * xn[0] + xn[1] * xn[1]) + (xn[2] * xn[2] + xn[3] * xn[3]);
                    }
                ss += __shfl_xor(ss, 16); ss += __shfl_xor(ss, 32);
                if (fq == 0) R[(ai * HALF + wr * 64 + m * 16 + fr) * 4 + wc] = ss;
            }
        asm volatile("s_waitcnt lgkmcnt(0)" ::: "memory"); __builtin_amdgcn_s_barrier(); asm volatile("" ::: "memory");
        if (tid < 256) { const f32x4 q = *(const PG8_LAS f32x4*)(R + tid * 4); xsq[(size_t)(u.pm * BM + tid) * 4 + u.pn] = (q[0] + q[1]) + (q[2] + q[3]); }
    }
};

template <class Epi, class Sched>
__device__ __forceinline__ void gemm_phase(PG8_LAS unsigned char* lds, PG8_LAS unsigned char* red, const Gemm g, const Sched& S, const Epi& E) {
    int tid_ = threadIdx.x; asm volatile("" : "+v"(tid_));
    const int tid = tid_, wid = __builtin_amdgcn_readfirstlane(tid >> 6), lane = tid & 63, wr = wid >> 2, wc = wid & 3, fr = lane & 15, fq = lane >> 4;
    const int K = g.K, nt = K / BK;
    unsigned voffA[2], voffB[2];
#pragma unroll
    for (int i = 0; i < 2; ++i) { int R, C; stage_rc(tid * 16 + i * 8192, R, C); const int Rb = Epi::PERM ? ((R & ~31) + perm32(R & 31)) : R;
        voffA[i] = (unsigned)(R * K + C) * 2u; voffB[i] = (unsigned)(Rb * K + C) * 2u; }
    const size_t kstep = (size_t)(BK * 2);
    const size_t hstep = (size_t)HALF * K * 2;
    const size_t tstep = 2 * hstep;
    const unsigned ldsw = (unsigned)wid * 1024u;
    const int aoff = lds_byte(wr * 64 + fr, fq * 8), boff = lds_byte(wc * 32 + fr, fq * 8);
#define PG8_SA(b, h) (((b) * 2 + (h)) * HTB)
#define PG8_SB(b, h) ((4 + (b) * 2 + (h)) * HTB)
#define PG8_STAGE(bufoff, gbase, voff) do { _Pragma("unroll") for (int _i = 0; _i < 2; ++_i) \
        __builtin_amdgcn_global_load_lds((const unsigned*)((const char*)(gbase) + (voff)[_i]), (PG8_LAS unsigned*)(lds + (bufoff) + ldsw + _i * 8192), 16, 0, 0); } while (0)
#define PG8_LDA(dst, b, h) do { _Pragma("unroll") for (int m = 0; m < 4; ++m) _Pragma("unroll") for (int k = 0; k < 2; ++k) dst[m][k] = *(const PG8_LAS bf16x8*)(lds + PG8_SA(b, h) + aoff + m * 2048 + k * 1024); } while (0)
#define PG8_LDB(dst, b, h) do { _Pragma("unroll") for (int n = 0; n < 2; ++n) _Pragma("unroll") for (int k = 0; k < 2; ++k) dst[n][k] = *(const PG8_LAS bf16x8*)(lds + PG8_SB(b, h) + boff + n * 2048 + k * 1024); } while (0)
#define PG8_MMA(ai, bj, At, Bt) do { __builtin_amdgcn_s_setprio(1); _Pragma("unroll") for (int m = 0; m < 4; ++m) _Pragma("unroll") for (int n = 0; n < 2; ++n) _Pragma("unroll") for (int k = 0; k < 2; ++k) \
        acc[ai][bj][m][n] = __builtin_amdgcn_mfma_f32_16x16x32_bf16(Bt[n][k], At[m][k], acc[ai][bj][m][n], 0, 0, 0); __builtin_amdgcn_s_setprio(0); } while (0)
#define PG8_WAIT_V(n) asm volatile("s_waitcnt vmcnt(" #n ")" ::: "memory")
#define PG8_WAIT_L(n) asm volatile("s_waitcnt lgkmcnt(" #n ")" ::: "memory")
#define PG8_BAR __builtin_amdgcn_s_barrier()
#define PG8_SCHED __builtin_amdgcn_sched_barrier(0)
    Unit cur, nxt; int ui = 0;
    if (!S.next(0, cur)) return;
    f32x4 acc[2][2][4][2];
#pragma unroll
    for (int a = 0; a < 2; ++a)
#pragma unroll
        for (int b = 0; b < 2; ++b)
#pragma unroll
            for (int m = 0; m < 4; ++m)
#pragma unroll
                for (int n = 0; n < 2; ++n) acc[a][b][m][n] = (f32x4){0.f, 0.f, 0.f, 0.f};
    bf16x8 At[4][2], B0[2][2], B1[2][2];
    const char* cA = (const char*)g.A + (size_t)cur.pm * tstep; const char* cB = (const char*)g.Bt + (size_t)cur.pn * tstep;
    PG8_STAGE(PG8_SB(0, 0), cB, voffB); PG8_STAGE(PG8_SB(0, 1), cB + hstep, voffB); PG8_STAGE(PG8_SA(0, 0), cA, voffA); PG8_STAGE(PG8_SA(0, 1), cA + hstep, voffA);
    if (wr == 1) PG8_BAR;
    PG8_WAIT_V(2); PG8_BAR;
    PG8_STAGE(PG8_SB(1, 0), cB + kstep, voffB); PG8_STAGE(PG8_SA(1, 0), cA + kstep, voffA); PG8_STAGE(PG8_SB(1, 1), cB + hstep + kstep, voffB);
    PG8_WAIT_V(6); PG8_BAR;
    for (;;) {
        const bool has_next = S.next(ui + 1, nxt);
        const char* nA = has_next ? (const char*)g.A + (size_t)nxt.pm * tstep : cA; const char* nB = has_next ? (const char*)g.Bt + (size_t)nxt.pn * tstep : cB;
        for (int t = 0; t < nt; t += 2) {
            const bool last = (t == nt - 2);
            const char* a1 = cA + (size_t)(t + 1) * kstep;
            const char* a2 = last ? nA : cA + (size_t)(t + 2) * kstep; const char* b2 = last ? nB : cB + (size_t)(t + 2) * kstep;
            const char* a3 = a2 + kstep; const char* b3 = b2 + kstep;
            if constexpr (Epi::MID_T >= 0) { if (t == Epi::MID_T) E.mid(acc, cur, wr, wc, fr, fq); }
            PG8_LDB(B0, 0, 0); PG8_LDB(B1, 0, 1); PG8_SCHED; PG8_LDA(At, 0, 0); PG8_STAGE(PG8_SA(1, 1), a1 + hstep, voffA);
            PG8_WAIT_V(8); PG8_WAIT_L(0); PG8_BAR; PG8_MMA(0, 0, At, B0); PG8_MMA(0, 1, At, B1); PG8_BAR; PG8_SCHED;
            PG8_LDA(At, 0, 1); PG8_STAGE(PG8_SB(0, 0), b2, voffB); PG8_STAGE(PG8_SB(0, 1), b2 + hstep, voffB); PG8_STAGE(PG8_SA(0, 0), a2, voffA);
            PG8_WAIT_V(8); PG8_WAIT_L(0); PG8_BAR; PG8_MMA(1, 0, At, B0); PG8_MMA(1, 1, At, B1); PG8_BAR; PG8_SCHED;
            PG8_LDB(B0, 1, 0); PG8_LDB(B1, 1, 1); PG8_SCHED; PG8_LDA(At, 1, 0); PG8_STAGE(PG8_SA(0, 1), a2 + hstep, voffA);
            PG8_WAIT_V(8); PG8_WAIT_L(0); PG8_BAR; PG8_MMA(0, 0, At, B0); PG8_MMA(0, 1, At, B1); PG8_BAR; PG8_SCHED;
            PG8_LDA(At, 1, 1); PG8_STAGE(PG8_SB(1, 0), b3, voffB); PG8_STAGE(PG8_SB(1, 1), b3 + hstep, voffB); PG8_STAGE(PG8_SA(1, 0), a3, voffA);
            PG8_WAIT_V(8); PG8_WAIT_L(0); PG8_BAR; PG8_MMA(1, 0, At, B0); PG8_MMA(1, 1, At, B1); PG8_BAR; PG8_SCHED;
        }
        if (wr == 0) PG8_BAR;
        E.run(acc, cur, wr, wc, fr, fq, red, tid);
        if (!has_next) break;
#pragma unroll
        for (int a = 0; a < 2; ++a)
#pragma unroll
            for (int b = 0; b < 2; ++b)
#pragma unroll
                for (int m = 0; m < 4; ++m)
#pragma unroll
                    for (int n = 0; n < 2; ++n) acc[a][b][m][n] = (f32x4){0.f, 0.f, 0.f, 0.f};
        cur = nxt; cA = nA; cB = nB; ++ui;
        if (wr == 1) PG8_BAR;
    }
    PG8_WAIT_V(0);
    PG8_BAR;
#undef PG8_SA
#undef PG8_SB
#undef PG8_STAGE
#undef PG8_LDA
#undef PG8_LDB
#undef PG8_MMA
#undef PG8_WAIT_V
#undef PG8_WAIT_L
#undef PG8_BAR
#undef PG8_SCHED
}
}

typedef GAS unsigned gu32;
#define RLX_AGENT __ATOMIC_RELAXED, __HIP_MEMORY_SCOPE_AGENT
#define LDS_WAIT() asm volatile("s_waitcnt lgkmcnt(0)" ::: "memory")
#define VM_WAIT() asm volatile("s_waitcnt vmcnt(0)" ::: "memory")

#define XB_TMO      128
#define XB_XCNT(j)  (256  + 64 * (j))
#define XB_XSUB(j)  (1280 + 64 * (j))
#define XB_XGEN(j)  (2304 + 64 * (j))
#define XB_TOP      3328
#define XB_TOPGEN   3392
#define XCD_BAR_WORDS 3456
#define XB_SPIN_CAP (1u << 18)
__device__ __forceinline__ unsigned xb_ld(unsigned* p)              { return __hip_atomic_load(p, __ATOMIC_RELAXED, __HIP_MEMORY_SCOPE_AGENT); }
__device__ __forceinline__ unsigned xb_add(unsigned* p, unsigned v) { return __hip_atomic_fetch_add(p, v, __ATOMIC_RELAXED, __HIP_MEMORY_SCOPE_AGENT); }
__device__ __forceinline__ unsigned xb_xcc_id() { return (unsigned)__builtin_amdgcn_s_getreg((3 << 11) | 20) & 0xFu; }
#define XB_SPIN(cond, bar) do { unsigned _sp = 0; while (cond) { __builtin_amdgcn_s_sleep(1); \
    if ((++_sp & 255u) == 0u) { if (xb_ld(&(bar)[XB_TMO])) break; if (_sp > XB_SPIN_CAP) { atomicAdd(&(bar)[XB_TMO], 1u); break; } } } } while (0)
struct XcdBarrier { unsigned* bar; unsigned x; volatile LAS unsigned* st; };
__device__ __forceinline__ XcdBarrier xcd_barrier_post(unsigned* bar, volatile LAS unsigned* st) {
    XcdBarrier b; b.bar = bar; b.x = xb_xcc_id(); b.st = st;
    if (threadIdx.x == 0) (void)xb_add(&bar[XB_XCNT(b.x)], 1u);
    return b;
}
__device__ __forceinline__ void xcd_barrier_complete(unsigned* bar, unsigned x, unsigned& nloc, unsigned& nx) {
    const unsigned G = gridDim.x * gridDim.y * gridDim.z;
    unsigned sum, cnt, mine, sp = 0u;
    for (;;) {
        sum = 0u; cnt = 0u; mine = 0u;
#pragma unroll
        for (unsigned j = 0; j < 16; ++j) { const unsigned c = xb_ld(&bar[XB_XCNT(j)]); sum += c; cnt += (c > 0u) ? 1u : 0u; mine = (j == x) ? c : mine; }
        if (sum == G) break;
        __builtin_amdgcn_s_sleep(1);
        if ((++sp & 255u) == 0u) { if (xb_ld(&bar[XB_TMO])) break; if (sp > XB_SPIN_CAP) { atomicAdd(&bar[XB_TMO], 1u); break; } }
    }
    nloc = mine > 0u ? mine : 1u; nx = cnt > 0u ? cnt : 1u;
}
__device__ __forceinline__ void xcd_barrier(const XcdBarrier& b) {
    asm volatile("s_waitcnt vmcnt(0)" ::: "memory");
    __syncthreads();
    if (threadIdx.x == 0) {
        unsigned* bar = b.bar;
        __builtin_amdgcn_s_waitcnt(0);
        unsigned nloc = b.st[0], nx = b.st[1];
        if (nloc == 0u) { xcd_barrier_complete(bar, b.x, nloc, nx); b.st[0] = nloc; b.st[1] = nx; }
        const unsigned old = xb_add(&bar[XB_XSUB(b.x)], 1u);
        const unsigned gen = old / nloc;
        if (old + 1u == (gen + 1u) * nloc) {
            __builtin_amdgcn_fence(__ATOMIC_RELEASE, "agent");
            asm volatile("s_waitcnt vmcnt(0)" ::: "memory");
            const unsigned og = xb_add(&bar[XB_TOP], 1u);
            const unsigned tg = og / nx;
            if (og + 1u == (tg + 1u) * nx) xb_add(&bar[XB_TOPGEN], 1u);
            else XB_SPIN(xb_ld(&bar[XB_TOPGEN]) == tg, bar);
            __builtin_amdgcn_fence(__ATOMIC_ACQUIRE, "agent");
            xb_add(&bar[XB_XGEN(b.x)], 1u);
            asm volatile("s_waitcnt vmcnt(0)" ::: "memory");
        } else {
            XB_SPIN(xb_ld(&bar[XB_XGEN(b.x)]) == gen, bar);
            __builtin_amdgcn_fence(__ATOMIC_ACQUIRE, "agent");
            asm volatile("s_waitcnt vmcnt(0)" ::: "memory");
        }
    }
    __syncthreads();
}

struct Frame { LAS unsigned char* lds; int tid, lane, wave, vcu, G; };
__device__ __forceinline__ Frame make_frame(LAS unsigned char* lds) {
    Frame F; F.lds = lds; int t = threadIdx.x; asm volatile("" : "+v"(t)); F.tid = t; F.lane = t & 63; F.wave = __builtin_amdgcn_readfirstlane(t >> 6);
    F.G = gridDim.x; { const int bx = blockIdx.x; F.vcu = (F.G % 8 == 0) ? (bx % 8) * (F.G / 8) + bx / 8 : bx; }
    return F;
}

__device__ __forceinline__ float wave_sum(float v) {
#pragma unroll
    for (int o = 1; o < 64; o <<= 1) v += __shfl_xor(v, o);
    return v;
}

__device__ __forceinline__ void p0_transpose_item(const float* W, int N, bf16_t* WT, int ldt, int col_off, const float* gain, LAS float* scr, int item, int lane) {
    const int nblk = N / 32, kb = item / nblk, nb = item % nblk, k0 = 64 * kb, n0 = 32 * nb;
#pragma unroll 8
    for (int i = 0; i < 32; ++i) { const int kk = 2 * i + (lane >> 5); const float gsc = gain ? gain[k0 + kk] : 1.0f; scr[kk * 33 + (lane & 31)] = W[(size_t)(k0 + kk) * N + n0 + (lane & 31)] * gsc; }
    LDS_WAIT(); asm volatile("" ::: "memory");
    const int c = lane & 7;
#pragma unroll
    for (int j = 0; j < 4; ++j) { const int n = (lane >> 3) + 8 * j; const LAS float* s = scr + (8 * c) * 33 + n;
        u32x4 o; o.x = cvtpk(s[0 * 33], s[1 * 33]); o.y = cvtpk(s[2 * 33], s[3 * 33]); o.z = cvtpk(s[4 * 33], s[5 * 33]); o.w = cvtpk(s[6 * 33], s[7 * 33]);
        *(GAS u32x4*)(WT + (size_t)(n0 + n) * ldt + col_off + k0 + 8 * c) = o; }
    LDS_WAIT(); asm volatile("" ::: "memory");
}

struct Ptrs {
    const float *xp, *xs, *ck, *cv, *sc, *nmix, *w_in, *sinks, *lng, *lnb, *gws, *gbs, *wpa, *wpb, *wout, *nffn, *wup, *cw, *cb, *wdn, *nfin;
    float* out; unsigned char* ws;
};

__device__ __forceinline__ void p0_prologue(LAS unsigned char* lds_, const Ptrs& P) {
    const Frame F = make_frame(lds_);
    LAS float* scr = (LAS float*)(F.lds + RING_OFF + F.wave * 16384);
    const int gw = F.vcu * 8 + F.wave, NGW = F.G * 8;
    bf16_t* WINb = (bf16_t*)(P.ws + WS_WIN); bf16_t* WMb = (bf16_t*)(P.ws + WS_WM); bf16_t* WOb = (bf16_t*)(P.ws + WS_WOUT); bf16_t* WUb = (bf16_t*)(P.ws + WS_WUP); bf16_t* WDb = (bf16_t*)(P.ws + WS_WDN);
    constexpr int I_IN = 16 * 160, I_PA = 16 * 32, I_PB = 12 * 32, I_OUT = 16 * 32, I_UP = 16 * 176, I_DN = 44 * 32, I_L = I_IN + I_PA + I_PB + I_OUT + I_UP + I_DN;
    for (int it = gw; it < DEPTH * I_L; it += NGW) {
        const int l = it / I_L; int r = it % I_L;
        if (r < I_IN) { p0_transpose_item(P.w_in + (size_t)l * DM * NIN, NIN, WINb + (size_t)l * NIN * DM, DM, 0, P.nmix + l * DM, scr, r, F.lane); continue; } r -= I_IN;
        if (r < I_PA) { p0_transpose_item(P.wpa + (size_t)l * DM * DM, DM, WMb + (size_t)l * DM * KM, KM, 0, nullptr, scr, r, F.lane); continue; } r -= I_PA;
        if (r < I_PB) { p0_transpose_item(P.wpb + (size_t)l * GW * DM, DM, WMb + (size_t)l * DM * KM, KM, 1024, nullptr, scr, r, F.lane); continue; } r -= I_PB;
        if (r < I_OUT) { p0_transpose_item(P.wout + (size_t)l * DM * DM, DM, WOb + (size_t)l * DM * DM, DM, 0, nullptr, scr, r, F.lane); continue; } r -= I_OUT;
        if (r < I_UP) { p0_transpose_item(P.wup + (size_t)l * DM * NUP, NUP, WUb + (size_t)l * NUP * DM, DM, 0, P.nffn + l * DM, scr, r, F.lane); continue; } r -= I_UP;
        p0_transpose_item(P.wdn + (size_t)l * DFF * DM, DM, WDb + (size_t)l * DM * DFF, DFF, 0, nullptr, scr, r, F.lane);
    }
    { bf16_t* WSB = (bf16_t*)(P.ws + WS_WSB); const int gt = gw * 64 + F.lane, NT = NGW * 64;
      for (int e = gt; e < DEPTH * 6 * 128 * 64; e += NT) { const int s = (e & 63) * 2, t = (e >> 6) & 127; const f32x2 w = *(const f32x2*)(P.gws + (size_t)e * 2);
          *(unsigned*)(WSB + (size_t)e * 2) = cvtpk(s <= t ? w[0] : 0.f, s + 1 <= t ? w[1] : 0.f); } }
    { float* X = P.out + O_Y; bf16_t* XB = (bf16_t*)(P.ws + WS_XB); float* xsq = (float*)(P.ws + WS_XSQ);
      for (int m = gw; m < M; m += NGW) {
          const float* src = m < MP ? P.xp + (size_t)m * DM : P.xs + (size_t)(m - MP) * DM;
          f32x4 v[4]; float s = 0.f;
#pragma unroll
          for (int j = 0; j < 4; ++j) { v[j] = *(const f32x4*)(src + 4 * F.lane + 256 * j); s += (v[j][0] * v[j][0] + v[j][1] * v[j][1]) + (v[j][2] * v[j][2] + v[j][3] * v[j][3]); }
          s = wave_sum(s);
#pragma unroll
          for (int j = 0; j < 4; ++j) { *(f32x4*)(X + (size_t)m * DM + 4 * F.lane + 256 * j) = v[j]; u32x2 w; w.x = cvtpk(v[j][0], v[j][1]); w.y = cvtpk(v[j][2], v[j][3]); *(u32x2*)(XB + (size_t)m * DM + 4 * F.lane + 256 * j) = w; }
          if (F.lane == 0) *(f32x4*)(xsq + (size_t)m * 4) = (f32x4){s, 0.f, 0.f, 0.f};
      } }
    { const int gt = gw * 64 + F.lane, NT = NGW * 64; constexpr int PER = 7680, TOT = DEPTH * SB * PER;
      for (int e = gt; e < 2 * TOT; e += NT) { const int which = e >= TOT, r = which ? e - TOT : e, lb = r / PER, o = r % PER;
          const float* src = (which ? P.cv : P.ck) + (size_t)lb * 32768 + 2048 + (size_t)o * 4; float* dst = P.out + (which ? O_WVS : O_WKS) + (size_t)lb * 32768 + (size_t)o * 4;
          *(f32x4*)dst = *(const f32x4*)src; } }
}

constexpr int AT_K = 0, AT_V = 24576, AT_WS = 49152, AT_OST = 51200;
constexpr int GM_VN = 0, GM_ST = 32768, GM_OST = 34816;
__device__ __forceinline__ f32x16 mfma32(bf16x8 a, bf16x8 b, f32x16 c) { return __builtin_amdgcn_mfma_f32_32x32x16_bf16(a, b, c, 0, 0, 0); }
typedef short v4i16_t __attribute__((ext_vector_type(4)));
__device__ __forceinline__ s16x4 vtr(LAS const unsigned char* p) { return __builtin_bit_cast(s16x4, __builtin_amdgcn_ds_read_tr16_b64_v4i16((LAS v4i16_t*)p)); }
#define PK8(lo, hi) (bf16x8){lo[0], lo[1], lo[2], lo[3], hi[0], hi[1], hi[2], hi[3]}
__device__ __forceinline__ bf16x8 pack8(float a0, float a1, float a2, float a3, float a4, float a5, float a6, float a7) {
    u32x4 w; w.x = cvtpk(a0, a1); w.y = cvtpk(a2, a3); w.z = cvtpk(a4, a5); w.w = cvtpk(a6, a7); return __builtin_bit_cast(bf16x8, w); }

__device__ __forceinline__ float softmax5(f32x16 (&p)[5], float sink2) {
    float m = sink2;
#pragma unroll
    for (int j = 0; j < 5; ++j)
#pragma unroll
        for (int r = 0; r < 16; ++r) m = fmaxf(m, p[j][r]);
    { auto rr = __builtin_amdgcn_permlane32_swap(__float_as_uint(m), __float_as_uint(m), false, false); m = fmaxf(__uint_as_float(rr[0]), __uint_as_float(rr[1])); }
    float l = 0.f;
#pragma unroll
    for (int j = 0; j < 5; ++j)
#pragma unroll
        for (int r = 0; r < 16; ++r) { p[j][r] = __builtin_amdgcn_exp2f(p[j][r] - m); l += p[j][r]; }
    { auto rr = __builtin_amdgcn_permlane32_swap(__float_as_uint(l), __float_as_uint(l), false, false); l = __uint_as_float(rr[0]) + __uint_as_float(rr[1]); }
    return l + __builtin_amdgcn_exp2f(sink2 - m);
}

__device__ __forceinline__ void attn_prompt_unit(const Frame& F, const bf16_t* Z, bf16_t* OS, float* owk, float* owv, const float* sinks_l, int b, int kvh, int qb) {
    LAS unsigned char* lds = F.lds;
    const int lane = F.lane, wid = F.wave, r32 = lane & 31, hi = lane >> 5, g = wid >> 1, rh = wid & 1;
    const int pos0 = 64 * qb - 128; const size_t rowb = (size_t)b * SEQ;
#pragma unroll
    for (int tl = 0; tl < 3; ++tl) {
        int pk = pos0 + 64 * tl + lane; pk = pk < 0 ? 0 : pk;
        __builtin_amdgcn_global_load_lds((const unsigned*)(Z + (rowb + pk) * NIN + C_K + kvh * 64 + wid * 8), (LAS unsigned*)(lds + AT_K + tl * 8192 + wid * 1024), 16, 0, 0);
        int pv = pos0 + 64 * tl + 16 * (wid & 3) + (lane >> 2); pv = pv < 0 ? 0 : pv;
        __builtin_amdgcn_global_load_lds((const unsigned*)(Z + (rowb + pv) * NIN + C_V + kvh * 64 + (wid >> 2) * 32 + (lane & 3) * 8), (LAS unsigned*)(lds + AT_V + tl * 8192 + wid * 1024), 16, 0, 0);
    }
    const size_t qrow = rowb + 64 * qb + 32 * rh + r32;
    bf16x8 qr[4];
#pragma unroll
    for (int d0 = 0; d0 < 4; ++d0) qr[d0] = *(const bf16x8*)(Z + qrow * NIN + C_Q + (kvh * 4 + g) * 64 + d0 * 16 + hi * 8);
    VM_WAIT(); __syncthreads();
    f32x16 p[5];
#pragma unroll
    for (int j = 0; j < 5; ++j) {
        const int kbk = rh + j; LAS const unsigned char* kb = lds + AT_K + (kbk >> 1) * 8192 + hi * 1024 + ((kbk & 1) * 32 + r32) * 16;
        f32x16 a = {};
#pragma unroll
        for (int d0 = 0; d0 < 4; ++d0) a = mfma32(*(LAS const bf16x8*)(kb + d0 * 2048), qr[d0], a);
        p[j] = a;
    }
#pragma unroll
    for (int r = 0; r < 16; ++r) { const int cr = crow(r, hi); if (cr <= r32) p[0][r] = NEGBIG; if (cr > r32) p[4][r] = NEGBIG; }
    if (qb < 2) {
#pragma unroll
        for (int j = 0; j < 5; ++j)
#pragma unroll
            for (int r = 0; r < 16; ++r) if (pos0 + 32 * (rh + j) + crow(r, hi) < 0) p[j][r] = NEGBIG;
    }
    const float l = softmax5(p, sinks_l[kvh * 4 + g] * LOG2E);
    f32x16 o0 = {}, o1 = {};
    const int vlane = ((lane >> 4) & 1) * 32 + (lane & 3) * 8 + (4 * hi + ((lane & 15) >> 2)) * 64;
#pragma unroll
    for (int j = 0; j < 5; ++j) {
        const int kbk = rh + j;
#pragma unroll
        for (int s = 0; s < 2; ++s) {
            const bf16x8 pa = pack8(p[j][8 * s + 0], p[j][8 * s + 1], p[j][8 * s + 2], p[j][8 * s + 3], p[j][8 * s + 4], p[j][8 * s + 5], p[j][8 * s + 6], p[j][8 * s + 7]);
            LAS const unsigned char* vb = lds + AT_V + (kbk >> 1) * 8192 + (2 * (kbk & 1) + s) * 1024 + vlane;
            { const s16x4 lo = vtr(vb), hh = vtr(vb + 512); o0 = mfma32(pa, PK8(lo, hh), o0); }
            { const s16x4 lo = vtr(vb + 4096), hh = vtr(vb + 4096 + 512); o1 = mfma32(pa, PK8(lo, hh), o1); }
        }
    }
    LAS float* wsf = (LAS float*)(lds + AT_WS) + wid * 64;
    if (hi == 0) wsf[r32] = l;
    LDS_WAIT();
    LAS bf16_t* stg = (LAS bf16_t*)(lds + AT_OST) + wid * 2048;
#pragma unroll
    for (int r = 0; r < 16; ++r) { const int orow = crow(r, hi); const float rl = __builtin_amdgcn_rcpf(wsf[orow]);
        stg[orow * 64 + r32] = (bf16_t)(cvtpk(o0[r] * rl, 0.f) & 0xffffu); stg[orow * 64 + 32 + r32] = (bf16_t)(cvtpk(o1[r] * rl, 0.f) & 0xffffu); }
    LDS_WAIT();
    bf16_t* Ow = OS + (rowb + 64 * qb + 32 * rh) * KM + (kvh * 4 + g) * 64;
#pragma unroll
    for (int i = 0; i < 4; ++i) { const int row = i * 8 + (lane >> 3), ch = lane & 7; const u32x4 v = *(LAS const u32x4*)(stg + row * 64 + ch * 8); *(u32x4*)(Ow + (size_t)row * KM + ch * 8) = v; }
    if (qb >= 126) {
        const int row = F.tid & 63, c = F.tid >> 6, j = 64 * (qb - 126) + row;
        const u32x4 kk = *(LAS const u32x4*)(lds + AT_K + 2 * 8192 + c * 1024 + row * 16);
        const u32x4 vv = *(LAS const u32x4*)(lds + AT_V + 2 * 8192 + (c >> 2) * 4096 + (row >> 4) * 1024 + (row & 15) * 64 + (c & 3) * 16);
        float* dk = owk + ((size_t)(b * WIN + j)) * 256 + kvh * 64 + c * 8; float* dv = owv + ((size_t)(b * WIN + j)) * 256 + kvh * 64 + c * 8;
        *(f32x4*)dk = (f32x4){bflo(kk.x), bfhi(kk.x), bflo(kk.y), bfhi(kk.y)}; *(f32x4*)(dk + 4) = (f32x4){bflo(kk.z), bfhi(kk.z), bflo(kk.w), bfhi(kk.w)};
        *(f32x4*)dv = (f32x4){bflo(vv.x), bfhi(vv.x), bflo(vv.y), bfhi(vv.y)}; *(f32x4*)(dv + 4) = (f32x4){bflo(vv.z), bfhi(vv.z), bflo(vv.w), bfhi(vv.w)};
    }
}

__device__ __forceinline__ void attn_sample_wave(const Frame& F, const bf16_t* Z, bf16_t* OS, const float* ck, const float* cv, float* owk, float* owv, const float* sinks_l, int b, int kvh) {
    LAS unsigned char* lds = F.lds;
    const int lane = F.lane, wid = F.wave, r32 = lane & 31, hi = lane >> 5, g = r32 >> 3, qi = r32 & 7;
    const size_t qrow = (size_t)MP + b * 8 + qi;
    bf16x8 qr[4];
#pragma unroll
    for (int d0 = 0; d0 < 4; ++d0) qr[d0] = *(const bf16x8*)(Z + qrow * NIN + C_Q + (kvh * 4 + g) * 64 + d0 * 16 + hi * 8);
    f32x16 p[5];
#pragma unroll
    for (int j = 0; j < 4; ++j) {
        const float* kp = ck + ((size_t)(b * WIN + 32 * j + r32) * 4 + kvh) * 64 + 8 * hi;
        f32x16 a = {};
#pragma unroll
        for (int d0 = 0; d0 < 4; ++d0) { const f32x4 x = *(const f32x4*)(kp + 16 * d0), y = *(const f32x4*)(kp + 16 * d0 + 4); a = mfma32(pack8(x[0], x[1], x[2], x[3], y[0], y[1], y[2], y[3]), qr[d0], a); }
        p[j] = a;
    }
    { const size_t krow = (size_t)MP + b * 8 + (r32 < 8 ? r32 : 7); f32x16 a = {};
#pragma unroll
      for (int d0 = 0; d0 < 4; ++d0) a = mfma32(*(const bf16x8*)(Z + krow * NIN + C_K + kvh * 64 + d0 * 16 + hi * 8), qr[d0], a);
      p[4] = a; }
#pragma unroll
    for (int r = 0; r < 16; ++r) { const int cr = crow(r, hi); if (cr <= qi) p[0][r] = NEGBIG; if (cr > qi) p[4][r] = NEGBIG; }
    const float l = softmax5(p, sinks_l[kvh * 4 + g] * LOG2E);
    f32x16 o0 = {}, o1 = {};
#pragma unroll
    for (int j = 0; j < 4; ++j)
#pragma unroll
        for (int s = 0; s < 2; ++s) {
            const bf16x8 pa = pack8(p[j][8 * s + 0], p[j][8 * s + 1], p[j][8 * s + 2], p[j][8 * s + 3], p[j][8 * s + 4], p[j][8 * s + 5], p[j][8 * s + 6], p[j][8 * s + 7]);
            const float* vp = cv + ((size_t)(b * WIN + 32 * j + 16 * s + 4 * hi) * 4 + kvh) * 64 + r32;
            float x[8], y[8];
#pragma unroll
            for (int e = 0; e < 8; ++e) { const int kk = (e & 3) + 8 * (e >> 2); x[e] = vp[(size_t)kk * 256]; y[e] = vp[(size_t)kk * 256 + 32]; }
            o0 = mfma32(pa, pack8(x[0], x[1], x[2], x[3], x[4], x[5], x[6], x[7]), o0);
            o1 = mfma32(pa, pack8(y[0], y[1], y[2], y[3], y[4], y[5], y[6], y[7]), o1);
        }
    { const bf16x8 pa = pack8(p[4][0], p[4][1], p[4][2], p[4][3], p[4][4], p[4][5], p[4][6], p[4][7]);
      const bf16_t* vp = Z + ((size_t)MP + b * 8 + 4 * hi) * NIN + C_V + kvh * 64 + r32;
      u32x4 x = {0u, 0u, 0u, 0u}, y = {0u, 0u, 0u, 0u};
      x.x = (unsigned)vp[0] | ((unsigned)vp[NIN] << 16); x.y = (unsigned)vp[2 * NIN] | ((unsigned)vp[3 * NIN] << 16);
      y.x = (unsigned)vp[32] | ((unsigned)vp[NIN + 32] << 16); y.y = (unsigned)vp[2 * NIN + 32] | ((unsigned)vp[3 * NIN + 32] << 16);
      o0 = mfma32(pa, __builtin_bit_cast(bf16x8, x), o0); o1 = mfma32(pa, __builtin_bit_cast(bf16x8, y), o1); }
    LAS float* wsf = (LAS float*)(lds + AT_WS) + wid * 64;
    if (hi == 0) wsf[r32] = l;
    LDS_WAIT();
    LAS bf16_t* stg = (LAS bf16_t*)(lds + AT_OST) + wid * 2048;
#pragma unroll
    for (int r = 0; r < 16; ++r) { const int orow = crow(r, hi); const float rl = __builtin_amdgcn_rcpf(wsf[orow]);
        stg[orow * 64 + r32] = (bf16_t)(cvtpk(o0[r] * rl, 0.f) & 0xffffu); stg[orow * 64 + 32 + r32] = (bf16_t)(cvtpk(o1[r] * rl, 0.f) & 0xffffu); }
    LDS_WAIT();
#pragma unroll
    for (int i = 0; i < 4; ++i) { const int row = i * 8 + (lane >> 3), ch = lane & 7; const u32x4 v = *(LAS const u32x4*)(stg + row * 64 + ch * 8);
        *(u32x4*)(OS + ((size_t)MP + b * 8 + (row & 7)) * KM + (kvh * 4 + (row >> 3)) * 64 + ch * 8) = v; }
    { const int i = lane >> 3, c = (lane & 7) * 8; const bf16_t* zr = Z + ((size_t)MP + b * 8 + i) * NIN + kvh * 64 + c;
      const u32x4 kk = *(const u32x4*)(zr + C_K), vv = *(const u32x4*)(zr + C_V);
      float* dk = owk + ((size_t)(b * WIN + 120 + i)) * 256 + kvh * 64 + c; float* dv = owv + ((size_t)(b * WIN + 120 + i)) * 256 + kvh * 64 + c;
      *(f32x4*)dk = (f32x4){bflo(kk.x), bfhi(kk.x), bflo(kk.y), bfhi(kk.y)}; *(f32x4*)(dk + 4) = (f32x4){bflo(kk.z), bfhi(kk.z), bflo(kk.w), bfhi(kk.w)};
      *(f32x4*)dv = (f32x4){bflo(vv.x), bfhi(vv.x), bflo(vv.y), bfhi(vv.y)}; *(f32x4*)(dv + 4) = (f32x4){bflo(vv.z), bfhi(vv.z), bflo(vv.w), bfhi(vv.w)}; }
}

__device__ __forceinline__ void gmlp_prompt_unit(const Frame& F, const bf16_t* Z, bf16_t* OS, const float* gvst, const float* lng, const float* lnb, const bf16_t* wsb_l, const float* bs_l, int b, int ch, int g) {
    LAS unsigned char* lds = F.lds;
    const int tid = F.tid, lane = F.lane, wid = F.wave, r32 = lane & 31, hi = lane >> 5, tb = wid >> 1, chh = wid & 1;
    const size_t R0 = (size_t)b * SEQ + 128 * ch;
    LAS f32x2* st = (LAS f32x2*)(lds + GM_ST);
    if (tid < 128) { const float* pp = gvst + (R0 + tid) * 24; float s1 = 0.f, s2 = 0.f;
#pragma unroll
        for (int k = 0; k < 6; ++k) { const f32x4 v = *(const f32x4*)(pp + 4 * k); s1 += v[0] + v[2]; s2 += v[1] + v[3]; }
        const float mean = s1 * (1.0f / GW), var = fmaxf(s2 * (1.0f / GW) - mean * mean, 0.f); st[tid] = (f32x2){mean, __builtin_amdgcn_rsqf(var + EPS)}; }
    __syncthreads();
#pragma unroll
    for (int it = 0; it < 4; ++it) {
        const int idx = tid + 512 * it, s = idx >> 4, c8 = (idx & 15) * 8;
        const u32x4 x = *(const u32x4*)(Z + (R0 + s) * NIN + C_GV + 128 * g + c8);
        const f32x4 g0 = *(const f32x4*)(lng + 128 * g + c8), g1 = *(const f32x4*)(lng + 128 * g + c8 + 4), b0 = *(const f32x4*)(lnb + 128 * g + c8), b1 = *(const f32x4*)(lnb + 128 * g + c8 + 4);
        const f32x2 ms = st[s];
        const float v0 = (bflo(x.x) - ms[0]) * ms[1] * g0[0] + b0[0], v1 = (bfhi(x.x) - ms[0]) * ms[1] * g0[1] + b0[1], v2 = (bflo(x.y) - ms[0]) * ms[1] * g0[2] + b0[2], v3 = (bfhi(x.y) - ms[0]) * ms[1] * g0[3] + b0[3];
        const float v4 = (bflo(x.z) - ms[0]) * ms[1] * g1[0] + b1[0], v5 = (bfhi(x.z) - ms[0]) * ms[1] * g1[1] + b1[1], v6 = (bflo(x.w) - ms[0]) * ms[1] * g1[2] + b1[2], v7 = (bfhi(x.w) - ms[0]) * ms[1] * g1[3] + b1[3];
        u32x4 w; w.x = cvtpk(v0, v1); w.y = cvtpk(v2, v3); w.z = cvtpk(v4, v5); w.w = cvtpk(v6, v7);
        *(LAS u32x4*)(lds + GM_VN + ((c8 >> 5) * 8 + (s >> 4)) * 1024 + (s & 15) * 64 + (c8 & 31) * 2) = w;
    }
    __syncthreads();
    f32x16 a0 = {}, a1 = {};
    const int vlane = ((lane >> 4) & 1) * 32 + (lane & 3) * 8 + (8 * hi + ((lane & 15) >> 2)) * 64;
    const bf16_t* wrow = wsb_l + ((size_t)g * 128 + 32 * tb + r32) * 128 + 8 * hi;
    for (int ks = 0; ks < 2 * (tb + 1); ++ks) {
        const bf16x8 wa = *(const bf16x8*)(wrow + 16 * ks);
        LAS const unsigned char* vb = lds + GM_VN + ((2 * chh) * 8 + ks) * 1024 + vlane;
        { const s16x4 lo = vtr(vb), hh = vtr(vb + 256); a0 = mfma32(wa, PK8(lo, hh), a0); }
        { const s16x4 lo = vtr(vb + 8192), hh = vtr(vb + 8192 + 256); a1 = mfma32(wa, PK8(lo, hh), a1); }
    }
    LAS bf16_t* stg = (LAS bf16_t*)(lds + GM_OST) + wid * 2048;
#pragma unroll
    for (int r = 0; r < 16; ++r) { const int orow = crow(r, hi); const float bsv = bs_l[g * 128 + 32 * tb + orow];
        stg[orow * 64 + r32] = (bf16_t)(cvtpk(a0[r] + bsv, 0.f) & 0xffffu); stg[orow * 64 + 32 + r32] = (bf16_t)(cvtpk(a1[r] + bsv, 0.f) & 0xffffu); }
    LDS_WAIT();
#pragma unroll
    for (int i = 0; i < 4; ++i) { const int row = i * 8 + (lane >> 3), c8 = (lane & 7) * 8; const u32x4 mx = *(LAS const u32x4*)(stg + row * 64 + c8);
        const size_t grow = R0 + 32 * tb + row; const u32x4 gu = *(const u32x4*)(Z + grow * NIN + C_GU + 128 * g + 64 * chh + c8);
        u32x4 w; w.x = cvtpk(bflo(mx.x) * bflo(gu.x), bfhi(mx.x) * bfhi(gu.x)); w.y = cvtpk(bflo(mx.y) * bflo(gu.y), bfhi(mx.y) * bfhi(gu.y));
        w.z = cvtpk(bflo(mx.z) * bflo(gu.z), bfhi(mx.z) * bfhi(gu.z)); w.w = cvtpk(bflo(mx.w) * bflo(gu.w), bfhi(mx.w) * bfhi(gu.w));
        *(u32x4*)(OS + grow * KM + 1024 + 128 * g + 64 * chh + c8) = w; }
}

__device__ __forceinline__ void gmlp_sample_wave(const Frame& F, const bf16_t* Z, bf16_t* OS, const float* gvst, const float* lng, const float* lnb, const float* gws_l, const float* bs_l, float* ogv, int b) {
    const int lane = F.lane; const size_t R0 = (size_t)MP + b * 8;
    float mean = 0.f, rstd = 0.f;
    { const float* pp = gvst + (R0 + (lane & 7)) * 24; float s1 = 0.f, s2 = 0.f;
#pragma unroll
      for (int k = 0; k < 6; ++k) { const f32x4 v = *(const f32x4*)(pp + 4 * k); s1 += v[0] + v[2]; s2 += v[1] + v[3]; }
      mean = s1 * (1.0f / GW); const float var = fmaxf(s2 * (1.0f / GW) - mean * mean, 0.f); rstd = __builtin_amdgcn_rsqf(var + EPS); }
    float mu[8], rs[8];
#pragma unroll
    for (int i = 0; i < 8; ++i) { mu[i] = __shfl(mean, i); rs[i] = __shfl(rstd, i); }
    for (int kk = 0; kk < 12; ++kk) {
        const int c = lane + 64 * kk, g = kk >> 1; const float gg = lng[c], bb = lnb[c];
        float vn[8];
#pragma unroll
        for (int i = 0; i < 8; ++i) { const float x = bflo((unsigned)Z[(R0 + i) * NIN + C_GV + c]); vn[i] = (x - mu[i]) * rs[i] * gg + bb; ogv[((size_t)b * 8 + i) * GW + c] = vn[i]; }
#pragma unroll
        for (int t = 0; t < 8; ++t) { float mx = bs_l[g * 128 + t];
#pragma unroll
            for (int s = 0; s <= t; ++s) mx += gws_l[(size_t)g * 16384 + t * 128 + s] * vn[s];
            const float gu = bflo((unsigned)Z[(R0 + t) * NIN + C_GU + c]);
            OS[(R0 + t) * KM + 1024 + c] = (bf16_t)(cvtpk(gu * mx, 0.f) & 0xffffu); }
    }
}

__device__ __forceinline__ void p2_mixer(LAS unsigned char* lds_, const Ptrs& P, int l) {
    const Frame F = make_frame(lds_);
    const bf16_t* Z = (const bf16_t*)(P.ws + WS_RA); bf16_t* OS = (bf16_t*)(P.ws + WS_RB); const float* gvst = (const float*)(P.ws + WS_GVST);
    const bf16_t* wsb_l = (const bf16_t*)(P.ws + WS_WSB) + (size_t)l * 6 * 16384;
    const float* sinks_l = P.sinks + l * 16; const float* lng = P.lng + l * GW; const float* lnb = P.lnb + l * GW; const float* bs_l = P.gbs + l * GW; const float* gws_l = P.gws + (size_t)l * 6 * 16384;
    float* owkp = P.out + O_WKP + (size_t)l * NB * WIN * 256; float* owvp = P.out + O_WVP + (size_t)l * NB * WIN * 256;
    float* owks = P.out + O_WKS + (size_t)l * SB * WIN * 256; float* owvs = P.out + O_WVS + (size_t)l * SB * WIN * 256;
    const float* ck = P.ck + (size_t)l * SB * WIN * 256; const float* cv = P.cv + (size_t)l * SB * WIN * 256; float* ogv = P.out + O_GVS + (size_t)l * SB * 8 * GW;
    constexpr int NU = 1024 + 768 + 64 + 16;
    for (int U = F.vcu; U < NU; U += F.G) {
        __syncthreads();
        if (U < 1024) attn_prompt_unit(F, Z, OS, owkp, owvp, sinks_l, U >> 9, (U >> 7) & 3, U & 127);
        else if (U < 1792) { const int V = U - 1024; gmlp_prompt_unit(F, Z, OS, gvst, lng, lnb, wsb_l, bs_l, V / 384, (V / 6) % 64, V % 6); }
        else if (U < 1856) { const int V = U - 1792; attn_sample_wave(F, Z, OS, ck, cv, owks, owvs, sinks_l, 2 * V + (F.wave >> 2), F.wave & 3); }
        else { const int V = U - 1856; gmlp_sample_wave(F, Z, OS, gvst, lng, lnb, gws_l, bs_l, ogv, 8 * V + F.wave); }
    }
}

__device__ __forceinline__ void ld8(const bf16_t* p, float (&v)[8]) { const u32x4 x = *(const u32x4*)p; v[0] = bflo(x.x); v[1] = bfhi(x.x); v[2] = bflo(x.y); v[3] = bfhi(x.y); v[4] = bflo(x.z); v[5] = bfhi(x.z); v[6] = bflo(x.w); v[7] = bfhi(x.w); }
__device__ __forceinline__ void ld8f(const float* p, float (&v)[8]) { const f32x4 a = *(const f32x4*)p, b = *(const f32x4*)(p + 4); v[0] = a[0]; v[1] = a[1]; v[2] = a[2]; v[3] = a[3]; v[4] = b[0]; v[5] = b[1]; v[6] = b[2]; v[7] = b[3]; }
__device__ __forceinline__ void st8f(float* p, const float (&v)[8]) { *(f32x4*)p = (f32x4){v[0], v[1], v[2], v[3]}; *(f32x4*)(p + 4) = (f32x4){v[4], v[5], v[6], v[7]}; }
__device__ __forceinline__ void p6_convgate(LAS unsigned char* lds_, const Ptrs& P, int l) {
    const Frame F = make_frame(lds_);
    const bf16_t* Z2 = (const bf16_t*)(P.ws + WS_RA); bf16_t* G = (bf16_t*)(P.ws + WS_RB);
    const float* cw = P.cw + (size_t)l * 3 * NUP; const float* cb = P.cb + (size_t)l * NUP; const float* sc = P.sc + (size_t)l * SB * 2 * NUP;
    float* ocp = P.out + O_CVP + (size_t)l * NB * 2 * NUP; float* ocs = P.out + O_CVS + (size_t)l * SB * 2 * NUP;
    if (F.tid >= 352) return;
    const int c = F.tid * 8;
    float wa[3][8], wb[3][8], ba[8], bb[8];
#pragma unroll
    for (int j = 0; j < 3; ++j) { ld8f(cw + j * NUP + c, wa[j]); ld8f(cw + j * NUP + DFF + c, wb[j]); }
    ld8f(cb + c, ba); ld8f(cb + DFF + c, bb);
    for (int U = F.vcu; U < M / 16; U += F.G) {
        const int r0 = U * 16;
        float a1[8], a2[8], b1[8], b2[8];
        if (r0 < MP) { if ((r0 & (SEQ - 1)) == 0) {
#pragma unroll
                for (int e = 0; e < 8; ++e) { a1[e] = a2[e] = b1[e] = b2[e] = 0.f; } }
            else { ld8(Z2 + (size_t)(r0 - 1) * NUP + c, a1); ld8(Z2 + (size_t)(r0 - 2) * NUP + c, a2); ld8(Z2 + (size_t)(r0 - 1) * NUP + DFF + c, b1); ld8(Z2 + (size_t)(r0 - 2) * NUP + DFF + c, b2); } }
        for (int rr = 0; rr < 16; ++rr) {
            const int row = r0 + rr;
            if (row >= MP && ((row - MP) & 7) == 0) { const float* s0 = sc + (size_t)((row - MP) >> 3) * 2 * NUP; ld8f(s0 + c, a2); ld8f(s0 + NUP + c, a1); ld8f(s0 + DFF + c, b2); ld8f(s0 + NUP + DFF + c, b1); }
            float za[8], zb[8]; ld8(Z2 + (size_t)row * NUP + c, za); ld8(Z2 + (size_t)row * NUP + DFF + c, zb);
            float o[8];
#pragma unroll
            for (int e = 0; e < 8; ++e) { const float ca = ba[e] + wa[0][e] * a2[e] + wa[1][e] * a1[e] + wa[2][e] * za[e], cbv = bb[e] + wb[0][e] * b2[e] + wb[1][e] * b1[e] + wb[2][e] * zb[e]; o[e] = gelu_t(ca) * cbv; }
            u32x4 w; w.x = cvtpk(o[0], o[1]); w.y = cvtpk(o[2], o[3]); w.z = cvtpk(o[4], o[5]); w.w = cvtpk(o[6], o[7]);
            *(u32x4*)(G + (size_t)row * DFF + c) = w;
            if (row < MP) { const int pos = row & (SEQ - 1); if (pos >= SEQ - 2) { float* d = ocp + ((size_t)(row >> 13) * 2 + (pos - (SEQ - 2))) * NUP; st8f(d + c, za); st8f(d + DFF + c, zb); } }
            else { const int i = (row - MP) & 7; if (i >= 6) { float* d = ocs + ((size_t)((row - MP) >> 3) * 2 + (i - 6)) * NUP; st8f(d + c, za); st8f(d + DFF + c, zb); } }
#pragma unroll
            for (int e = 0; e < 8; ++e) { a2[e] = a1[e]; a1[e] = za[e]; b2[e] = b1[e]; b1[e] = zb[e]; }
        }
    }
}

__device__ __forceinline__ void p_final(LAS unsigned char* lds_, const Ptrs& P) {
    const Frame F = make_frame(lds_);
    float* X = P.out + O_Y; const float* xsq = (const float*)(P.ws + WS_XSQ);
    const int gw = F.vcu * 8 + F.wave, NGW = F.G * 8;
    f32x4 gn[4];
#pragma unroll
    for (int j = 0; j < 4; ++j) gn[j] = *(const f32x4*)(P.nfin + 4 * F.lane + 256 * j);
    for (int m = gw; m < M; m += NGW) {
        const f32x4 ps = *(const f32x4*)(xsq + (size_t)m * 4); const float rs = __builtin_amdgcn_rsqf(((ps[0] + ps[1]) + (ps[2] + ps[3])) * (1.0f / DM) + EPS);
#pragma unroll
        for (int j = 0; j < 4; ++j) { float* p = X + (size_t)m * DM + 4 * F.lane + 256 * j; const f32x4 v = *(const f32x4*)p; *(f32x4*)p = v * rs * gn[j]; }
    }
}

struct Args { const float* in[21]; float* out; unsigned char* ws; int ph_lo, ph_hi; };
__global__ void __launch_bounds__(512, 2) mk_fwd(Args args) {
    extern __shared__ __attribute__((aligned(16))) unsigned char lds_raw[];
    LAS unsigned char* const lds = (LAS unsigned char*)lds_raw; const int G = gridDim.x;
    Ptrs P; P.xp = args.in[0]; P.xs = args.in[1]; P.ck = args.in[2]; P.cv = args.in[3]; P.sc = args.in[4]; P.nmix = args.in[5]; P.w_in = args.in[6]; P.sinks = args.in[7]; P.lng = args.in[8]; P.lnb = args.in[9];
    P.gws = args.in[10]; P.gbs = args.in[11]; P.wpa = args.in[12]; P.wpb = args.in[13]; P.wout = args.in[14]; P.nffn = args.in[15]; P.wup = args.in[16]; P.cw = args.in[17]; P.cb = args.in[18]; P.wdn = args.in[19]; P.nfin = args.in[20];
    P.out = args.out; P.ws = args.ws;
    volatile LAS unsigned* MISC = (volatile LAS unsigned*)(lds + MISC_OFF);
    for (int u = threadIdx.x; u < (LDS_BYTES - LDSCTL_OFF) / 4; u += 512) ((LAS unsigned*)(lds + LDSCTL_OFF))[u] = 0u;
    __syncthreads();
    const int lo = args.ph_lo, hi = args.ph_hi;
    XcdBarrier bar; bar.bar = (unsigned*)(args.ws + WS_CTL) + 4096; bar.x = 0; bar.st = nullptr;
    if (hi - lo > 1) bar = xcd_barrier_post((unsigned*)(args.ws + WS_CTL) + 4096, MISC + 8);
    LAS unsigned char* ring = lds + RING_OFF; LAS unsigned char* red = lds + RED_OFF;
    float* X = P.out + O_Y; bf16_t* XB = (bf16_t*)(P.ws + WS_XB); float* xsq = (float*)(P.ws + WS_XSQ);
    for (int ph = lo; ph < hi; ++ph) {
        if (ph == 0) p0_prologue(lds, P);
        else if (ph == NPH - 1) p_final(lds, P);
        else {
            const int l = (ph - 1) / 7, k = (ph - 1) % 7;
            if (k == 0) { pg8::Gemm g{XB, (const bf16_t*)(P.ws + WS_WIN) + (size_t)l * NIN * DM, M, NIN, DM}; pg8::StaticOrder S; S.init(M, NIN, G, (int)blockIdx.x);
                pg8::EpiAct E{(bf16_t*)(P.ws + WS_RA), NIN, xsq, (float*)(P.ws + WS_GVST), 1}; pg8::gemm_phase(ring, red, g, S, E); }
            else if (k == 1) p2_mixer(lds, P, l);
            else if (k == 2) { pg8::Gemm g{(const bf16_t*)(P.ws + WS_RB), (const bf16_t*)(P.ws + WS_WM) + (size_t)l * DM * KM, M, DM, KM}; pg8::StaticOrder S; S.init(M, DM, G, (int)blockIdx.x);
                pg8::EpiMerge E{(const bf16_t*)(P.ws + WS_RA), (bf16_t*)(P.ws + WS_MG)}; pg8::gemm_phase(ring, red, g, S, E); }
            else if (k == 3) { pg8::Gemm g{(const bf16_t*)(P.ws + WS_MG), (const bf16_t*)(P.ws + WS_WOUT) + (size_t)l * DM * DM, M, DM, DM}; pg8::StaticOrder S; S.init(M, DM, G, (int)blockIdx.x);
                pg8::EpiResid E{X, XB, xsq}; pg8::gemm_phase(ring, red, g, S, E); }
            else if (k == 4) { pg8::Gemm g{XB, (const bf16_t*)(P.ws + WS_WUP) + (size_t)l * NUP * DM, M, NUP, DM}; pg8::StaticOrder S; S.init(M, NUP, G, (int)blockIdx.x);
                pg8::EpiAct E{(bf16_t*)(P.ws + WS_RA), NUP, xsq, nullptr, 0}; pg8::gemm_phase(ring, red, g, S, E); }
            else if (k == 5) p6_convgate(lds, P, l);
            else { pg8::Gemm g{(const bf16_t*)(P.ws + WS_RB), (const bf16_t*)(P.ws + WS_WDN) + (size_t)l * DM * DFF, M, DM, DFF}; pg8::StaticOrder S; S.init(M, DM, G, (int)blockIdx.x);
                pg8::EpiResid E{X, XB, xsq}; pg8::gemm_phase(ring, red, g, S, E); }
        }
        if (ph + 1 < hi) xcd_barrier(bar);
    }
}

extern "C" void kernel_launch(void* const* d_in, const int* in_sizes, int n_in, void* d_out, int out_size, void* d_ws, size_t ws_size, hipStream_t stream) {
    static int grid = 0;
    if (grid == 0) {
        if (n_in != 21 || out_size != (int)O_END || ws_size < WS_END) { fprintf(stderr, "kernel_launch: unexpected shapes: n_in %d out %d ws %zu (need %zu)\n", n_in, out_size, ws_size, (size_t)WS_END); grid = -1; return; }
        int dev = 0, cus = 0, per_cu = 0;
        if (hipGetDevice(&dev) != hipSuccess || hipDeviceGetAttribute(&cus, hipDeviceAttributeMultiprocessorCount, dev) != hipSuccess) { grid = -1; return; }
        if (hipFuncSetAttribute((const void*)mk_fwd, hipFuncAttributeMaxDynamicSharedMemorySize, LDS_BYTES) != hipSuccess) { fprintf(stderr, "kernel_launch: hipFuncSetAttribute failed\n"); grid = -1; return; }
        if (hipOccupancyMaxActiveBlocksPerMultiprocessor(&per_cu, (const void*)mk_fwd, 512, LDS_BYTES) != hipSuccess || per_cu < 1) { fprintf(stderr, "kernel_launch: occupancy query says %d blocks/CU\n", per_cu); per_cu = 1; }
        (void)hipGetLastError();
        grid = cus;
    }
    if (grid < 0) return;
    (void)hipMemsetAsync((char*)d_ws + WS_CTL, 0, CTL_ZERO_BYTES, stream);
    Args a{};
    for (int i = 0; i < 21; ++i) a.in[i] = (const float*)d_in[i];
    a.out = (float*)d_out; a.ws = (unsigned char*)d_ws;
#if MK_ONE_LAUNCH
    a.ph_lo = 0; a.ph_hi = NPH;
    void* kargs[] = {&a};
    hipError_t e = hipLaunchCooperativeKernel((const void*)mk_fwd, dim3(grid), dim3(512), kargs, LDS_BYTES, stream);
    if (e != hipSuccess) fprintf(stderr, "kernel_launch: cooperative launch failed: %s\n", hipGetErrorString(e));
#else
    for (int ph = 0; ph < NPH; ++ph) { a.ph_lo = ph; a.ph_hi = ph + 1; hipLaunchKernelGGL(mk_fwd, dim3(grid), dim3(512), LDS_BYTES, stream, a); }
#endif
}
```

```cpp
#include <hip/hip_runtime.h>
#include <cstdio>
#include <cstdint>
#include <cstddef>

#ifndef MK_ONE_LAUNCH
#define MK_ONE_LAUNCH 1
#endif

#define LAS __attribute__((address_space(3)))
#define GAS __attribute__((address_space(1)))
typedef unsigned short bf16_t;
typedef short bf16x8 __attribute__((ext_vector_type(8)));
typedef short s16x4 __attribute__((ext_vector_type(4)));
typedef float f32x2 __attribute__((ext_vector_type(2)));
typedef float f32x4 __attribute__((ext_vector_type(4)));
typedef float f32x16 __attribute__((ext_vector_type(16)));
typedef unsigned u32x2 __attribute__((ext_vector_type(2)));
typedef unsigned u32x4 __attribute__((ext_vector_type(4)));
typedef __bf16 bf16x2_t __attribute__((ext_vector_type(2)));

constexpr int DM = 1024, NB = 2, SEQ = 8192, DEPTH = 4, SB = 128, ST = 8, WIN = 128;
constexpr int MP = NB * SEQ, MS = SB * ST, M = MP + MS;
constexpr int NIN = 5120, C_Q = 0, C_K = 1024, C_V = 1280, C_GU = 1536, C_GV = 2304, C_GA = 3072, C_GB = 4096;
constexpr int KM = 1792, NUP = 5632, DFF = 2816, GW = 768;
constexpr float EPS = 1e-5f, LOG2E = 1.4426950408889634f, C2 = 0.125f * 1.4426950408889634f, NEGBIG = -1e30f;
#ifndef MK_NWORKERS
#define MK_NWORKERS 24
#endif
constexpr int NPH = 26, NWORKERS = MK_NWORKERS;

constexpr size_t O_Y = 0, O_WKP = 17825792, O_WVP = 18087936, O_CVP = 18350080, O_WKS = 18440192, O_WVS = 35217408, O_CVS = 51994624, O_GVS = 57761792, O_END = 60907520;

constexpr size_t MiB = 1u << 20;
constexpr size_t WS_CTL = 0, CTL_ZERO_BYTES = 64 * 1024, WS_XSQ = 1 * MiB  , WS_GVST = 2 * MiB + 512 * 1024, WS_WSB = 5 * MiB, WS_WIN = 8 * MiB, WS_WM = 48 * MiB, WS_WOUT = 62 * MiB,
                 WS_WUP = 70 * MiB, WS_WDN = 114 * MiB, WS_XB = 136 * MiB, WS_RA = 170 * MiB, WS_RB = 357 * MiB, WS_MG = WS_RB + 60 * MiB, WS_END = 451 * MiB;
static_assert((size_t)M * NUP * 2 <= WS_RB - WS_RA && (size_t)M * DFF * 2 <= WS_END - WS_RB && (size_t)M * KM * 2 <= 60 * MiB && WS_MG + (size_t)M * DM * 2 <= WS_END, "ws map");

constexpr int RING_OFF = 0, RING_BYTES = 131072, RED_OFF = RING_BYTES, RED_BYTES = 20480, LDSCTL_OFF = RED_OFF + RED_BYTES, MISC_OFF = LDSCTL_OFF + 320, LDS_BYTES = 155648;

__device__ __forceinline__ unsigned cvtpk(float lo, float hi) { f32x2 v = {lo, hi}; bf16x2_t b = __builtin_convertvector(v, bf16x2_t); return __builtin_bit_cast(unsigned, b); }
__device__ __forceinline__ float bflo(unsigned u) { return __uint_as_float(u << 16); }
__device__ __forceinline__ float bfhi(unsigned u) { return __uint_as_float(u & 0xffff0000u); }
__device__ __forceinline__ float gelu_t(float x) { const float t = x * (-2.302208198f + -0.1029432398f * x * x); return x * __builtin_amdgcn_rcpf(1.0f + __builtin_amdgcn_exp2f(t)); }
__device__ __forceinline__ float sigm(float x) { return __builtin_amdgcn_rcpf(1.0f + __builtin_amdgcn_exp2f(-LOG2E * x)); }
__device__ __forceinline__ int crow(int r, int hi) { return (r & 3) + 8 * (r >> 2) + 4 * hi; }
template <int MASK> __device__ __forceinline__ float xadd(float v) {
    if constexpr (MASK == 32) { auto rr = __builtin_amdgcn_permlane32_swap(__float_as_uint(v), __float_as_uint(v), false, false); return __uint_as_float(rr[0]) + __uint_as_float(rr[1]); }
    else return v + __int_as_float(__builtin_amdgcn_ds_swizzle(__float_as_int(v), (MASK << 10) | 0x1f));
}
__device__ __forceinline__ int tid_from_wave(int s_wave) { int lane; asm volatile("v_mbcnt_lo_u32_b32 %0, -1, 0\n\tv_mbcnt_hi_u32_b32 %0, -1, %0" : "=v"(lane)); return s_wave * 64 + lane; }

namespace pg8 {
#define PG8_LAS __attribute__((address_space(3)))
constexpr int BM = 256, BK = 64, HALF = 128, HTB = HALF * BK * 2  , STAGE_BYTES = 8 * HTB, NXCD = 8, WGM = 8;
__host__ __device__ __forceinline__ int lds_byte(int r, int c) { const int st = (r >> 4) * 2 + (c >> 5), rr = r & 15, cc = c & 31, ob = rr * 64 + cc * 2; return st * 1024 + (ob ^ (((ob >> 9) & 1) << 5)); }
__host__ __device__ __forceinline__ void stage_rc(int b, int& R, int& C) { const int st = b / 1024, sb = b % 1024, swz = sb ^ (((sb >> 9) & 1) << 5); R = (st >> 1) * 16 + swz / 64; C = (st & 1) * 32 + (swz % 64) / 2; }
__host__ __device__ __forceinline__ int perm32(int rho) { const int n = rho >> 4, i = rho & 15; return 8 * (i >> 2) + 4 * n + (i & 3); }

struct Unit { int pm, pn; };
struct Gemm { const bf16_t* A; const bf16_t* Bt; int M, N, K; };
struct StaticOrder {
    int nM, nN, nwg, G, c;
    __host__ __device__ void init(int M_, int N_, int G_, int c_) { nM = M_ / BM; nN = N_ / BM; nwg = nM * nN; G = G_; c = c_; }
    __host__ __device__ bool next(int i, Unit& u) const {
        const long L = (long)i * G + c; if (L >= nwg) return false;
        int wgid = (int)L; { const int q = nwg / NXCD, r = nwg % NXCD, xcd = wgid % NXCD, off = wgid / NXCD; wgid = (xcd < r ? xcd * (q + 1) : r * (q + 1) + (xcd - r) * q) + off; }
        const int nig = WGM * nN, gid = wgid / nig, fm = gid * WGM, gsz = (nM - fm) < WGM ? (nM - fm) : WGM;
        u.pm = fm + ((wgid % nig) % gsz); u.pn = (wgid % nig) / gsz; return true;
    }
};


struct RsPf { f32x4 a, b; };
__device__ __forceinline__ void rs_issue(RsPf& p, const float* xsq, int pm, int tid) { const float* q = xsq + (size_t)(pm * BM + (tid >> 1)) * 16 + 8 * (tid & 1); p.a = *(const f32x4*)q; p.b = *(const f32x4*)(q + 4); }
__device__ __forceinline__ void rs_write(const RsPf& p, PG8_LAS float* R, int tid) {
    float s = ((p.a[0] + p.a[1]) + (p.a[2] + p.a[3])) + ((p.b[0] + p.b[1]) + (p.b[2] + p.b[3])); s = xadd<1>(s);
    if ((tid & 1) == 0) R[tid >> 1] = __builtin_amdgcn_rsqf(s * (1.0f / DM) + EPS);
}
struct EpiAct {
    static constexpr bool PERM = true, IDEMP = true; static constexpr int MID_T = -1;
    bf16_t* O; int ldc; const float* xsq; float* gvst; int mode;
    __device__ __forceinline__ void mid(f32x4 (&)[2][2][4][2], const Unit&, int, int, int, int) const {}
    template <int KIND> __device__ __forceinline__ void body(const f32x4 (&acc)[2][2][4][2], const Unit& u, int wr, int wc, int fr, int fq, const PG8_LAS float* R) const {
        const int row0 = u.pm * BM + wr * 64 + fr, col0 = u.pn * BM + wc * 32 + 8 * fq;
#pragma unroll
        for (int ai = 0; ai < 2; ++ai)
#pragma unroll
            for (int m = 0; m < 4; ++m) {
                const int row = row0 + ai * HALF + m * 16;
                float rs = R[ai * HALF + wr * 64 + m * 16 + fr];
                if (KIND == 0) rs *= C2;
                float s1 = 0.f, s2 = 0.f;
                bf16_t* rowp = O + (size_t)row * ldc + col0;
                float v[2][8];
#pragma unroll
                for (int bj = 0; bj < 2; ++bj)
#pragma unroll
                    for (int e = 0; e < 8; ++e) { float x = acc[ai][bj][m][e >> 2][e & 3] * rs;
                        if (KIND == 2 || KIND == 3) x = gelu_t(x);
                        if (KIND == 4) x = fminf(1.0f + __builtin_amdgcn_exp2f(-LOG2E * x), 1e30f);
                        v[bj][e] = x; }
                if (KIND == 4) {
#pragma unroll
                    for (int e = 0; e < 8; ++e) { const float ta = v[0][e], tb = v[1][e]; v[0][e] = tb * __builtin_amdgcn_rcpf(ta); v[1][e] = __builtin_amdgcn_rcpf(tb); } }
#pragma unroll
                for (int bj = 0; bj < 2; ++bj) {
                    u32x4 w; w.x = cvtpk(v[bj][0], v[bj][1]); w.y = cvtpk(v[bj][2], v[bj][3]); w.z = cvtpk(v[bj][4], v[bj][5]); w.w = cvtpk(v[bj][6], v[bj][7]);
                    if (KIND == 3) {
#pragma unroll
                        for (int e = 0; e < 4; ++e) { const unsigned q = e == 0 ? w.x : e == 1 ? w.y : e == 2 ? w.z : w.w; const float a = bflo(q), b = bfhi(q); s1 += a + b; s2 += a * a + b * b; } }
                    *(u32x4*)(rowp + bj * HALF) = w;
                }
                if (KIND == 3) {
                    s1 = xadd<16>(s1); s1 = xadd<32>(s1); s2 = xadd<16>(s2); s2 = xadd<32>(s2);
                    if (fq == 0) *(f32x2*)(gvst + (size_t)row * 24 + ((u.pn - 9) * 4 + wc) * 2) = (f32x2){s1, s2};
                }
            }
    }
    static constexpr bool USES_R = true;
    __device__ __forceinline__ void prep(const Unit& u, PG8_LAS unsigned char* red, int tid) const { RsPf p; rs_issue(p, xsq, u.pm, tid); rs_write(p, (PG8_LAS float*)red, tid); }
    __device__ __forceinline__ void run(f32x4 (&acc)[2][2][4][2], const Unit& u, int wr, int wc, int fr, int fq, PG8_LAS unsigned char* red, int tid, const Unit* nxt, int par) const {
        asm volatile("" : "+v"(fr), "+v"(fq), "+v"(tid));
        const PG8_LAS float* R = (const PG8_LAS float*)red + par * 256;
        RsPf pf; rs_issue(pf, xsq, nxt ? nxt->pm : u.pm, tid);
        run2(acc, u, wr, wc, fr, fq, R);
        rs_write(pf, (PG8_LAS float*)red + (par ^ 1) * 256, tid);
    }
    __device__ __forceinline__ void run2(f32x4 (&acc)[2][2][4][2], const Unit& u, int wr, int wc, int fr, int fq, const PG8_LAS float* R) const {
        if (mode == 0) { body<1>(acc, u, wr, wc, fr, fq, R); return; }
        const int pn = u.pn;
        if (pn < 4) body<0>(acc, u, wr, wc, fr, fq, R);
        else if (pn < 6) body<1>(acc, u, wr, wc, fr, fq, R);
        else if (pn < 9) body<2>(acc, u, wr, wc, fr, fq, R);
        else if (pn < 12) body<3>(acc, u, wr, wc, fr, fq, R);
        else body<4>(acc, u, wr, wc, fr, fq, R);
    }
};

struct EpiMerge {
    static constexpr bool PERM = true, IDEMP = false; static constexpr int MID_T = 16;
    const bf16_t* Z; bf16_t* O;
    template <int WHICH> __device__ __forceinline__ void scale(f32x4 (&acc)[2][2][4][2], const Unit& u, int wr, int wc, int fr, int fq) const {
        asm volatile("" : "+v"(fr), "+v"(fq));
        const int row0 = u.pm * BM + wr * 64 + fr, gc0 = C_GA + 512 * u.pn + WHICH * 128 + wc * 32 + 8 * fq;
        u32x4 gt[2][4][2];
#pragma unroll
        for (int ai = 0; ai < 2; ++ai)
#pragma unroll
            for (int m = 0; m < 4; ++m) { const bf16_t* zr = Z + (size_t)(row0 + ai * HALF + m * 16) * NIN + gc0;
#pragma unroll
                for (int bj = 0; bj < 2; ++bj) gt[ai][m][bj] = *(const u32x4*)(zr + bj * 256); }
        __builtin_amdgcn_sched_barrier(0);
#pragma unroll
        for (int ai = 0; ai < 2; ++ai)
#pragma unroll
            for (int m = 0; m < 4; ++m)
#pragma unroll
                for (int bj = 0; bj < 2; ++bj) { const u32x4 a = gt[ai][m][bj];
#pragma unroll
                    for (int e = 0; e < 4; ++e) { const unsigned qa = e == 0 ? a.x : e == 1 ? a.y : e == 2 ? a.z : a.w;
                        acc[ai][bj][m][e >> 1][(e & 1) * 2] *= bflo(qa); acc[ai][bj][m][e >> 1][(e & 1) * 2 + 1] *= bfhi(qa); } }
    }
    __device__ __forceinline__ void mid(f32x4 (&acc)[2][2][4][2], const Unit& u, int wr, int wc, int fr, int fq) const { scale<0>(acc, u, wr, wc, fr, fq); }
    template <int WHICH> __device__ __forceinline__ void scalex(f32x4 (&accx)[2], const Unit& u, int wr, int wc, int fr, int fq) const {
        asm volatile("" : "+v"(fr), "+v"(fq));
        const u32x4 a = *(const u32x4*)(Z + (size_t)(MP + 16 * u.pm + fr) * NIN + C_GA + 512 * u.pn + 256 * wr + WHICH * 128 + wc * 32 + 8 * fq);
#pragma unroll
        for (int e = 0; e < 4; ++e) { const unsigned qa = e == 0 ? a.x : e == 1 ? a.y : e == 2 ? a.z : a.w; accx[e >> 1][(e & 1) * 2] *= bflo(qa); accx[e >> 1][(e & 1) * 2 + 1] *= bfhi(qa); }
    }
    __device__ __forceinline__ void midx(f32x4 (&accx)[2], const Unit& u, int wr, int wc, int fr, int fq) const { scalex<0>(accx, u, wr, wc, fr, fq); }
    __device__ __forceinline__ void runx(f32x4 (&accx)[2], const Unit& u, int wr, int wc, int fr, int fq, PG8_LAS unsigned char*, int) const {
        scalex<1>(accx, u, wr, wc, fr, fq);
        asm volatile("" : "+v"(fr), "+v"(fq));
        u32x4 w; w.x = cvtpk(accx[0][0], accx[0][1]); w.y = cvtpk(accx[0][2], accx[0][3]); w.z = cvtpk(accx[1][0], accx[1][1]); w.w = cvtpk(accx[1][2], accx[1][3]);
        *(u32x4*)(O + (size_t)(MP + 16 * u.pm + fr) * DM + u.pn * BM + 128 * wr + wc * 32 + 8 * fq) = w;
    }
    static constexpr bool USES_R = false;
    __device__ __forceinline__ void prep(const Unit&, PG8_LAS unsigned char*, int) const {}
    __device__ __forceinline__ void run(f32x4 (&acc)[2][2][4][2], const Unit& u, int wr, int wc, int fr, int fq, PG8_LAS unsigned char*, int, const Unit*, int) const {
        scale<1>(acc, u, wr, wc, fr, fq);
        asm volatile("" : "+v"(fr), "+v"(fq));
        const int row0 = u.pm * BM + wr * 64 + fr, col0 = u.pn * BM + wc * 32 + 8 * fq;
#pragma unroll
        for (int ai = 0; ai < 2; ++ai)
#pragma unroll
            for (int m = 0; m < 4; ++m) {
                const int row = row0 + ai * HALF + m * 16;
#pragma unroll
                for (int bj = 0; bj < 2; ++bj) {
                    u32x4 w; w.x = cvtpk(acc[ai][bj][m][0][0], acc[ai][bj][m][0][1]); w.y = cvtpk(acc[ai][bj][m][0][2], acc[ai][bj][m][0][3]);
                    w.z = cvtpk(acc[ai][bj][m][1][0], acc[ai][bj][m][1][1]); w.w = cvtpk(acc[ai][bj][m][1][2], acc[ai][bj][m][1][3]);
                    *(u32x4*)(O + (size_t)row * DM + col0 + bj * HALF) = w;
                }
            }
    }
};

struct EpiResid {
    static constexpr bool PERM = true, IDEMP = false; static constexpr int MID_T = -1;
    bf16_t* XB; float* xsq;
    __device__ __forceinline__ void mid(f32x4 (&)[2][2][4][2], const Unit&, int, int, int, int) const {}
    __device__ __forceinline__ void midx(f32x4 (&)[2], const Unit&, int, int, int, int) const {}
    __device__ __forceinline__ void runx(f32x4 (&accx)[2], const Unit& u, int wr, int wc, int fr, int fq, PG8_LAS unsigned char* red, int tid) const {
        asm volatile("" : "+v"(fr), "+v"(fq), "+v"(tid));
        const int row = MP + 16 * u.pm + fr; bf16_t* xr = XB + (size_t)row * DM + u.pn * BM + 128 * wr + wc * 32 + 8 * fq;
        const u32x4 o = *(const u32x4*)xr; u32x4 w; float ss = 0.f;
#pragma unroll
        for (int e = 0; e < 4; ++e) { const unsigned q = e == 0 ? o.x : e == 1 ? o.y : e == 2 ? o.z : o.w;
            const unsigned r = cvtpk(bflo(q) + accx[e >> 1][(e & 1) * 2], bfhi(q) + accx[e >> 1][(e & 1) * 2 + 1]);
            const float a = bflo(r), b = bfhi(r); ss += a * a + b * b;
            if (e == 0) w.x = r; else if (e == 1) w.y = r; else if (e == 2) w.z = r; else w.w = r; }
        *(u32x4*)xr = w;
        ss = xadd<16>(ss); ss = xadd<32>(ss);
        PG8_LAS float* RX = (PG8_LAS float*)(red + 4096);
        if (fq == 0) RX[(wr * 4 + wc) * 16 + fr] = ss;
        asm volatile("s_waitcnt lgkmcnt(0)" ::: "memory"); __builtin_amdgcn_s_barrier(); asm volatile("" ::: "memory");
        if (tid < 16) { float s = 0.f;
#pragma unroll
            for (int w8 = 0; w8 < 8; ++w8) s += RX[w8 * 16 + tid];
            xsq[(size_t)(MP + 16 * u.pm + tid) * 16 + u.pn] = s; }
    }
    static constexpr bool USES_R = false;
    __device__ __forceinline__ void prep(const Unit&, PG8_LAS unsigned char*, int) const {}
    __device__ __forceinline__ void run(f32x4 (&acc)[2][2][4][2], const Unit& u, int wr, int wc, int fr, int fq, PG8_LAS unsigned char*, int, const Unit*, int) const {
        asm volatile("" : "+v"(fr), "+v"(fq));
        const int row0 = u.pm * BM + wr * 64 + fr, col0 = u.pn * BM + wc * 32 + 8 * fq;
        u32x4 xo[2][4][2];
#pragma unroll
        for (int ai = 0; ai < 2; ++ai)
#pragma unroll
            for (int m = 0; m < 4; ++m)
#pragma unroll
                for (int bj = 0; bj < 2; ++bj) xo[ai][m][bj] = *(const u32x4*)(XB + (size_t)(row0 + ai * HALF + m * 16) * DM + col0 + bj * HALF);
        __builtin_amdgcn_sched_barrier(0);
#pragma unroll
        for (int ai = 0; ai < 2; ++ai)
#pragma unroll
            for (int m = 0; m < 4; ++m) {
                const int row = row0 + ai * HALF + m * 16;
                bf16_t* xr = XB + (size_t)row * DM + col0;
                float ss = 0.f;
#pragma unroll
                for (int bj = 0; bj < 2; ++bj) {
                    const u32x4 o = xo[ai][m][bj];
                    u32x4 w;
#pragma unroll
                    for (int e = 0; e < 4; ++e) { const unsigned q = e == 0 ? o.x : e == 1 ? o.y : e == 2 ? o.z : o.w;
                        const unsigned r = cvtpk(bflo(q) + acc[ai][bj][m][e >> 1][(e & 1) * 2], bfhi(q) + acc[ai][bj][m][e >> 1][(e & 1) * 2 + 1]);
                        const float a = bflo(r), b = bfhi(r); ss += a * a + b * b;
                        if (e == 0) w.x = r; else if (e == 1) w.y = r; else if (e == 2) w.z = r; else w.w = r; }
                    *(u32x4*)(xr + bj * HALF) = w;
                }
                ss = xadd<16>(ss); ss = xadd<32>(ss);
                if (fq == 0) xsq[(size_t)row * 16 + u.pn * 4 + wc] = ss;
            }
    }
};

template <int CTRL> __device__ __forceinline__ unsigned dppu(unsigned old, unsigned src) { return (unsigned)__builtin_amdgcn_update_dpp((int)old, (int)src, CTRL, 0xf, 0xf, false); }
template <int CTRL> __device__ __forceinline__ float dppf(float old, float src) { return __int_as_float(__builtin_amdgcn_update_dpp(__float_as_int(old), __float_as_int(src), CTRL, 0xf, 0xf, false)); }
#ifndef MK_DOT2
#define MK_DOT2 1
#endif
typedef __attribute__((ext_vector_type(2))) __bf16 bf16v2_t;
__device__ __forceinline__ float dot2bf(unsigned a, unsigned b, float c) { return __builtin_amdgcn_fdot2_f32_bf16(__builtin_bit_cast(bf16v2_t, a), __builtin_bit_cast(bf16v2_t, b), c, false); }
struct EpiUp {
    static constexpr bool PERM = true, IDEMP = true; static constexpr int MID_T = -1;
    unsigned char* ws; const float* cw; const float* cb; float* ocp;
    __device__ __forceinline__ void mid(f32x4 (&)[2][2][4][2], const Unit&, int, int, int, int) const {}
    static constexpr bool USES_R = true;
    __device__ __forceinline__ void stage_cw(int pn, PG8_LAS unsigned char* red, int tid, int par) const {
        if (tid < 256) { const int tp = __builtin_amdgcn_readfirstlane(tid >> 6), hb = (tid >> 5) & 1, c4 = (tid & 31) * 4; const float* srcw = (tp < 3 ? cw + tp * NUP : cb) + hb * DFF + 128 * pn + c4;
            __builtin_amdgcn_global_load_lds((const unsigned*)srcw, (PG8_LAS unsigned*)((PG8_LAS float*)(red + 12288) + par * 1024 + tp * 256), 16, 0, 0); }
    }
    __device__ __forceinline__ void prep(const Unit& u, PG8_LAS unsigned char* red, int tid) const { RsPf p; rs_issue(p, (const float*)(ws + WS_XSQ), u.pm, tid); stage_cw(u.pn, red, tid, 0); rs_write(p, (PG8_LAS float*)red, tid); }
    __device__ __forceinline__ void run(f32x4 (&acc)[2][2][4][2], const Unit& u, int wr, int wc, int fr, int fq, PG8_LAS unsigned char* red, int tid, const Unit* nxt, int par) const {
        asm volatile("" : "+v"(fr), "+v"(fq), "+v"(tid));
        const PG8_LAS float* R = (const PG8_LAS float*)red + par * 256;
        RsPf pf; rs_issue(pf, (const float*)(ws + WS_XSQ), nxt ? nxt->pm : u.pm, tid);
        run2(acc, u, wr, wc, fr, fq, red, R, tid, pf, true, (PG8_LAS float*)red + (par ^ 1) * 256, par);
        if (nxt) { int t2 = tid; asm volatile("" : "+v"(t2)); stage_cw(nxt->pn, red, t2, par ^ 1); }
    }
    __device__ __forceinline__ void run2(f32x4 (&acc)[2][2][4][2], const Unit& u, int wr, int wc, int fr, int fq, PG8_LAS unsigned char* red, const PG8_LAS float* R, int tid, const RsPf& pf, bool has_pf, PG8_LAS float* Rn, int par) const {
        bf16_t* const G = (bf16_t*)(ws + WS_RB); bf16_t* const Z2 = (bf16_t*)(ws + WS_RA); float* const HT = (float*)(ws + WS_RA);
        const int row0 = u.pm * BM + wr * 64 + fr, jc = 128 * u.pn + 32 * wc + 8 * fq;
        if (u.pm >= MP / BM) {
#pragma unroll
            for (int ai = 0; ai < 2; ++ai)
#pragma unroll
                for (int m = 0; m < 4; ++m) { const int row = row0 + ai * HALF + m * 16; const float rs = R[ai * HALF + wr * 64 + m * 16 + fr];
#pragma unroll
                    for (int bj = 0; bj < 2; ++bj) { u32x4 w; w.x = cvtpk(acc[ai][bj][m][0][0] * rs, acc[ai][bj][m][0][1] * rs); w.y = cvtpk(acc[ai][bj][m][0][2] * rs, acc[ai][bj][m][0][3] * rs);
                        w.z = cvtpk(acc[ai][bj][m][1][0] * rs, acc[ai][bj][m][1][1] * rs); w.w = cvtpk(acc[ai][bj][m][1][2] * rs, acc[ai][bj][m][1][3] * rs);
                        *(u32x4*)(Z2 + (size_t)row * NUP + bj * DFF + jc) = w; } }
            if (has_pf) rs_write(pf, Rn, tid);
            return;
        }
        const float rs3[2] = {R[wr * 64 + 48 + fr], R[HALF + wr * 64 + 48 + fr]}; const float rs00 = R[wr * 64 + fr];
        PG8_LAS float* H = (PG8_LAS float*)(red + 4096);
        const PG8_LAS float* CW = (const PG8_LAS float*)(red + 12288) + par * 1024;
        if (fr >= 14) {
#pragma unroll
            for (int ai = 0; ai < 2; ++ai)
#pragma unroll
                for (int bj = 0; bj < 2; ++bj)
#pragma unroll
                    for (int n = 0; n < 2; ++n) *(PG8_LAS f32x4*)(H + ((2 * ai + wr) * 2 + (fr - 14)) * 256 + bj * HALF + 32 * wc + 8 * fq + 4 * n) = acc[ai][bj][3][n] * rs3[ai];
        }
        if (has_pf) rs_write(pf, Rn, tid);
        asm volatile("s_waitcnt lgkmcnt(0)" ::: "memory"); __builtin_amdgcn_s_barrier(); asm volatile("" ::: "memory");
        if (fr >= 14 && wr == 1) {
            float* t = HT + ((size_t)u.pm * 4 + 2 + (fr - 14)) * NUP + jc;
#pragma unroll
            for (int bj = 0; bj < 2; ++bj)
#pragma unroll
                for (int n = 0; n < 2; ++n) *(f32x4*)(t + bj * DFF + 4 * n) = acc[1][bj][3][n] * rs3[1];
            if ((u.pm & 31) == 31) { float* o = ocp + ((size_t)(u.pm >> 5) * 2 + (fr - 14)) * NUP + jc;
#pragma unroll
                for (int bj = 0; bj < 2; ++bj)
#pragma unroll
                    for (int n = 0; n < 2; ++n) *(f32x4*)(o + bj * DFF + 4 * n) = acc[1][bj][3][n] * rs3[1]; }
        }
        if (fr < 2 && wr == 0) { float* t = HT + ((size_t)u.pm * 4 + fr) * NUP + jc;
#pragma unroll
            for (int bj = 0; bj < 2; ++bj)
#pragma unroll
                for (int n = 0; n < 2; ++n) *(f32x4*)(t + bj * DFF + 4 * n) = acc[0][bj][0][n] * rs00; }
        u32x2 zp[2][2][4][2];
#pragma unroll
        for (int ai = 0; ai < 2; ++ai)
#pragma unroll
            for (int m = 0; m < 4; ++m) { const float rs = R[ai * HALF + wr * 64 + m * 16 + fr];
#pragma unroll
                for (int bj = 0; bj < 2; ++bj)
#pragma unroll
                    for (int n = 0; n < 2; ++n) { zp[ai][bj][m][n].x = cvtpk(acc[ai][bj][m][n][0] * rs, acc[ai][bj][m][n][1] * rs); zp[ai][bj][m][n].y = cvtpk(acc[ai][bj][m][n][2] * rs, acc[ai][bj][m][n][3] * rs); } }
#if defined(MK_UP_MAIN_REPS)
        for (int mr_ = 0; mr_ < MK_UP_MAIN_REPS; ++mr_)
#endif
#pragma unroll
        for (int n = 0; n < 2; ++n) {
            f32x4 wa[3], wb[3], ba, bb;
#pragma unroll
            for (int j = 0; j < 3; ++j) { wa[j] = *(const PG8_LAS f32x4*)(CW + (j * 2 + 0) * 128 + 32 * wc + 8 * fq + 4 * n); wb[j] = *(const PG8_LAS f32x4*)(CW + (j * 2 + 1) * 128 + 32 * wc + 8 * fq + 4 * n); }
            ba = *(const PG8_LAS f32x4*)(CW + 6 * 128 + 32 * wc + 8 * fq + 4 * n); bb = *(const PG8_LAS f32x4*)(CW + 7 * 128 + 32 * wc + 8 * fq + 4 * n);
#if MK_DOT2
            unsigned wap[3][4], wbp[3][4];
#pragma unroll
            for (int j = 0; j < 3; ++j)
#pragma unroll
                for (int e = 0; e < 4; ++e) { wap[j][e] = (e & 1) ? cvtpk(0.f, wa[j][e]) : cvtpk(wa[j][e], 0.f); wbp[j][e] = (e & 1) ? cvtpk(0.f, wb[j][e]) : cvtpk(wb[j][e], 0.f); }
#endif
#pragma unroll
            for (int ai = 0; ai < 2; ++ai) {
                const int cid = 2 * ai + wr;
                u32x2 h1a = {0u, 0u}, h2a = h1a, h1b = h1a, h2b = h1a;
                if (cid > 0 && fr < 2) { const PG8_LAS float* hb = H + (cid - 1) * 512 + 32 * wc + 8 * fq + 4 * n;
                    const f32x4 x2a = *(const PG8_LAS f32x4*)(hb), x1a = *(const PG8_LAS f32x4*)(hb + 256), x2b = *(const PG8_LAS f32x4*)(hb + HALF), x1b = *(const PG8_LAS f32x4*)(hb + 256 + HALF);
                    h2a.x = cvtpk(x2a[0], x2a[1]); h2a.y = cvtpk(x2a[2], x2a[3]); h1a.x = cvtpk(x1a[0], x1a[1]); h1a.y = cvtpk(x1a[2], x1a[3]);
                    h2b.x = cvtpk(x2b[0], x2b[1]); h2b.y = cvtpk(x2b[2], x2b[3]); h1b.x = cvtpk(x1b[0], x1b[1]); h1b.y = cvtpk(x1b[2], x1b[3]); }
#pragma unroll
                for (int m = 0; m < 4; ++m) {
                    float g4[4];
#pragma unroll
                    for (int hx = 0; hx < 2; ++hx) {
                        const unsigned za = hx ? zp[ai][0][m][n].y : zp[ai][0][m][n].x, zb = hx ? zp[ai][1][m][n].y : zp[ai][1][m][n].x;
                        unsigned o1a, o2a, o1b, o2b;
                        if (m == 0) { const unsigned q1a = hx ? h1a.y : h1a.x, q2a = hx ? h2a.y : h2a.x, q1b = hx ? h1b.y : h1b.x, q2b = hx ? h2b.y : h2b.x; o1a = q1a; o1b = q1b; o2a = fr == 0 ? q2a : q1a; o2b = fr == 0 ? q2b : q1b; }
                        else { const unsigned pa = hx ? zp[ai][0][m - 1][n].y : zp[ai][0][m - 1][n].x, pb = hx ? zp[ai][1][m - 1][n].y : zp[ai][1][m - 1][n].x;
                            o1a = dppu<0x121>(pa, pa); o2a = dppu<0x122>(pa, pa); o1b = dppu<0x121>(pb, pb); o2b = dppu<0x122>(pb, pb); }
                        const unsigned p1a = dppu<0x111>(o1a, za), p2a = dppu<0x112>(o2a, za), p1b = dppu<0x111>(o1b, zb), p2b = dppu<0x112>(o2b, zb);
                        const int e0 = 2 * hx, e1 = 2 * hx + 1;
#if MK_DOT2
                        const float ca0 = dot2bf(za, wap[2][e0], dot2bf(p1a, wap[1][e0], dot2bf(p2a, wap[0][e0], ba[e0]))), cb0 = dot2bf(zb, wbp[2][e0], dot2bf(p1b, wbp[1][e0], dot2bf(p2b, wbp[0][e0], bb[e0])));
                        const float ca1 = dot2bf(za, wap[2][e1], dot2bf(p1a, wap[1][e1], dot2bf(p2a, wap[0][e1], ba[e1]))), cb1 = dot2bf(zb, wbp[2][e1], dot2bf(p1b, wbp[1][e1], dot2bf(p2b, wbp[0][e1], bb[e1])));
#else
                        const float ca0 = ba[e0] + wa[0][e0] * bflo(p2a) + wa[1][e0] * bflo(p1a) + wa[2][e0] * bflo(za), cb0 = bb[e0] + wb[0][e0] * bflo(p2b) + wb[1][e0] * bflo(p1b) + wb[2][e0] * bflo(zb);
                        const float ca1 = ba[e1] + wa[0][e1] * bfhi(p2a) + wa[1][e1] * bfhi(p1a) + wa[2][e1] * bfhi(za), cb1 = bb[e1] + wb[0][e1] * bfhi(p2b) + wb[1][e1] * bfhi(p1b) + wb[2][e1] * bfhi(zb);
#endif
                        g4[e0] = gelu_t(ca0) * cb0; g4[e1] = gelu_t(ca1) * cb1;
                    }
                    u32x2 w2; w2.x = cvtpk(g4[0], g4[1]); w2.y = cvtpk(g4[2], g4[3]);
                    { const bool deferred = (cid == 0) && (m == 0) && (fr < 2) && ((u.pm & 31) != 0);
                        if (!deferred) *(u32x2*)(G + (size_t)(row0 + ai * HALF + m * 16) * DFF + jc + 4 * n) = w2; }
                    __builtin_amdgcn_sched_barrier(0);
                }
            }
        }
    }
};

template <class Epi, class Sched>
__device__ __forceinline__ void gemm_phase(PG8_LAS unsigned char* lds, PG8_LAS unsigned char* red, const Gemm g, const Sched& S, const Epi& E, int s_wave) {
    int tid_ = tid_from_wave(s_wave); asm volatile("" : "+v"(tid_));
    const int tid = tid_, wid = __builtin_amdgcn_readfirstlane(tid >> 6), lane = tid & 63, wr = wid >> 2, wc = wid & 3, fr = lane & 15, fq = lane >> 4;
    const int K = g.K, nt = K / BK;
    unsigned voffA[2], voffB[2];
#pragma unroll
    for (int i = 0; i < 2; ++i) { int R, C; stage_rc(tid * 16 + i * 8192, R, C); const int Rb = Epi::PERM ? ((R & ~31) + perm32(R & 31)) : R;
        voffA[i] = (unsigned)(R * K + C) * 2u; voffB[i] = (unsigned)(Rb * K + C) * 2u; }
    const size_t kstep = (size_t)(BK * 2);
    const size_t hstep = (size_t)HALF * K * 2;
    const size_t tstep = 2 * hstep;
    const unsigned ldsw = (unsigned)wid * 1024u;
    const int aoff = lds_byte(wr * 64 + fr, fq * 8), boff = lds_byte(wc * 32 + fr, fq * 8);
#define PG8_SA(b, h) (((b) * 2 + (h)) * HTB)
#define PG8_SB(b, h) ((4 + (b) * 2 + (h)) * HTB)
#define PG8_STAGE(bufoff, gbase, voff) do { _Pragma("unroll") for (int _i = 0; _i < 2; ++_i) \
        __builtin_amdgcn_global_load_lds((const unsigned*)((const char*)(gbase) + (voff)[_i]), (PG8_LAS unsigned*)(lds + (bufoff) + ldsw + _i * 8192), 16, 0, 0); } while (0)
#define PG8_LDA(dst, b, h) do { _Pragma("unroll") for (int m = 0; m < 4; ++m) _Pragma("unroll") for (int k = 0; k < 2; ++k) dst[m][k] = *(const PG8_LAS bf16x8*)(lds + PG8_SA(b, h) + aoff + m * 2048 + k * 1024); } while (0)
#define PG8_LDB(dst, b, h) do { _Pragma("unroll") for (int n = 0; n < 2; ++n) _Pragma("unroll") for (int k = 0; k < 2; ++k) dst[n][k] = *(const PG8_LAS bf16x8*)(lds + PG8_SB(b, h) + boff + n * 2048 + k * 1024); } while (0)
#define PG8_MMA(ai, bj, At, Bt) do { __builtin_amdgcn_s_setprio(1); _Pragma("unroll") for (int m = 0; m < 4; ++m) _Pragma("unroll") for (int n = 0; n < 2; ++n) _Pragma("unroll") for (int k = 0; k < 2; ++k) \
        acc[ai][bj][m][n] = __builtin_amdgcn_mfma_f32_16x16x32_bf16(Bt[n][k], At[m][k], acc[ai][bj][m][n], 0, 0, 0); __builtin_amdgcn_s_setprio(0); } while (0)
#define PG8_WAIT_V(n) asm volatile("s_waitcnt vmcnt(" #n ")" ::: "memory")
#define PG8_WAIT_L(n) asm volatile("s_waitcnt lgkmcnt(" #n ")" ::: "memory")
#define PG8_BAR __builtin_amdgcn_s_barrier()
#define PG8_SCHED __builtin_amdgcn_sched_barrier(0)
#if defined(MK_DUP_KLOOP)
#define PG8_NEXT(i, u) (Epi::IDEMP ? S.next((i) >> 1, u) : S.next((i), u))
#define PG8_SKIP_EPI(i) (Epi::IDEMP && (((i) & 1) == 0))
#else
#define PG8_NEXT(i, u) S.next((i), u)
#define PG8_SKIP_EPI(i) false
#endif
    Unit cur, nxt; int ui = 0;
    if (!PG8_NEXT(0, cur)) return;
    if constexpr (Epi::USES_R) E.prep(cur, red, tid);
    f32x4 acc[2][2][4][2];
#pragma unroll
    for (int a = 0; a < 2; ++a)
#pragma unroll
        for (int b = 0; b < 2; ++b)
#pragma unroll
            for (int m = 0; m < 4; ++m)
#pragma unroll
                for (int n = 0; n < 2; ++n) acc[a][b][m][n] = (f32x4){0.f, 0.f, 0.f, 0.f};
    bf16x8 At[4][2], B0[2][2], B1[2][2];
    const char* cA = (const char*)g.A + (size_t)cur.pm * tstep; const char* cB = (const char*)g.Bt + (size_t)cur.pn * tstep;
    PG8_STAGE(PG8_SB(0, 0), cB, voffB); PG8_STAGE(PG8_SB(0, 1), cB + hstep, voffB); PG8_STAGE(PG8_SA(0, 0), cA, voffA); PG8_STAGE(PG8_SA(0, 1), cA + hstep, voffA);
    if (wr == 1) PG8_BAR;
    PG8_WAIT_V(2); PG8_BAR;
    PG8_STAGE(PG8_SB(1, 0), cB + kstep, voffB); PG8_STAGE(PG8_SA(1, 0), cA + kstep, voffA); PG8_STAGE(PG8_SB(1, 1), cB + hstep + kstep, voffB);
    PG8_WAIT_V(6); PG8_BAR;
    for (;;) {
        const bool has_next = PG8_NEXT(ui + 1, nxt);
        const char* nA = has_next ? (const char*)g.A + (size_t)nxt.pm * tstep : cA; const char* nB = has_next ? (const char*)g.Bt + (size_t)nxt.pn * tstep : cB;
        for (int t = 0; t < nt; t += 2) {
            const bool last = (t == nt - 2);
            const char* a1 = cA + (size_t)(t + 1) * kstep;
            const char* a2 = last ? nA : cA + (size_t)(t + 2) * kstep; const char* b2 = last ? nB : cB + (size_t)(t + 2) * kstep;
            const char* a3 = a2 + kstep; const char* b3 = b2 + kstep;
            if constexpr (Epi::MID_T >= 0) { if (t == Epi::MID_T) E.mid(acc, cur, wr, wc, fr, fq); }
            PG8_LDB(B0, 0, 0); PG8_LDB(B1, 0, 1); PG8_SCHED; PG8_LDA(At, 0, 0); PG8_STAGE(PG8_SA(1, 1), a1 + hstep, voffA);
            PG8_WAIT_V(8); PG8_WAIT_L(0); PG8_BAR; PG8_MMA(0, 0, At, B0); PG8_MMA(0, 1, At, B1); PG8_BAR; PG8_SCHED;
            PG8_LDA(At, 0, 1); PG8_STAGE(PG8_SB(0, 0), b2, voffB); PG8_STAGE(PG8_SB(0, 1), b2 + hstep, voffB); PG8_STAGE(PG8_SA(0, 0), a2, voffA);
            PG8_WAIT_V(8); PG8_WAIT_L(0); PG8_BAR; PG8_MMA(1, 0, At, B0); PG8_MMA(1, 1, At, B1); PG8_BAR; PG8_SCHED;
            PG8_LDB(B0, 1, 0); PG8_LDB(B1, 1, 1); PG8_SCHED; PG8_LDA(At, 1, 0); PG8_STAGE(PG8_SA(0, 1), a2 + hstep, voffA);
            PG8_WAIT_V(8); PG8_WAIT_L(0); PG8_BAR; PG8_MMA(0, 0, At, B0); PG8_MMA(0, 1, At, B1); PG8_BAR; PG8_SCHED;
            PG8_LDA(At, 1, 1); PG8_STAGE(PG8_SB(1, 0), b3, voffB); PG8_STAGE(PG8_SB(1, 1), b3 + hstep, voffB); PG8_STAGE(PG8_SA(1, 0), a3, voffA);
            PG8_WAIT_V(8); PG8_WAIT_L(0); PG8_BAR; PG8_MMA(1, 0, At, B0); PG8_MMA(1, 1, At, B1); PG8_BAR; PG8_SCHED;
        }
        if (wr == 0) PG8_BAR;
        if (!PG8_SKIP_EPI(ui)) E.run(acc, cur, wr, wc, fr, fq, red, tid, has_next ? &nxt : nullptr, ui & 1);
#if defined(MK_EPI_TWICE)
        if constexpr (Epi::MID_T < 0 && Epi::IDEMP) { for (int er_ = 1; er_ < MK_EPI_TWICE; ++er_) { asm volatile("s_waitcnt lgkmcnt(0)" ::: "memory"); __builtin_amdgcn_s_barrier(); E.run(acc, cur, wr, wc, fr, fq, red, tid, has_next ? &nxt : nullptr, ui & 1); } }
#endif
        if (!has_next) break;
#pragma unroll
        for (int a = 0; a < 2; ++a)
#pragma unroll
            for (int b = 0; b < 2; ++b)
#pragma unroll
                for (int m = 0; m < 4; ++m)
#pragma unroll
                    for (int n = 0; n < 2; ++n) acc[a][b][m][n] = (f32x4){0.f, 0.f, 0.f, 0.f};
        cur = nxt; cA = nA; cB = nB; ++ui;
        if (wr == 1) PG8_BAR;
    }
    PG8_WAIT_V(0);
    PG8_BAR;
#undef PG8_SA
#undef PG8_SB
#undef PG8_STAGE
#undef PG8_LDA
#undef PG8_LDB
#undef PG8_MMA
#undef PG8_WAIT_V
#undef PG8_WAIT_L
#undef PG8_BAR
#undef PG8_SCHED
}
template <class Epi>
__device__ __forceinline__ void gemm_phase_x(PG8_LAS unsigned char* lds, PG8_LAS unsigned char* red, const Gemm g, const Unit cur, const Epi& E, int s_wave) {
    int tid_ = tid_from_wave(s_wave); asm volatile("" : "+v"(tid_));
    const int tid = tid_, wid = __builtin_amdgcn_readfirstlane(tid >> 6), lane = tid & 63, wr = wid >> 2, wc = wid & 3, fr = lane & 15, fq = lane >> 4;
    const int K = g.K, nt = K / BK;
    unsigned voffA[2], voffB[2], voffX;
#pragma unroll
    for (int i = 0; i < 2; ++i) { int R, C; stage_rc(tid * 16 + i * 8192, R, C); const int Rb = Epi::PERM ? ((R & ~31) + perm32(R & 31)) : R;
        voffA[i] = (unsigned)(R * K + C) * 2u; voffB[i] = (unsigned)(Rb * K + C) * 2u; }
    { int R, C; stage_rc(tid * 4, R, C); voffX = (unsigned)(R * K + C) * 2u; }
    const size_t kstep = (size_t)(BK * 2);
    const size_t hstep = (size_t)HALF * K * 2;
    const size_t tstep = 2 * hstep;
    const unsigned ldsw = (unsigned)wid * 1024u;
    const int aoff = lds_byte(wr * 64 + fr, fq * 8), boff = lds_byte(wc * 32 + fr, fq * 8), xoff = lds_byte(fr, fq * 8);
    constexpr int XA_OFF = RING_BYTES + 4096;
#define PGX_SA(b, h) (((b) * 2 + (h)) * HTB)
#define PGX_SB(b, h) ((4 + (b) * 2 + (h)) * HTB)
#define PGX_STAGE(bufoff, gbase, voff) do { _Pragma("unroll") for (int _i = 0; _i < 2; ++_i) \
        __builtin_amdgcn_global_load_lds((const unsigned*)((const char*)(gbase) + (voff)[_i]), (PG8_LAS unsigned*)(lds + (bufoff) + ldsw + _i * 8192), 16, 0, 0); } while (0)
#define PGX_STAGEX(b, gbase) __builtin_amdgcn_global_load_lds((const unsigned*)((const char*)(gbase) + voffX), (PG8_LAS unsigned*)(lds + XA_OFF + (b) * 2048 + wid * 256), 4, 0, 0)
#define PGX_LDA(dst, b, h) do { _Pragma("unroll") for (int m = 0; m < 4; ++m) _Pragma("unroll") for (int k = 0; k < 2; ++k) dst[m][k] = *(const PG8_LAS bf16x8*)(lds + PGX_SA(b, h) + aoff + m * 2048 + k * 1024); } while (0)
#define PGX_LDB(dst, b, h) do { _Pragma("unroll") for (int n = 0; n < 2; ++n) _Pragma("unroll") for (int k = 0; k < 2; ++k) dst[n][k] = *(const PG8_LAS bf16x8*)(lds + PGX_SB(b, h) + boff + n * 2048 + k * 1024); } while (0)
#define PGX_LDX(dst, b) do { _Pragma("unroll") for (int k = 0; k < 2; ++k) dst[k] = *(const PG8_LAS bf16x8*)(lds + XA_OFF + (b) * 2048 + xoff + k * 1024); } while (0)
#define PGX_MMA(ai, bj, At, Bt) do { __builtin_amdgcn_s_setprio(1); _Pragma("unroll") for (int m = 0; m < 4; ++m) _Pragma("unroll") for (int n = 0; n < 2; ++n) _Pragma("unroll") for (int k = 0; k < 2; ++k) \
        acc[ai][bj][m][n] = __builtin_amdgcn_mfma_f32_16x16x32_bf16(Bt[n][k], At[m][k], acc[ai][bj][m][n], 0, 0, 0); __builtin_amdgcn_s_setprio(0); } while (0)
#define PGX_MMAX(Bt) do { _Pragma("unroll") for (int n = 0; n < 2; ++n) _Pragma("unroll") for (int k = 0; k < 2; ++k) accx[n] = __builtin_amdgcn_mfma_f32_16x16x32_bf16(Bt[n][k], Xt[k], accx[n], 0, 0, 0); } while (0)
#define PGX_WAIT_V(n) asm volatile("s_waitcnt vmcnt(" #n ")" ::: "memory")
#define PGX_WAIT_L(n) asm volatile("s_waitcnt lgkmcnt(" #n ")" ::: "memory")
#define PGX_BAR __builtin_amdgcn_s_barrier()
#define PGX_SCHED __builtin_amdgcn_sched_barrier(0)
    f32x4 acc[2][2][4][2], accx[2];
#pragma unroll
    for (int a = 0; a < 2; ++a)
#pragma unroll
        for (int b = 0; b < 2; ++b)
#pragma unroll
            for (int m = 0; m < 4; ++m)
#pragma unroll
                for (int n = 0; n < 2; ++n) acc[a][b][m][n] = (f32x4){0.f, 0.f, 0.f, 0.f};
    accx[0] = (f32x4){0.f, 0.f, 0.f, 0.f}; accx[1] = (f32x4){0.f, 0.f, 0.f, 0.f};
    bf16x8 At[4][2], B0[2][2], B1[2][2], Xt[2];
    const char* cA = (const char*)g.A + (size_t)cur.pm * tstep; const char* cB = (const char*)g.Bt + (size_t)cur.pn * tstep;
    const char* cX = (const char*)g.A + (size_t)(MP + 16 * cur.pm) * K * 2;
    PGX_STAGEX(0, cX); PGX_STAGE(PGX_SB(0, 0), cB, voffB); PGX_STAGE(PGX_SB(0, 1), cB + hstep, voffB); PGX_STAGE(PGX_SA(0, 0), cA, voffA); PGX_STAGE(PGX_SA(0, 1), cA + hstep, voffA);
    if (wr == 1) PGX_BAR;
    PGX_WAIT_V(2); PGX_BAR;
    PGX_STAGEX(1, cX + kstep); PGX_STAGE(PGX_SB(1, 0), cB + kstep, voffB); PGX_STAGE(PGX_SA(1, 0), cA + kstep, voffA); PGX_STAGE(PGX_SB(1, 1), cB + hstep + kstep, voffB);
    PGX_WAIT_V(7); PGX_BAR;
    for (int t = 0; t < nt; t += 2) {
        const bool last = (t == nt - 2);
        const char* a1 = cA + (size_t)(t + 1) * kstep;
        const char* a2 = last ? cA : cA + (size_t)(t + 2) * kstep; const char* b2 = last ? cB : cB + (size_t)(t + 2) * kstep; const char* x2 = last ? cX : cX + (size_t)(t + 2) * kstep;
        const char* a3 = a2 + kstep; const char* b3 = b2 + kstep; const char* x3 = x2 + kstep;
        if constexpr (Epi::MID_T >= 0) { if (t == Epi::MID_T) { E.mid(acc, cur, wr, wc, fr, fq); E.midx(accx, cur, wr, wc, fr, fq); } }
        PGX_LDB(B0, 0, 0); PGX_LDB(B1, 0, 1); PGX_SCHED; PGX_LDA(At, 0, 0); PGX_LDX(Xt, 0); PGX_STAGE(PGX_SA(1, 1), a1 + hstep, voffA);
        PGX_WAIT_V(9); PGX_WAIT_L(0); PGX_BAR; PGX_MMA(0, 0, At, B0); PGX_MMA(0, 1, At, B1); if (wr == 0) PGX_MMAX(B0); else PGX_MMAX(B1); PGX_BAR; PGX_SCHED;
        PGX_LDA(At, 0, 1); PGX_STAGEX(0, x2); PGX_STAGE(PGX_SB(0, 0), b2, voffB); PGX_STAGE(PGX_SB(0, 1), b2 + hstep, voffB); PGX_STAGE(PGX_SA(0, 0), a2, voffA);
        PGX_WAIT_V(9); PGX_WAIT_L(0); PGX_BAR; PGX_MMA(1, 0, At, B0); PGX_MMA(1, 1, At, B1); PGX_BAR; PGX_SCHED;
        PGX_LDB(B0, 1, 0); PGX_LDB(B1, 1, 1); PGX_SCHED; PGX_LDA(At, 1, 0); PGX_LDX(Xt, 1); PGX_STAGE(PGX_SA(0, 1), a2 + hstep, voffA);
        PGX_WAIT_V(9); PGX_WAIT_L(0); PGX_BAR; PGX_MMA(0, 0, At, B0); PGX_MMA(0, 1, At, B1); if (wr == 0) PGX_MMAX(B0); else PGX_MMAX(B1); PGX_BAR; PGX_SCHED;
        PGX_LDA(At, 1, 1); PGX_STAGEX(1, x3); PGX_STAGE(PGX_SB(1, 0), b3, voffB); PGX_STAGE(PGX_SB(1, 1), b3 + hstep, voffB); PGX_STAGE(PGX_SA(1, 0), a3, voffA);
        PGX_WAIT_V(9); PGX_WAIT_L(0); PGX_BAR; PGX_MMA(1, 0, At, B0); PGX_MMA(1, 1, At, B1); PGX_BAR; PGX_SCHED;
    }
    if (wr == 0) PGX_BAR;
    PGX_WAIT_V(0); PGX_BAR;
    E.run(acc, cur, wr, wc, fr, fq, red, tid, nullptr, 0);
    E.runx(accx, cur, wr, wc, fr, fq, red, tid);
    PGX_BAR;
#undef PGX_SA
#undef PGX_SB
#undef PGX_STAGE
#undef PGX_STAGEX
#undef PGX_LDA
#undef PGX_LDB
#undef PGX_LDX
#undef PGX_MMA
#undef PGX_MMAX
#undef PGX_WAIT_V
#undef PGX_WAIT_L
#undef PGX_BAR
#undef PGX_SCHED
}
}

typedef GAS unsigned gu32;
#define RLX_AGENT __ATOMIC_RELAXED, __HIP_MEMORY_SCOPE_AGENT
#define LDS_WAIT() asm volatile("s_waitcnt lgkmcnt(0)" ::: "memory")
#define VM_WAIT() asm volatile("s_waitcnt vmcnt(0)" ::: "memory")

#define XB_TMO      128
#define XB_XCNT(j)  (256  + 64 * (j))
#define XB_XSUB(j)  (1280 + 64 * (j))
#define XB_XGEN(j)  (2304 + 64 * (j))
#define XB_TOP      3328
#define XB_TOPGEN   3392
#define XCD_BAR_WORDS 3456
#define XB_SPIN_CAP (1u << 18)
__device__ __forceinline__ unsigned xb_ld(unsigned* p)              { return __hip_atomic_load(p, __ATOMIC_RELAXED, __HIP_MEMORY_SCOPE_AGENT); }
__device__ __forceinline__ unsigned xb_add(unsigned* p, unsigned v) { return __hip_atomic_fetch_add(p, v, __ATOMIC_RELAXED, __HIP_MEMORY_SCOPE_AGENT); }
__device__ __forceinline__ unsigned xb_xcc_id() { return (unsigned)__builtin_amdgcn_s_getreg((3 << 11) | 20) & 0xFu; }
#define XB_SPIN(cond, bar) do { unsigned _sp = 0; while (cond) { __builtin_amdgcn_s_sleep(1); \
    if ((++_sp & 255u) == 0u) { if (xb_ld(&(bar)[XB_TMO])) break; if (_sp > XB_SPIN_CAP) { atomicAdd(&(bar)[XB_TMO], 1u); break; } } } } while (0)
struct XcdBarrier { unsigned* bar; unsigned x; volatile LAS unsigned* st; };
__device__ __forceinline__ XcdBarrier xcd_barrier_post(unsigned* bar, volatile LAS unsigned* st, bool leader) {
    XcdBarrier b; b.bar = bar; b.x = xb_xcc_id(); b.st = st;
    if (leader) (void)xb_add(&bar[XB_XCNT(b.x)], 1u);
    return b;
}
__device__ __forceinline__ void xcd_barrier_complete(unsigned* bar, unsigned x, unsigned& nloc, unsigned& nx) {
    const unsigned G = gridDim.x * gridDim.y * gridDim.z;
    unsigned sum, cnt, mine, sp = 0u;
    for (;;) {
        sum = 0u; cnt = 0u; mine = 0u;
#pragma unroll
        for (unsigned j = 0; j < 16; ++j) { const unsigned c = xb_ld(&bar[XB_XCNT(j)]); sum += c; cnt += (c > 0u) ? 1u : 0u; mine = (j == x) ? c : mine; }
        if (sum == G) break;
        __builtin_amdgcn_s_sleep(1);
        if ((++sp & 255u) == 0u) { if (xb_ld(&bar[XB_TMO])) break; if (sp > XB_SPIN_CAP) { atomicAdd(&bar[XB_TMO], 1u); break; } }
    }
    nloc = mine > 0u ? mine : 1u; nx = cnt > 0u ? cnt : 1u;
}
__device__ __forceinline__ void xcd_barrier(const XcdBarrier& b, bool leader) {
    asm volatile("s_waitcnt vmcnt(0)" ::: "memory");
    __syncthreads();
    if (leader) {
        unsigned* bar = b.bar;
        __builtin_amdgcn_s_waitcnt(0);
        unsigned nloc = b.st[0], nx = b.st[1];
        if (nloc == 0u) { xcd_barrier_complete(bar, b.x, nloc, nx); b.st[0] = nloc; b.st[1] = nx; }
        const unsigned old = xb_add(&bar[XB_XSUB(b.x)], 1u);
        const unsigned gen = old / nloc;
        if (old + 1u == (gen + 1u) * nloc) {
            __builtin_amdgcn_fence(__ATOMIC_RELEASE, "agent");
            asm volatile("s_waitcnt vmcnt(0)" ::: "memory");
            const unsigned og = xb_add(&bar[XB_TOP], 1u);
            const unsigned tg = og / nx;
            if (og + 1u == (tg + 1u) * nx) xb_add(&bar[XB_TOPGEN], 1u);
            else XB_SPIN(xb_ld(&bar[XB_TOPGEN]) == tg, bar);
            __builtin_amdgcn_fence(__ATOMIC_ACQUIRE, "agent");
            xb_add(&bar[XB_XGEN(b.x)], 1u);
            asm volatile("s_waitcnt vmcnt(0)" ::: "memory");
        } else {
            XB_SPIN(xb_ld(&bar[XB_XGEN(b.x)]) == gen, bar);
            __builtin_amdgcn_fence(__ATOMIC_ACQUIRE, "agent");
            asm volatile("s_waitcnt vmcnt(0)" ::: "memory");
        }
    }
    __syncthreads();
}

struct Frame { LAS unsigned char* lds; int tid, lane, wave, vcu, G; };
__device__ __forceinline__ Frame make_frame(LAS unsigned char* lds, int s_wave) {
    Frame F; F.lds = lds; int t = tid_from_wave(s_wave); asm volatile("" : "+v"(t)); F.tid = t; F.lane = t & 63; F.wave = __builtin_amdgcn_readfirstlane(t >> 6);
    F.G = gridDim.x; { const int bx = blockIdx.x; F.vcu = (F.G % 8 == 0) ? (bx % 8) * (F.G / 8) + bx / 8 : bx; }
    return F;
}

__device__ __forceinline__ float wave_sum(float v) {
    v = xadd<1>(v); v = xadd<2>(v); v = xadd<4>(v); v = xadd<8>(v); v = xadd<16>(v); v = xadd<32>(v);
    return v;
}

struct Ptrs {
    const float *xp, *xs, *ck, *cv, *sc, *nmix, *w_in, *sinks, *lng, *lnb, *gws, *gbs, *wpa, *wpb, *wout, *nffn, *wup, *cw, *cb, *wdn, *nfin;
    float* out; unsigned char* ws;
};

struct TItem { const float* W; bf16_t* WT; const float* gain; int N, ldt, col_off, k0, n0, n0d; };
__device__ __forceinline__ void titem_decode(const Ptrs& P, int it, TItem& t) {
    constexpr int I_IN = 16 * 160, I_PA = 16 * 32, I_PB = 12 * 32, I_OUT = 16 * 32, I_UP = 16 * 176, I_DN = 44 * 32, I_L = I_IN + I_PA + I_PB + I_OUT + I_UP + I_DN;
    const int l = it / I_L; int r = it % I_L; int remap = 0;
    if (r < I_IN) { t.W = P.w_in + (size_t)l * DM * NIN; t.N = NIN; t.WT = (bf16_t*)(P.ws + WS_WIN) + (size_t)l * NIN * DM; t.ldt = DM; t.col_off = 0; t.gain = P.nmix + l * DM; remap = 1; }
    else if ((r -= I_IN) < I_PA) { t.W = P.wpa + (size_t)l * DM * DM; t.N = DM; t.WT = (bf16_t*)(P.ws + WS_WM) + (size_t)l * DM * KM; t.ldt = KM; t.col_off = 0; t.gain = nullptr; }
    else if ((r -= I_PA) < I_PB) { t.W = P.wpb + (size_t)l * GW * DM; t.N = DM; t.WT = (bf16_t*)(P.ws + WS_WM) + (size_t)l * DM * KM; t.ldt = KM; t.col_off = 1024; t.gain = nullptr; }
    else if ((r -= I_PB) < I_OUT) { t.W = P.wout + (size_t)l * DM * DM; t.N = DM; t.WT = (bf16_t*)(P.ws + WS_WOUT) + (size_t)l * DM * DM; t.ldt = DM; t.col_off = 0; t.gain = nullptr; }
    else if ((r -= I_OUT) < I_UP) { t.W = P.wup + (size_t)l * DM * NUP; t.N = NUP; t.WT = (bf16_t*)(P.ws + WS_WUP) + (size_t)l * NUP * DM; t.ldt = DM; t.col_off = 0; t.gain = P.nffn + l * DM; remap = 2; }
    else { r -= I_UP; t.W = P.wdn + (size_t)l * DFF * DM; t.N = DM; t.WT = (bf16_t*)(P.ws + WS_WDN) + (size_t)l * DM * DFF; t.ldt = DFF; t.col_off = 0; t.gain = nullptr; }
    const int nblk = t.N / 32, kb = r / nblk, nb = r % nblk; t.k0 = 64 * kb; t.n0 = 32 * nb; t.n0d = t.n0;
    if (remap == 1 && t.n0 >= C_GA) { const int h = t.n0 >= C_GB, a = t.n0 - (h ? C_GB : C_GA); t.n0d = C_GA + 256 * (a >> 7) + 128 * h + (a & 127); }
    if (remap == 2) { const int h = t.n0 >= DFF, a = t.n0 - (h ? DFF : 0); t.n0d = 256 * (a >> 7) + 128 * h + (a & 127); }
}
__device__ __forceinline__ void titem_load(const TItem& t, f32x4 (&v)[8], int lane) {
    const float* p = t.W + (size_t)(t.k0 + (lane >> 3)) * t.N + t.n0 + (lane & 7) * 4;
#pragma unroll
#ifndef MK_WT_NT
#define MK_WT_NT 2
#endif
#if MK_WT_NT >= 1
    for (int i = 0; i < 8; ++i) v[i] = __builtin_nontemporal_load((const f32x4*)(p + (size_t)(8 * i) * t.N));
#else
    for (int i = 0; i < 8; ++i) v[i] = *(const f32x4*)(p + (size_t)(8 * i) * t.N);
#endif
}
__device__ __forceinline__ void titem_finish(const TItem& t, const f32x4 (&v)[8], LAS float* scr, int lane) {
#pragma unroll
    for (int i = 0; i < 8; ++i) { const int kk = 8 * i + (lane >> 3); const float gsc = t.gain ? t.gain[t.k0 + kk] : 1.0f; LAS float* s = scr + kk * 33 + (lane & 7) * 4;
        s[0] = v[i][0] * gsc; s[1] = v[i][1] * gsc; s[2] = v[i][2] * gsc; s[3] = v[i][3] * gsc; }
    LDS_WAIT(); asm volatile("" ::: "memory");
    const int c = lane & 7;
#pragma unroll
    for (int j = 0; j < 4; ++j) { const int n = (lane >> 3) + 8 * j; const LAS float* s = scr + (8 * c) * 33 + n;
        u32x4 o; o.x = cvtpk(s[0 * 33], s[1 * 33]); o.y = cvtpk(s[2 * 33], s[3 * 33]); o.z = cvtpk(s[4 * 33], s[5 * 33]); o.w = cvtpk(s[6 * 33], s[7 * 33]);
#if MK_WT_NT >= 2
        __builtin_nontemporal_store(o, (GAS u32x4*)(t.WT + (size_t)(t.n0d + n) * t.ldt + t.col_off + t.k0 + 8 * c)); }
#else
        *(GAS u32x4*)(t.WT + (size_t)(t.n0d + n) * t.ldt + t.col_off + t.k0 + 8 * c) = o; }
#endif
    LDS_WAIT(); asm volatile("" ::: "memory");
}
__device__ __forceinline__ void job_weights(const Ptrs& P, int l, LAS float* scr, int gw, int NGW, int lane) {
    constexpr int I_L = 8192; const int beg = l * I_L, end = beg + I_L;
    int it = beg + gw; TItem ta, tb; f32x4 va[8], vb[8];
    if (it < end) { titem_decode(P, it, ta); titem_load(ta, va, lane); }
    while (it < end) {
        const int it1 = it + NGW; if (it1 < end) { titem_decode(P, it1, tb); titem_load(tb, vb, lane); }
        titem_finish(ta, va, scr, lane);
        if (it1 >= end) break;
        const int it2 = it1 + NGW; if (it2 < end) { titem_decode(P, it2, ta); titem_load(ta, va, lane); }
        titem_finish(tb, vb, scr, lane);
        it = it2;
    }
}
__device__ __forceinline__ void job_cache_copy(const Ptrs& P, int l, int gt, int NT) {
    constexpr int PER = 7680, TOT = 2 * SB * PER;
    const float* ckl = P.ck + (size_t)l * SB * 32768; const float* cvl = P.cv + (size_t)l * SB * 32768; float* okl = P.out + O_WKS + (size_t)l * SB * 32768; float* ovl = P.out + O_WVS + (size_t)l * SB * 32768;
    for (int e0 = gt; e0 < TOT; e0 += 8 * NT) {
        f32x4 v[8];
#pragma unroll
        for (int q = 0; q < 8; ++q) { const int e = e0 + q * NT; if (e < TOT) { const int which = e >= SB * PER, r = which ? e - SB * PER : e, b = r / PER, o = r % PER; v[q] = *(const f32x4*)((which ? cvl : ckl) + (size_t)b * 32768 + 2048 + (size_t)o * 4); } }
#pragma unroll
        for (int q = 0; q < 8; ++q) { const int e = e0 + q * NT; if (e < TOT) { const int which = e >= SB * PER, r = which ? e - SB * PER : e, b = r / PER, o = r % PER; *(f32x4*)((which ? ovl : okl) + (size_t)b * 32768 + (size_t)o * 4) = v[q]; } }
    }
}

__device__ __forceinline__ void p0_prologue(LAS unsigned char* lds_, const Ptrs& P, int s_wave) {
    const Frame F = make_frame(lds_, s_wave);
    LAS float* scr = (LAS float*)(F.lds + RING_OFF + F.wave * 16384);
    const int gw = F.vcu * 8 + F.wave, NGW = F.G * 8;
    job_weights(P, 0, scr, gw, NGW, F.lane);
    { bf16_t* WSB = (bf16_t*)(P.ws + WS_WSB); const int gt = gw * 64 + F.lane, NT = NGW * 64;
      for (int e = gt; e < DEPTH * 6 * 128 * 64; e += NT) { const int s = (e & 63) * 2, t = (e >> 6) & 127; const f32x2 w = *(const f32x2*)(P.gws + (size_t)e * 2);
          *(unsigned*)(WSB + (size_t)e * 2) = cvtpk(s <= t ? w[0] : 0.f, s + 1 <= t ? w[1] : 0.f); } }
    { bf16_t* XB = (bf16_t*)(P.ws + WS_XB); float* xsq = (float*)(P.ws + WS_XSQ);
      for (int m0 = gw; m0 < M; m0 += 2 * NGW) {
          f32x4 v[2][4];
#pragma unroll
          for (int q = 0; q < 2; ++q) { const int m = m0 + q * NGW; if (m < M) { const float* src = m < MP ? P.xp + (size_t)m * DM : P.xs + (size_t)(m - MP) * DM;
#pragma unroll
              for (int j = 0; j < 4; ++j) v[q][j] = *(const f32x4*)(src + 4 * F.lane + 256 * j); } }
#pragma unroll
          for (int q = 0; q < 2; ++q) { const int m = m0 + q * NGW; if (m < M) { float s = 0.f;
#pragma unroll
              for (int j = 0; j < 4; ++j) { u32x2 w; w.x = cvtpk(v[q][j][0], v[q][j][1]); w.y = cvtpk(v[q][j][2], v[q][j][3]); *(u32x2*)(XB + (size_t)m * DM + 4 * F.lane + 256 * j) = w;
                  const float a = bflo(w.x), b = bfhi(w.x), c = bflo(w.y), d = bfhi(w.y); s += (a * a + b * b) + (c * c + d * d); }
              s = wave_sum(s);
              if (F.lane < 4) *(f32x4*)(xsq + (size_t)m * 16 + 4 * F.lane) = (f32x4){F.lane == 0 ? s : 0.f, 0.f, 0.f, 0.f}; } }
      } }
}
__device__ __forceinline__ void p1_workers(LAS unsigned char* lds_, const Ptrs& P, int l, int widx, int nworkers, int s_wave) {
    const Frame F = make_frame(lds_, s_wave);
    LAS float* scr = (LAS float*)(F.lds + RING_OFF + F.wave * 16384);
    if (l + 1 < DEPTH) job_weights(P, l + 1, scr, widx * 8 + F.wave, nworkers * 8, F.lane);
}

constexpr int AT_K = 0, AT_V = 24576, AT_BUF = 49152, AT_WS = 2 * AT_BUF, AT_OST = AT_WS + 2048;
constexpr int GM_VN = 0, GM_ST = 32768, GM_OST = 34816;
__device__ __forceinline__ f32x16 zero16() { float z = 0.f; asm volatile("" : "+v"(z)); f32x16 r;
#pragma unroll
    for (int i = 0; i < 16; ++i) r[i] = z;
    return r; }
__device__ __forceinline__ f32x16 mfma32(bf16x8 a, bf16x8 b, f32x16 c) { return __builtin_amdgcn_mfma_f32_32x32x16_bf16(a, b, c, 0, 0, 0); }
typedef short v4i16_t __attribute__((ext_vector_type(4)));
__device__ __forceinline__ s16x4 vtr(LAS const unsigned char* p) { return __builtin_bit_cast(s16x4, __builtin_amdgcn_ds_read_tr16_b64_v4i16((LAS v4i16_t*)p)); }
#define PK8(lo, hi) (bf16x8){lo[0], lo[1], lo[2], lo[3], hi[0], hi[1], hi[2], hi[3]}
__device__ __forceinline__ bf16x8 pack8(float a0, float a1, float a2, float a3, float a4, float a5, float a6, float a7) {
    u32x4 w; w.x = cvtpk(a0, a1); w.y = cvtpk(a2, a3); w.z = cvtpk(a4, a5); w.w = cvtpk(a6, a7); return __builtin_bit_cast(bf16x8, w); }

__device__ __forceinline__ float softmax5(f32x16 (&p)[5], float sink2) {
    float m = sink2;
#pragma unroll
    for (int j = 0; j < 5; ++j)
#pragma unroll
        for (int r = 0; r < 16; ++r) m = fmaxf(m, p[j][r]);
    { auto rr = __builtin_amdgcn_permlane32_swap(__float_as_uint(m), __float_as_uint(m), false, false); m = fmaxf(__uint_as_float(rr[0]), __uint_as_float(rr[1])); }
    float l = 0.f;
#pragma unroll
    for (int j = 0; j < 5; ++j)
#pragma unroll
        for (int r = 0; r < 16; ++r) { p[j][r] = __builtin_amdgcn_exp2f(p[j][r] - m); l += p[j][r]; }
    { auto rr = __builtin_amdgcn_permlane32_swap(__float_as_uint(l), __float_as_uint(l), false, false); l = __uint_as_float(rr[0]) + __uint_as_float(rr[1]); }
    return l + __builtin_amdgcn_exp2f(sink2 - m);
}

__device__ __forceinline__ void attn_prompt_load(const Frame& F, const bf16_t* Z, int U, int bo, bf16x8 (&qr)[4]) {
    LAS unsigned char* lds = F.lds + bo;
    const int b = U >> 9, kvh = (U >> 7) & 3, qb = U & 127;
    const int lane = F.lane, wid = F.wave, r32 = lane & 31, hi = lane >> 5, g = wid >> 1, rh = wid & 1;
    const int pos0 = 64 * qb - 128; const size_t rowb = (size_t)b * SEQ;
#pragma unroll
    for (int tl = 0; tl < 3; ++tl) {
        int pk = pos0 + 64 * tl + lane; pk = pk < 0 ? 0 : pk;
        __builtin_amdgcn_global_load_lds((const unsigned*)(Z + (rowb + pk) * NIN + C_K + kvh * 64 + wid * 8), (LAS unsigned*)(lds + AT_K + tl * 8192 + wid * 1024), 16, 0, 0);
        int pv = pos0 + 64 * tl + 16 * (wid & 3) + (lane >> 2); pv = pv < 0 ? 0 : pv;
        __builtin_amdgcn_global_load_lds((const unsigned*)(Z + (rowb + pv) * NIN + C_V + kvh * 64 + (wid >> 2) * 32 + (lane & 3) * 8), (LAS unsigned*)(lds + AT_V + tl * 8192 + wid * 1024), 16, 0, 0);
    }
    const size_t qrow = rowb + 64 * qb + 32 * rh + r32;
#pragma unroll
    for (int d0 = 0; d0 < 4; ++d0) qr[d0] = *(const bf16x8*)(Z + qrow * NIN + C_Q + (kvh * 4 + g) * 64 + d0 * 16 + hi * 8);
}
__device__ __forceinline__ void attn_prompt_compute(const Frame& F, bf16_t* OS, float* owk, float* owv, const float* sinks_l, int U, int bo, const bf16x8 (&qr)[4]) {
    LAS unsigned char* lds = F.lds + bo;
    const int b = U >> 9, kvh = (U >> 7) & 3, qb = U & 127;
    const int lane = F.lane, wid = F.wave, r32 = lane & 31, hi = lane >> 5, g = wid >> 1, rh = wid & 1;
    const int pos0 = 64 * qb - 128; const size_t rowb = (size_t)b * SEQ;
    f32x16 p[5];
    float ng_ = NEGBIG; asm volatile("" : "+v"(ng_));
#pragma unroll
    for (int j = 0; j < 5; ++j) {
        const int kbk = rh + j; LAS const unsigned char* kb = lds + AT_K + (kbk >> 1) * 8192 + hi * 1024 + ((kbk & 1) * 32 + r32) * 16;
        f32x16 a = zero16();
#pragma unroll
        for (int d0 = 0; d0 < 4; ++d0) a = mfma32(*(LAS const bf16x8*)(kb + d0 * 2048), qr[d0], a);
        p[j] = a;
    }
#pragma unroll
    for (int r = 0; r < 16; ++r) { const int cr = crow(r, hi); if (cr <= r32) p[0][r] = ng_; if (cr > r32) p[4][r] = ng_; }
    if (qb < 2) {
#pragma unroll
        for (int j = 0; j < 5; ++j)
#pragma unroll
            for (int r = 0; r < 16; ++r) if (pos0 + 32 * (rh + j) + crow(r, hi) < 0) p[j][r] = ng_;
    }
    const float l = softmax5(p, sinks_l[kvh * 4 + g] * LOG2E);
    f32x16 o0 = zero16(), o1 = zero16();
    const int vlane = ((lane >> 4) & 1) * 32 + (lane & 3) * 8 + (4 * hi + ((lane & 15) >> 2)) * 64;
#pragma unroll
    for (int j = 0; j < 5; ++j) {
        const int kbk = rh + j;
#pragma unroll
        for (int s = 0; s < 2; ++s) {
            const bf16x8 pa = pack8(p[j][8 * s + 0], p[j][8 * s + 1], p[j][8 * s + 2], p[j][8 * s + 3], p[j][8 * s + 4], p[j][8 * s + 5], p[j][8 * s + 6], p[j][8 * s + 7]);
            LAS const unsigned char* vb = lds + AT_V + (kbk >> 1) * 8192 + (2 * (kbk & 1) + s) * 1024 + vlane;
            { const s16x4 lo = vtr(vb), hh = vtr(vb + 512); o0 = mfma32(pa, PK8(lo, hh), o0); }
            { const s16x4 lo = vtr(vb + 4096), hh = vtr(vb + 4096 + 512); o1 = mfma32(pa, PK8(lo, hh), o1); }
        }
    }
    LAS float* wsf = (LAS float*)(F.lds + AT_WS) + wid * 64;
    if (hi == 0) wsf[r32] = l;
    LDS_WAIT();
    LAS bf16_t* stg = (LAS bf16_t*)(F.lds + AT_OST) + wid * 2048;
#pragma unroll
    for (int r = 0; r < 16; ++r) { const int orow = crow(r, hi); const float rl = __builtin_amdgcn_rcpf(wsf[orow]);
        stg[orow * 64 + r32] = (bf16_t)(cvtpk(o0[r] * rl, 0.f) & 0xffffu); stg[orow * 64 + 32 + r32] = (bf16_t)(cvtpk(o1[r] * rl, 0.f) & 0xffffu); }
    LDS_WAIT();
    bf16_t* Ow = OS + (rowb + 64 * qb + 32 * rh) * KM + (kvh * 4 + g) * 64;
#pragma unroll
    for (int i = 0; i < 4; ++i) { const int row = i * 8 + (lane >> 3), ch = lane & 7; const u32x4 v = *(LAS const u32x4*)(stg + row * 64 + ch * 8); *(u32x4*)(Ow + (size_t)row * KM + ch * 8) = v; }
    if (qb >= 126) {
        const int row = F.tid & 63, c = F.tid >> 6, j = 64 * (qb - 126) + row;
        const u32x4 kk = *(LAS const u32x4*)(lds + AT_K + 2 * 8192 + c * 1024 + row * 16);
        const u32x4 vv = *(LAS const u32x4*)(lds + AT_V + 2 * 8192 + (c >> 2) * 4096 + (row >> 4) * 1024 + (row & 15) * 64 + (c & 3) * 16);
        float* dk = owk + ((size_t)(b * WIN + j)) * 256 + kvh * 64 + c * 8; float* dv = owv + ((size_t)(b * WIN + j)) * 256 + kvh * 64 + c * 8;
        *(f32x4*)dk = (f32x4){bflo(kk.x), bfhi(kk.x), bflo(kk.y), bfhi(kk.y)}; *(f32x4*)(dk + 4) = (f32x4){bflo(kk.z), bfhi(kk.z), bflo(kk.w), bfhi(kk.w)};
        *(f32x4*)dv = (f32x4){bflo(vv.x), bfhi(vv.x), bflo(vv.y), bfhi(vv.y)}; *(f32x4*)(dv + 4) = (f32x4){bflo(vv.z), bfhi(vv.z), bflo(vv.w), bfhi(vv.w)};
    }
}

constexpr int SA_K = 0, SA_V = 32768, SA_WS = 65536, SA_OST = 65536 + 2048;
__device__ __forceinline__ void sample_stage_kv(const Frame& F, const float* ck, const float* cv, float* owk, float* owv, int b, int hp) {
    LAS unsigned char* lds = F.lds;
    f32x4 kx[4][2], vx[4][2];
#pragma unroll
    for (int q = 0; q < 4; ++q) { const int idx = F.tid + 512 * q, key = idx >> 4, hl = (idx >> 3) & 1, c = idx & 7;
        const size_t off = ((size_t)(b * WIN + key) * 4 + 2 * hp + hl) * 64 + c * 8;
        kx[q][0] = *(const f32x4*)(ck + off); kx[q][1] = *(const f32x4*)(ck + off + 4); vx[q][0] = *(const f32x4*)(cv + off); vx[q][1] = *(const f32x4*)(cv + off + 4); }
#pragma unroll
    for (int q = 0; q < 4; ++q) { const int idx = F.tid + 512 * q, key = idx >> 4, hl = (idx >> 3) & 1, c = idx & 7;
        u32x4 wk, wv; wk.x = cvtpk(kx[q][0][0], kx[q][0][1]); wk.y = cvtpk(kx[q][0][2], kx[q][0][3]); wk.z = cvtpk(kx[q][1][0], kx[q][1][1]); wk.w = cvtpk(kx[q][1][2], kx[q][1][3]);
        wv.x = cvtpk(vx[q][0][0], vx[q][0][1]); wv.y = cvtpk(vx[q][0][2], vx[q][0][3]); wv.z = cvtpk(vx[q][1][0], vx[q][1][1]); wv.w = cvtpk(vx[q][1][2], vx[q][1][3]);
        *(LAS u32x4*)(lds + SA_K + hl * 16384 + (key >> 6) * 8192 + c * 1024 + (key & 63) * 16) = wk;
        *(LAS u32x4*)(lds + SA_V + hl * 16384 + (key >> 6) * 8192 + (c >> 2) * 4096 + ((key & 63) >> 4) * 1024 + (key & 15) * 64 + (c & 3) * 16) = wv;
        if (key >= 8) {
            const size_t oo = ((size_t)(b * WIN + key - 8) * 4 + 2 * hp + hl) * 64 + c * 8;
            *(f32x4*)(owk + oo) = kx[q][0]; *(f32x4*)(owk + oo + 4) = kx[q][1]; *(f32x4*)(owv + oo) = vx[q][0]; *(f32x4*)(owv + oo + 4) = vx[q][1]; } }
}
__device__ __forceinline__ void attn_sample_wave(const Frame& F, const bf16_t* Z, bf16_t* OS, float* owk, float* owv, const float* sinks_l, int b, int kvh, int hl) {
    LAS unsigned char* lds = F.lds;
    const int lane = F.lane, wid = F.wave, r32 = lane & 31, hi = lane >> 5, g = r32 >> 3, qi = r32 & 7;
    const size_t qrow = (size_t)MP + b * 8 + qi;
    bf16x8 qr[4];
#pragma unroll
    for (int d0 = 0; d0 < 4; ++d0) qr[d0] = *(const bf16x8*)(Z + qrow * NIN + C_Q + (kvh * 4 + g) * 64 + d0 * 16 + hi * 8);
    f32x16 p[5];
    float ng_ = NEGBIG; asm volatile("" : "+v"(ng_));
#pragma unroll
    for (int j = 0; j < 4; ++j) {
        LAS const unsigned char* kb = lds + SA_K + hl * 16384 + (j >> 1) * 8192 + hi * 1024 + ((j & 1) * 32 + r32) * 16;
        f32x16 a = zero16();
#pragma unroll
        for (int d0 = 0; d0 < 4; ++d0) a = mfma32(*(LAS const bf16x8*)(kb + d0 * 2048), qr[d0], a);
        p[j] = a;
    }
    { const size_t krow = (size_t)MP + b * 8 + (r32 < 8 ? r32 : 7); f32x16 a = zero16();
#pragma unroll
      for (int d0 = 0; d0 < 4; ++d0) a = mfma32(*(const bf16x8*)(Z + krow * NIN + C_K + kvh * 64 + d0 * 16 + hi * 8), qr[d0], a);
      p[4] = a; }
#pragma unroll
    for (int r = 0; r < 16; ++r) { const int cr = crow(r, hi); if (cr <= qi) p[0][r] = ng_; if (cr > qi) p[4][r] = ng_; }
    const float l = softmax5(p, sinks_l[kvh * 4 + g] * LOG2E);
    f32x16 o0 = zero16(), o1 = zero16();
    const int vlane = ((lane >> 4) & 1) * 32 + (lane & 3) * 8 + (4 * hi + ((lane & 15) >> 2)) * 64;
#pragma unroll
    for (int j = 0; j < 4; ++j)
#pragma unroll
        for (int s = 0; s < 2; ++s) {
            const bf16x8 pa = pack8(p[j][8 * s + 0], p[j][8 * s + 1], p[j][8 * s + 2], p[j][8 * s + 3], p[j][8 * s + 4], p[j][8 * s + 5], p[j][8 * s + 6], p[j][8 * s + 7]);
            LAS const unsigned char* vb = lds + SA_V + hl * 16384 + (j >> 1) * 8192 + (2 * (j & 1) + s) * 1024 + vlane;
            { const s16x4 lo = vtr(vb), hh = vtr(vb + 512); o0 = mfma32(pa, PK8(lo, hh), o0); }
            { const s16x4 lo = vtr(vb + 4096), hh = vtr(vb + 4096 + 512); o1 = mfma32(pa, PK8(lo, hh), o1); }
        }
    { const bf16x8 pa = pack8(p[4][0], p[4][1], p[4][2], p[4][3], p[4][4], p[4][5], p[4][6], p[4][7]);
      const bf16_t* vp = Z + ((size_t)MP + b * 8 + 4 * hi) * NIN + C_V + kvh * 64 + r32;
      u32x4 x = {0u, 0u, 0u, 0u}, y = {0u, 0u, 0u, 0u};
      x.x = (unsigned)vp[0] | ((unsigned)vp[NIN] << 16); x.y = (unsigned)vp[2 * NIN] | ((unsigned)vp[3 * NIN] << 16);
      y.x = (unsigned)vp[32] | ((unsigned)vp[NIN + 32] << 16); y.y = (unsigned)vp[2 * NIN + 32] | ((unsigned)vp[3 * NIN + 32] << 16);
      o0 = mfma32(pa, __builtin_bit_cast(bf16x8, x), o0); o1 = mfma32(pa, __builtin_bit_cast(bf16x8, y), o1); }
    LAS float* wsf = (LAS float*)(lds + SA_WS) + wid * 64;
    if (hi == 0) wsf[r32] = l;
    LDS_WAIT();
    LAS bf16_t* stg = (LAS bf16_t*)(lds + SA_OST) + wid * 2048;
#pragma unroll
    for (int r = 0; r < 16; ++r) { const int orow = crow(r, hi); const float rl = __builtin_amdgcn_rcpf(wsf[orow]);
        stg[orow * 64 + r32] = (bf16_t)(cvtpk(o0[r] * rl, 0.f) & 0xffffu); stg[orow * 64 + 32 + r32] = (bf16_t)(cvtpk(o1[r] * rl, 0.f) & 0xffffu); }
    LDS_WAIT();
#pragma unroll
    for (int i = 0; i < 4; ++i) { const int row = i * 8 + (lane >> 3), ch = lane & 7; const u32x4 v = *(LAS const u32x4*)(stg + row * 64 + ch * 8);
        *(u32x4*)(OS + ((size_t)MP + b * 8 + (row & 7)) * KM + (kvh * 4 + (row >> 3)) * 64 + ch * 8) = v; }
    { const int i = lane >> 3, c = (lane & 7) * 8; const bf16_t* zr = Z + ((size_t)MP + b * 8 + i) * NIN + kvh * 64 + c;
      const u32x4 kk = *(const u32x4*)(zr + C_K), vv = *(const u32x4*)(zr + C_V);
      float* dk = owk + ((size_t)(b * WIN + 120 + i)) * 256 + kvh * 64 + c; float* dv = owv + ((size_t)(b * WIN + 120 + i)) * 256 + kvh * 64 + c;
      *(f32x4*)dk = (f32x4){bflo(kk.x), bfhi(kk.x), bflo(kk.y), bfhi(kk.y)}; *(f32x4*)(dk + 4) = (f32x4){bflo(kk.z), bfhi(kk.z), bflo(kk.w), bfhi(kk.w)};
      *(f32x4*)dv = (f32x4){bflo(vv.x), bfhi(vv.x), bflo(vv.y), bfhi(vv.y)}; *(f32x4*)(dv + 4) = (f32x4){bflo(vv.z), bfhi(vv.z), bflo(vv.w), bfhi(vv.w)}; }
}

__device__ __forceinline__ void gmlp_prompt_unit(const Frame& F, const bf16_t* Z, bf16_t* OS, const float* gvst, const float* lng, const float* lnb, const bf16_t* wsb_l, const float* bs_l, int b, int ch, int g) {
    LAS unsigned char* lds = F.lds;
    const int tid = F.tid, lane = F.lane, wid = F.wave, r32 = lane & 31, hi = lane >> 5, tb = wid >> 1, chh = wid & 1;
    const size_t R0 = (size_t)b * SEQ + 128 * ch;
    LAS f32x2* st = (LAS f32x2*)(lds + GM_ST);
    f32x4 sp[6];
    if (tid < 128) { const float* pp = gvst + (R0 + tid) * 24;
#pragma unroll
        for (int k = 0; k < 6; ++k) sp[k] = *(const f32x4*)(pp + 4 * k); }
    const int c8 = (tid & 15) * 8;
    u32x4 xg[4];
#pragma unroll
    for (int it = 0; it < 4; ++it) xg[it] = *(const u32x4*)(Z + (R0 + (tid >> 4) + 32 * it) * NIN + C_GV + 128 * g + c8);
    const f32x4 g0 = *(const f32x4*)(lng + 128 * g + c8), g1 = *(const f32x4*)(lng + 128 * g + c8 + 4), b0 = *(const f32x4*)(lnb + 128 * g + c8), b1 = *(const f32x4*)(lnb + 128 * g + c8 + 4);
    const int nks = 2 * (tb + 1);
    bf16x8 wf[8];
    { const bf16_t* wrow = wsb_l + ((size_t)g * 128 + 32 * tb + r32) * 128 + 8 * hi;
#pragma unroll
      for (int ks = 0; ks < 8; ++ks) if (ks < nks) wf[ks] = *(const bf16x8*)(wrow + 16 * ks); }
    u32x4 gu[4];
#pragma unroll
    for (int i = 0; i < 4; ++i) gu[i] = *(const u32x4*)(Z + (R0 + 32 * tb + i * 8 + (lane >> 3)) * NIN + C_GU + 128 * g + 64 * chh + (lane & 7) * 8);
    float bsv[16];
#pragma unroll
    for (int r = 0; r < 16; ++r) bsv[r] = bs_l[g * 128 + 32 * tb + crow(r, hi)];
    if (tid < 128) { float s1 = 0.f, s2 = 0.f;
#pragma unroll
        for (int k = 0; k < 6; ++k) { s1 += sp[k][0] + sp[k][2]; s2 += sp[k][1] + sp[k][3]; }
        const float mean = s1 * (1.0f / GW), var = fmaxf(s2 * (1.0f / GW) - mean * mean, 0.f); st[tid] = (f32x2){mean, __builtin_amdgcn_rsqf(var + EPS)}; }
    __syncthreads();
#pragma unroll
    for (int it = 0; it < 4; ++it) {
        const int s = (tid >> 4) + 32 * it; const u32x4 x = xg[it];
        const f32x2 ms = st[s];
        const float v0 = (bflo(x.x) - ms[0]) * ms[1] * g0[0] + b0[0], v1 = (bfhi(x.x) - ms[0]) * ms[1] * g0[1] + b0[1], v2 = (bflo(x.y) - ms[0]) * ms[1] * g0[2] + b0[2], v3 = (bfhi(x.y) - ms[0]) * ms[1] * g0[3] + b0[3];
        const float v4 = (bflo(x.z) - ms[0]) * ms[1] * g1[0] + b1[0], v5 = (bfhi(x.z) - ms[0]) * ms[1] * g1[1] + b1[1], v6 = (bflo(x.w) - ms[0]) * ms[1] * g1[2] + b1[2], v7 = (bfhi(x.w) - ms[0]) * ms[1] * g1[3] + b1[3];
        u32x4 w; w.x = cvtpk(v0, v1); w.y = cvtpk(v2, v3); w.z = cvtpk(v4, v5); w.w = cvtpk(v6, v7);
        *(LAS u32x4*)(lds + GM_VN + ((c8 >> 5) * 8 + (s >> 4)) * 1024 + (s & 15) * 64 + (c8 & 31) * 2) = w;
    }
    __syncthreads();
    f32x16 a0 = zero16(), a1 = zero16();
    const int vlane = ((lane >> 4) & 1) * 32 + (lane & 3) * 8 + (8 * hi + ((lane & 15) >> 2)) * 64;
#pragma unroll
    for (int ks = 0; ks < 8; ++ks) if (ks < nks) {
        LAS const unsigned char* vb = lds + GM_VN + ((2 * chh) * 8 + ks) * 1024 + vlane;
        { const s16x4 lo = vtr(vb), hh = vtr(vb + 256); a0 = mfma32(wf[ks], PK8(lo, hh), a0); }
        { const s16x4 lo = vtr(vb + 8192), hh = vtr(vb + 8192 + 256); a1 = mfma32(wf[ks], PK8(lo, hh), a1); }
    }
    LAS bf16_t* stg = (LAS bf16_t*)(lds + GM_OST) + wid * 2048;
#pragma unroll
    for (int r = 0; r < 16; ++r) { const int orow = crow(r, hi);
        stg[orow * 64 + r32] = (bf16_t)(cvtpk(a0[r] + bsv[r], 0.f) & 0xffffu); stg[orow * 64 + 32 + r32] = (bf16_t)(cvtpk(a1[r] + bsv[r], 0.f) & 0xffffu); }
    LDS_WAIT();
#pragma unroll
    for (int i = 0; i < 4; ++i) { const int row = i * 8 + (lane >> 3), cc = (lane & 7) * 8; const u32x4 mx = *(LAS const u32x4*)(stg + row * 64 + cc);
        const size_t grow = R0 + 32 * tb + row; const u32x4 q = gu[i];
        u32x4 w; w.x = cvtpk(bflo(mx.x) * bflo(q.x), bfhi(mx.x) * bfhi(q.x)); w.y = cvtpk(bflo(mx.y) * bflo(q.y), bfhi(mx.y) * bfhi(q.y));
        w.z = cvtpk(bflo(mx.z) * bflo(q.z), bfhi(mx.z) * bfhi(q.z)); w.w = cvtpk(bflo(mx.w) * bflo(q.w), bfhi(mx.w) * bfhi(q.w));
        *(u32x4*)(OS + grow * KM + 1024 + 128 * g + 64 * chh + cc) = w; }
}

__device__ __forceinline__ void gmlp_sample_wave(const Frame& F, const bf16_t* Z, bf16_t* OS, const float* gvst, const float* lng, const float* lnb, const float* gws_l, const float* bs_l, float* ogv, int b, int c0) {
    const int lane = F.lane; const size_t R0 = (size_t)MP + b * 8;
    const int c = c0 + lane, g = c0 >> 7;
    unsigned short xv[8], xu[8];
#pragma unroll
    for (int i = 0; i < 8; ++i) { xv[i] = Z[(R0 + i) * NIN + C_GV + c]; xu[i] = Z[(R0 + i) * NIN + C_GU + c]; }
    float mean = 0.f, rstd = 0.f;
    { const float* pp = gvst + (R0 + (lane & 7)) * 24; float s1 = 0.f, s2 = 0.f;
#pragma unroll
      for (int k = 0; k < 6; ++k) { const f32x4 v = *(const f32x4*)(pp + 4 * k); s1 += v[0] + v[2]; s2 += v[1] + v[3]; }
      mean = s1 * (1.0f / GW); const float var = fmaxf(s2 * (1.0f / GW) - mean * mean, 0.f); rstd = __builtin_amdgcn_rsqf(var + EPS); }
    const float gg = lng[c], bb = lnb[c];
    float vn[8];
#pragma unroll
    for (int i = 0; i < 8; ++i) { const float mu = __uint_as_float(__builtin_amdgcn_readlane(__float_as_uint(mean), i)), rs = __uint_as_float(__builtin_amdgcn_readlane(__float_as_uint(rstd), i)); vn[i] = (bflo((unsigned)xv[i]) - mu) * rs * gg + bb; ogv[((size_t)b * 8 + i) * GW + c] = vn[i]; }
#pragma unroll
    for (int t = 0; t < 8; ++t) { float mx = bs_l[g * 128 + t];
#pragma unroll
        for (int s = 0; s <= t; ++s) mx += gws_l[(size_t)g * 16384 + t * 128 + s] * vn[s];
        OS[(R0 + t) * KM + 1024 + c] = (bf16_t)(cvtpk(bflo((unsigned)xu[t]) * mx, 0.f) & 0xffffu); }
}

__device__ __forceinline__ void p2_mixer(LAS unsigned char* lds_, const Ptrs& P, int l, int s_wave) {
    const Frame F = make_frame(lds_, s_wave);
    const bf16_t* Z = (const bf16_t*)(P.ws + WS_RA); bf16_t* OS = (bf16_t*)(P.ws + WS_RB); const float* gvst = (const float*)(P.ws + WS_GVST);
    const bf16_t* wsb_l = (const bf16_t*)(P.ws + WS_WSB) + (size_t)l * 6 * 16384;
    const float* sinks_l = P.sinks + l * 16; const float* lng = P.lng + l * GW; const float* lnb = P.lnb + l * GW; const float* bs_l = P.gbs + l * GW; const float* gws_l = P.gws + (size_t)l * 6 * 16384;
    float* owkp = P.out + O_WKP + (size_t)l * NB * WIN * 256; float* owvp = P.out + O_WVP + (size_t)l * NB * WIN * 256;
    float* owks = P.out + O_WKS + (size_t)l * SB * WIN * 256; float* owvs = P.out + O_WVS + (size_t)l * SB * WIN * 256;
    const float* ck = P.ck + (size_t)l * SB * WIN * 256; const float* cv = P.cv + (size_t)l * SB * WIN * 256; float* ogv = P.out + O_GVS + (size_t)l * SB * 8 * GW;
    constexpr int NU = 1024 + 768 + 256;
#ifndef MK_P2_REPS
#define MK_P2_REPS 1
#define MK_P2_CLASS 0
#endif
    for (int prep_ = 0; prep_ < MK_P2_REPS; ++prep_) {
    if (prep_ == 0 || (MK_P2_CLASS & 1)) {
        int U = F.vcu, bo = 0; bf16x8 qc[4], qn[4];
        __syncthreads();
        if (U < 1024) attn_prompt_load(F, Z, U, bo, qc);
        while (U < 1024) {
            const int Un = U + F.G;
            VM_WAIT(); __syncthreads();
            if (Un < 1024) attn_prompt_load(F, Z, Un, bo ^ AT_BUF, qn);
            attn_prompt_compute(F, OS, owkp, owvp, sinks_l, U, bo, qc);
#pragma unroll
            for (int d0 = 0; d0 < 4; ++d0) qc[d0] = qn[d0];
            U = Un; bo ^= AT_BUF;
        }
    }
    for (int U = F.vcu + ((1024 - F.vcu + F.G - 1) / F.G) * F.G; U < NU; U += F.G) {
        if (prep_ > 0) { const int cls = U < 1792 ? 2 : 4; if (!(cls & MK_P2_CLASS)) continue; }
        __syncthreads();
        if (false) {}
        else if (U < 1792) { const int V = U - 1024; gmlp_prompt_unit(F, Z, OS, gvst, lng, lnb, wsb_l, bs_l, V / 384, (V / 6) % 64, V % 6); }
        else { const int V = U - 1792, b = V >> 1, hp = V & 1;
            sample_stage_kv(F, ck, cv, owks, owvs, b, hp);
            LDS_WAIT(); __syncthreads();
            if (F.wave < 2) attn_sample_wave(F, Z, OS, owks, owvs, sinks_l, b, 2 * hp + F.wave, F.wave);
            else gmlp_sample_wave(F, Z, OS, gvst, lng, lnb, gws_l, bs_l, ogv, b, 384 * hp + 64 * (F.wave - 2)); }
    }
    }
}

__device__ __forceinline__ void ld8(const bf16_t* p, float (&v)[8]) { const u32x4 x = *(const u32x4*)p; v[0] = bflo(x.x); v[1] = bfhi(x.x); v[2] = bflo(x.y); v[3] = bfhi(x.y); v[4] = bflo(x.z); v[5] = bfhi(x.z); v[6] = bflo(x.w); v[7] = bfhi(x.w); }
__device__ __forceinline__ void ld8f(const float* p, float (&v)[8]) { const f32x4 a = *(const f32x4*)p, b = *(const f32x4*)(p + 4); v[0] = a[0]; v[1] = a[1]; v[2] = a[2]; v[3] = a[3]; v[4] = b[0]; v[5] = b[1]; v[6] = b[2]; v[7] = b[3]; }
__device__ __forceinline__ void st8f(float* p, const float (&v)[8]) { *(f32x4*)p = (f32x4){v[0], v[1], v[2], v[3]}; *(f32x4*)(p + 4) = (f32x4){v[4], v[5], v[6], v[7]}; }
__device__ __forceinline__ void cv8(const u32x4 x, float (&v)[8]) { v[0] = bflo(x.x); v[1] = bfhi(x.x); v[2] = bflo(x.y); v[3] = bfhi(x.y); v[4] = bflo(x.z); v[5] = bfhi(x.z); v[6] = bflo(x.w); v[7] = bfhi(x.w); }
__device__ __forceinline__ u32x4 pk8f(const float* p) { const f32x4 a = *(const f32x4*)p, b = *(const f32x4*)(p + 4); u32x4 w; w.x = cvtpk(a[0], a[1]); w.y = cvtpk(a[2], a[3]); w.z = cvtpk(b[0], b[1]); w.w = cvtpk(b[2], b[3]); return w; }
__device__ __forceinline__ void p7_pre(LAS unsigned char* lds_, const Ptrs& P, int l, int pm_lo, int pm_hi, int s_wave) {
    const Frame F = make_frame(lds_, s_wave);
    const bf16_t* Z2 = (const bf16_t*)(P.ws + WS_RA); bf16_t* G = (bf16_t*)(P.ws + WS_RB); const float* HT = (const float*)(P.ws + WS_RA);
    const float* cw = P.cw + (size_t)l * 3 * NUP; const float* cb = P.cb + (size_t)l * NUP; const float* sc = P.sc + (size_t)l * SB * 2 * NUP;
    float* ocs = P.out + O_CVS + (size_t)l * SB * 2 * NUP;
    if (F.tid < 352) {
    const int c = F.tid * 8;
    float wa[3][8], wb[3][8], ba[8], bb[8];
#pragma unroll
    for (int j = 0; j < 3; ++j) { ld8f(cw + j * NUP + c, wa[j]); ld8f(cw + j * NUP + DFF + c, wb[j]); }
    ld8f(cb + c, ba); ld8f(cb + DFF + c, bb);
    for (int pm = pm_lo; pm < pm_hi; ++pm)
    for (int part = 0; part < 3; ++part) {
        if (part < 2) { const int U = 2 * pm + part;
            const int r0 = MP + U * 8;
            u32x4 ra[10], rb[10];
#pragma unroll
            for (int i = 2; i < 10; ++i) { ra[i] = *(const u32x4*)(Z2 + (size_t)(r0 + i - 2) * NUP + c); rb[i] = *(const u32x4*)(Z2 + (size_t)(r0 + i - 2) * NUP + DFF + c); }
            { const float* s0 = sc + (size_t)U * 2 * NUP; ra[0] = pk8f(s0 + c); ra[1] = pk8f(s0 + NUP + c); rb[0] = pk8f(s0 + DFF + c); rb[1] = pk8f(s0 + NUP + DFF + c); }
#pragma unroll
            for (int i = 2; i < 10; ++i) {
                float a2[8], a1[8], a0[8], b2[8], b1[8], b0[8], o[8];
                cv8(ra[i - 2], a2); cv8(ra[i - 1], a1); cv8(ra[i], a0); cv8(rb[i - 2], b2); cv8(rb[i - 1], b1); cv8(rb[i], b0);
#pragma unroll
                for (int e = 0; e < 8; ++e) { const float ca = ba[e] + wa[0][e] * a2[e] + wa[1][e] * a1[e] + wa[2][e] * a0[e], cbv = bb[e] + wb[0][e] * b2[e] + wb[1][e] * b1[e] + wb[2][e] * b0[e]; o[e] = gelu_t(ca) * cbv; }
                u32x4 w; w.x = cvtpk(o[0], o[1]); w.y = cvtpk(o[2], o[3]); w.z = cvtpk(o[4], o[5]); w.w = cvtpk(o[6], o[7]);
                *(u32x4*)(G + (size_t)(r0 + i - 2) * DFF + c) = w;
            }
            float* d = ocs + (size_t)U * 2 * NUP;
#pragma unroll
            for (int j = 0; j < 2; ++j) { float va[8], vb[8]; cv8(ra[8 + j], va); cv8(rb[8 + j], vb); st8f(d + j * NUP + c, va); st8f(d + j * NUP + DFF + c, vb); }
        } else if ((pm & 31) != 0) {
            float t0a[8], t1a[8], h0a[8], h1a[8], t0b[8], t1b[8], h0b[8], h1b[8];
            const float* tp = HT + ((size_t)(pm - 1) * 4 + 2) * NUP; const float* hp = HT + (size_t)pm * 4 * NUP;
            ld8f(tp + c, t0a); ld8f(tp + NUP + c, t1a); ld8f(hp + c, h0a); ld8f(hp + NUP + c, h1a);
            ld8f(tp + DFF + c, t0b); ld8f(tp + NUP + DFF + c, t1b); ld8f(hp + DFF + c, h0b); ld8f(hp + NUP + DFF + c, h1b);
            float o0[8], o1[8];
#pragma unroll
            for (int e = 0; e < 8; ++e) {
                const float ca0 = ba[e] + wa[0][e] * t0a[e] + wa[1][e] * t1a[e] + wa[2][e] * h0a[e], cb0 = bb[e] + wb[0][e] * t0b[e] + wb[1][e] * t1b[e] + wb[2][e] * h0b[e];
                const float ca1 = ba[e] + wa[0][e] * t1a[e] + wa[1][e] * h0a[e] + wa[2][e] * h1a[e], cb1 = bb[e] + wb[0][e] * t1b[e] + wb[1][e] * h0b[e] + wb[2][e] * h1b[e];
                o0[e] = gelu_t(ca0) * cb0; o1[e] = gelu_t(ca1) * cb1; }
            u32x4 w; w.x = cvtpk(o0[0], o0[1]); w.y = cvtpk(o0[2], o0[3]); w.z = cvtpk(o0[4], o0[5]); w.w = cvtpk(o0[6], o0[7]);
            *(u32x4*)(G + (size_t)(pm * 256) * DFF + c) = w;
            w.x = cvtpk(o1[0], o1[1]); w.y = cvtpk(o1[2], o1[3]); w.z = cvtpk(o1[4], o1[5]); w.w = cvtpk(o1[6], o1[7]);
            *(u32x4*)(G + (size_t)(pm * 256 + 1) * DFF + c) = w;
        }
    }
}
}

__device__ __forceinline__ void p_final(LAS unsigned char* lds_, const Ptrs& P, int s_wave) {
    const Frame F = make_frame(lds_, s_wave);
    float* Y = P.out + O_Y; const bf16_t* XB = (const bf16_t*)(P.ws + WS_XB); const float* xsq = (const float*)(P.ws + WS_XSQ);
    const int gw = F.vcu * 8 + F.wave, NGW = F.G * 8;
    float gn[2][8];
#pragma unroll
    for (int j = 0; j < 2; ++j) ld8f(P.nfin + 8 * F.lane + 512 * j, gn[j]);
    for (int m = gw; m < M; m += NGW) {
        float s = 0.f;
        { const f32x4 a = *(const f32x4*)(xsq + (size_t)m * 16 + 4 * (F.lane & 3)); s = (a[0] + a[1]) + (a[2] + a[3]); s = xadd<1>(s); s = xadd<2>(s); }
        const float rs = __builtin_amdgcn_rsqf(s * (1.0f / DM) + EPS);
#pragma unroll
        for (int j = 0; j < 2; ++j) { float v[8]; ld8(XB + (size_t)m * DM + 8 * F.lane + 512 * j, v);
#pragma unroll
            for (int e = 0; e < 8; ++e) v[e] = v[e] * rs * gn[j][e];
            st8f(Y + (size_t)m * DM + 8 * F.lane + 512 * j, v); }
    }
}

struct SFrag { bf16x8 a[4], b[4]; };
__device__ __forceinline__ void small_ld(SFrag& f, const bf16_t* ap, const bf16_t* bp, size_t lda16, size_t ldb16) {
#pragma unroll
    for (int i = 0; i < 4; ++i) { f.a[i] = *(const bf16x8*)(ap + i * lda16); f.b[i] = *(const bf16x8*)(bp + i * ldb16); }
}
__device__ __forceinline__ void small_mma(f32x4 (&acc)[4][4], const SFrag& f) {
#pragma unroll
    for (int i = 0; i < 4; ++i)
#pragma unroll
        for (int j = 0; j < 4; ++j) acc[i][j] = __builtin_amdgcn_mfma_f32_16x16x32_bf16(f.a[i], f.b[j], acc[i][j], 0, 0, 0);
}
__device__ __forceinline__ void small_kslice(f32x4 (&acc)[4][4], const bf16_t* A, int lda, const bf16_t* Bt, int ldb, int k0, int nks, int lane) {
    const bf16_t* ap = A + (size_t)(lane & 15) * lda + k0 + 8 * (lane >> 4); const bf16_t* bp = Bt + (size_t)(lane & 15) * ldb + k0 + 8 * (lane >> 4);
    const size_t lda16 = (size_t)16 * lda, ldb16 = (size_t)16 * ldb;
    for (int s = 0; s < nks; s += 4) {
        SFrag f0, f1, f2, f3;
        small_ld(f0, ap + 32 * s, bp + 32 * s, lda16, ldb16);
        if (s + 1 < nks) small_ld(f1, ap + 32 * (s + 1), bp + 32 * (s + 1), lda16, ldb16);
        if (s + 2 < nks) small_ld(f2, ap + 32 * (s + 2), bp + 32 * (s + 2), lda16, ldb16);
        if (s + 3 < nks) small_ld(f3, ap + 32 * (s + 3), bp + 32 * (s + 3), lda16, ldb16);
        __builtin_amdgcn_sched_barrier(0);
        small_mma(acc, f0);
        if (s + 1 < nks) small_mma(acc, f1);
        if (s + 2 < nks) small_mma(acc, f2);
        if (s + 3 < nks) small_mma(acc, f3);
    }
}
__device__ __forceinline__ void small_zero(f32x4 (&acc)[4][4]) { float z = 0.f; asm volatile("" : "+v"(z));
#pragma unroll
    for (int i = 0; i < 4; ++i)
#pragma unroll
        for (int j = 0; j < 4; ++j) acc[i][j] = (f32x4){z, z, z, z}; }
__device__ __forceinline__ void small_reduce(LAS unsigned char* ring, const f32x4 (&acc)[4][4], const Frame& F, float (&out)[8]) {
    LAS float* slab = (LAS float*)(ring + F.wave * 16384);
    const int rq = 4 * (F.lane >> 4), cl = F.lane & 15;
#pragma unroll
    for (int i = 0; i < 4; ++i)
#pragma unroll
        for (int j = 0; j < 4; ++j)
#pragma unroll
            for (int r = 0; r < 4; ++r) slab[(16 * i + rq + r) * 64 + 16 * j + cl] = acc[i][j][r];
    LDS_WAIT(); __syncthreads();
    const int row = F.tid >> 3, c8 = (F.tid & 7) * 8;
#pragma unroll
    for (int e = 0; e < 8; ++e) out[e] = 0.f;
#pragma unroll
    for (int w = 0; w < 8; ++w) { const f32x4 x = *(LAS const f32x4*)(ring + w * 16384 + (row * 64 + c8) * 4), y = *(LAS const f32x4*)(ring + w * 16384 + (row * 64 + c8) * 4 + 16);
        out[0] += x[0]; out[1] += x[1]; out[2] += x[2]; out[3] += x[3]; out[4] += y[0]; out[5] += y[1]; out[6] += y[2]; out[7] += y[3]; }
    LDS_WAIT(); __syncthreads();
}
__device__ __forceinline__ void small_resid(LAS unsigned char* lds_, const bf16_t* A, int K, const bf16_t* Bt, bf16_t* XB, float* xsq, int s_wave) {
    const Frame F = make_frame(lds_, s_wave);
    for (int t = F.vcu; t < 256; t += F.G) {
        const int rb = 4 * (t >> 6) + ((t >> 3) & 3), cb = 8 * ((t >> 5) & 1) + (t & 7);
        f32x4 acc[4][4]; small_zero(acc);
        small_kslice(acc, A + (size_t)(MP + 64 * rb) * K, K, Bt + (size_t)(64 * cb) * K, K, F.wave * (K / 8), K / 256, F.lane);
        float o[8]; small_reduce(lds_ + RING_OFF, acc, F, o);
        const int row = MP + 64 * rb + (F.tid >> 3), c8 = 64 * cb + (F.tid & 7) * 8;
        float xo[8]; ld8(XB + (size_t)row * DM + c8, xo);
        u32x4 w; float ss = 0.f;
        { const unsigned r0 = cvtpk(xo[0] + o[0], xo[1] + o[1]), r1 = cvtpk(xo[2] + o[2], xo[3] + o[3]), r2 = cvtpk(xo[4] + o[4], xo[5] + o[5]), r3 = cvtpk(xo[6] + o[6], xo[7] + o[7]);
          w.x = r0; w.y = r1; w.z = r2; w.w = r3;
          ss = (bflo(r0) * bflo(r0) + bfhi(r0) * bfhi(r0)) + (bflo(r1) * bflo(r1) + bfhi(r1) * bfhi(r1)) + (bflo(r2) * bflo(r2) + bfhi(r2) * bfhi(r2)) + (bflo(r3) * bflo(r3) + bfhi(r3) * bfhi(r3)); }
        *(u32x4*)(XB + (size_t)row * DM + c8) = w;
        ss = xadd<1>(ss); ss = xadd<2>(ss); ss = xadd<4>(ss);
        if ((F.tid & 7) == 0) xsq[(size_t)row * 16 + cb] = ss;
    }
}
__device__ __forceinline__ void small_merge(LAS unsigned char* lds_, const bf16_t* OS, const bf16_t* WMl, const bf16_t* Z, bf16_t* MG, int s_wave) {
    const Frame F = make_frame(lds_, s_wave);
    for (int t = F.vcu; t < 256; t += F.G) {
        const int rb = 4 * (t >> 6) + ((t >> 3) & 3), cb = 8 * ((t >> 5) & 1) + (t & 7);
        const bf16_t* A = OS + (size_t)(MP + 64 * rb) * KM; const bf16_t* Bt = WMl + (size_t)(64 * cb) * KM;
        float o[8], s[8];
        { f32x4 acc[4][4]; small_zero(acc); small_kslice(acc, A, KM, Bt, KM, F.wave * 128, 4, F.lane); small_reduce(lds_ + RING_OFF, acc, F, o); }
        { f32x4 acc[4][4]; small_zero(acc); small_kslice(acc, A, KM, Bt, KM, 1024 + F.wave * 96, 3, F.lane); small_reduce(lds_ + RING_OFF, acc, F, s); }
        const int row = MP + 64 * rb + (F.tid >> 3), c8 = 64 * cb + (F.tid & 7) * 8;
        float ga[8], gb[8]; { const int gc = C_GA + 256 * (c8 >> 7) + (c8 & 127); ld8(Z + (size_t)row * NIN + gc, ga); ld8(Z + (size_t)row * NIN + gc + 128, gb); }
        u32x4 w; w.x = cvtpk(gb[0] * (ga[0] * o[0] + s[0]), gb[1] * (ga[1] * o[1] + s[1])); w.y = cvtpk(gb[2] * (ga[2] * o[2] + s[2]), gb[3] * (ga[3] * o[3] + s[3]));
        w.z = cvtpk(gb[4] * (ga[4] * o[4] + s[4]), gb[5] * (ga[5] * o[5] + s[5])); w.w = cvtpk(gb[6] * (ga[6] * o[6] + s[6]), gb[7] * (ga[7] * o[7] + s[7]));
        *(u32x4*)(MG + (size_t)row * DM + c8) = w;
    }
}

struct Args { const float* in[21]; float* out; unsigned char* ws; int ph_lo, ph_hi; };
static_assert(offsetof(Args, out) == 21 * 8 && offsetof(Args, ws) == 22 * 8, "Args layout");
__global__ void __launch_bounds__(512, 2) mk_fwd(Args args) {
    extern __shared__ __attribute__((aligned(16))) unsigned char lds_raw[];
    LAS unsigned char* const lds = (LAS unsigned char*)lds_raw; const int G = gridDim.x;
    volatile LAS unsigned* MISC = (volatile LAS unsigned*)(lds + MISC_OFF);
    const int s_wave = __builtin_amdgcn_readfirstlane((int)threadIdx.x >> 6);
    for (int u = tid_from_wave(s_wave); u < (LDS_BYTES - LDSCTL_OFF) / 4; u += 512) ((LAS unsigned*)(lds + LDSCTL_OFF))[u] = 0u;
    __syncthreads();
    const int lo = args.ph_lo, hi = args.ph_hi;
    XcdBarrier bar; bar.bar = (unsigned*)(args.ws + WS_CTL) + 4096; bar.x = 0; bar.st = nullptr;
    if (hi - lo > 1) bar = xcd_barrier_post((unsigned*)(args.ws + WS_CTL) + 4096, MISC + 8, tid_from_wave(s_wave) == 0);
    LAS unsigned char* ring = lds + RING_OFF; LAS unsigned char* red = lds + RED_OFF;
    for (int ph = lo; ph < hi; ++ph) {
        int z_ = 0; asm volatile("" : "+s"(z_));
        Ptrs P; P.xp = args.in[0 + z_]; P.xs = args.in[1 + z_]; P.ck = args.in[2 + z_]; P.cv = args.in[3 + z_]; P.sc = args.in[4 + z_]; P.nmix = args.in[5 + z_]; P.w_in = args.in[6 + z_]; P.sinks = args.in[7 + z_];
        P.lng = args.in[8 + z_]; P.lnb = args.in[9 + z_]; P.gws = args.in[10 + z_]; P.gbs = args.in[11 + z_]; P.wpa = args.in[12 + z_]; P.wpb = args.in[13 + z_]; P.wout = args.in[14 + z_]; P.nffn = args.in[15 + z_];
        P.wup = args.in[16 + z_]; P.cw = args.in[17 + z_]; P.cb = args.in[18 + z_]; P.wdn = args.in[19 + z_]; P.nfin = args.in[20 + z_]; P.out = (float*)args.in[21 + z_]; P.ws = (unsigned char*)args.in[22 + z_];
        bf16_t* XB = (bf16_t*)(P.ws + WS_XB); float* xsq = (float*)(P.ws + WS_XSQ);
#if defined(MK_REP_K)
      const int nrep_ = ((ph == 0 && MK_REP_K == 100) || (ph > 0 && ph < NPH - 1 && (ph - 1) % 6 == MK_REP_K)) ? MK_REP_N : 1;
      for (int rep_ = 0; rep_ < nrep_; ++rep_) {
        if (rep_ > 0) xcd_barrier(bar, tid_from_wave(s_wave) == 0);
#endif
#if defined(MK_REP_K)
        bf16_t* XBo = rep_ > 0 ? (bf16_t*)(P.ws + ((size_t)460 << 20)) : XB; float* xsqo = rep_ > 0 ? (float*)(P.ws + ((size_t)500 << 20)) : xsq;
#else
        bf16_t* XBo = XB; float* xsqo = xsq;
#endif
        if (ph == 0) p0_prologue(lds, P, s_wave);
        else if (ph == NPH - 1) p_final(lds, P, s_wave);
        else {
            const int l = (ph - 1) / 6, k = (ph - 1) % 6;
            if (k == 0) { const int NGm = G - NWORKERS;
                if ((int)blockIdx.x < NGm) { pg8::Gemm g{XB, (const bf16_t*)(P.ws + WS_WIN) + (size_t)l * NIN * DM, M, NIN, DM}; pg8::StaticOrder S; S.init(M, NIN, NGm, (int)blockIdx.x);
                    pg8::EpiAct E{(bf16_t*)(P.ws + WS_RA), NIN, xsq, (float*)(P.ws + WS_GVST), 1}; pg8::gemm_phase(ring, red, g, S, E, s_wave); }
#if defined(MK_REP_K) && defined(MK_WORK_ONCE)
                else if (rep_ == 0) p1_workers(lds, P, l, (int)blockIdx.x - NGm, NWORKERS, s_wave); }
#else
                else p1_workers(lds, P, l, (int)blockIdx.x - NGm, NWORKERS, s_wave); }
#endif
            else if (k == 1) p2_mixer(lds, P, l, s_wave);
            else if (k == 2) { pg8::Gemm g{(const bf16_t*)(P.ws + WS_RB), (const bf16_t*)(P.ws + WS_WM) + (size_t)l * DM * KM, MP, DM, KM}; pg8::StaticOrder S; S.init(MP, DM, G, (int)blockIdx.x);
                pg8::EpiMerge E{(const bf16_t*)(P.ws + WS_RA), (bf16_t*)(P.ws + WS_MG)};
                if (G == 256) { pg8::Unit u; S.next(0, u); pg8::gemm_phase_x(ring, red, g, u, E, s_wave); }
                else { pg8::gemm_phase(ring, red, g, S, E, s_wave);
                    small_merge(lds, (const bf16_t*)(P.ws + WS_RB), (const bf16_t*)(P.ws + WS_WM) + (size_t)l * DM * KM, (const bf16_t*)(P.ws + WS_RA), (bf16_t*)(P.ws + WS_MG), s_wave); } }
            else if (k == 3) { pg8::Gemm g{(const bf16_t*)(P.ws + WS_MG), (const bf16_t*)(P.ws + WS_WOUT) + (size_t)l * DM * DM, MP, DM, DM}; pg8::StaticOrder S; S.init(MP, DM, G, (int)blockIdx.x);
                pg8::EpiResid E{XBo, xsqo};
                if (G == 256) { pg8::Unit u; S.next(0, u); pg8::gemm_phase_x(ring, red, g, u, E, s_wave); }
                else { pg8::gemm_phase(ring, red, g, S, E, s_wave); small_resid(lds, (const bf16_t*)(P.ws + WS_MG), DM, (const bf16_t*)(P.ws + WS_WOUT) + (size_t)l * DM * DM, XBo, xsqo, s_wave); } }
            else if (k == 4) { pg8::Gemm g{XB, (const bf16_t*)(P.ws + WS_WUP) + (size_t)l * NUP * DM, M, NUP, DM}; pg8::StaticOrder S; S.init(M, NUP, G, (int)blockIdx.x);
                pg8::EpiUp E{P.ws, P.cw + (size_t)l * 3 * NUP, P.cb + (size_t)l * NUP, P.out + O_CVP + (size_t)l * NB * 2 * NUP};
                pg8::gemm_phase(ring, red, g, S, E, s_wave); }
            else { if (G == 256) { pg8::StaticOrder S0; S0.init(MP, DM, G, (int)blockIdx.x); pg8::Unit u0; S0.next(0, u0); p7_pre(lds, P, l, u0.pm, u0.pm + 1, s_wave); } else p7_pre(lds, P, l, 0, MP / 256, s_wave);
                VM_WAIT(); __syncthreads();
                pg8::Gemm g{(const bf16_t*)(P.ws + WS_RB), (const bf16_t*)(P.ws + WS_WDN) + (size_t)l * DM * DFF, MP, DM, DFF}; pg8::StaticOrder S; S.init(MP, DM, G, (int)blockIdx.x);
                pg8::EpiResid E{XBo, xsqo};
                if (G == 256) { pg8::Unit u; S.next(0, u); pg8::gemm_phase_x(ring, red, g, u, E, s_wave); }
                else { pg8::gemm_phase(ring, red, g, S, E, s_wave); small_resid(lds, (const bf16_t*)(P.ws + WS_RB), DFF, (const bf16_t*)(P.ws + WS_WDN) + (size_t)l * DM * DFF, XBo, xsqo, s_wave); } }
        }
#if defined(MK_REP_K)
      }
#endif
        if (ph + 1 < hi) xcd_barrier(bar, tid_from_wave(s_wave) == 0);
#if defined(MK_BAR_TWICE)
        for (int bb_ = 1; bb_ < MK_BAR_TWICE; ++bb_) if (ph + 1 < hi) xcd_barrier(bar, tid_from_wave(s_wave) == 0);
#endif
    }
}

extern "C" void kernel_launch(void* const* d_in, const int* in_sizes, int n_in, void* d_out, int out_size, void* d_ws, size_t ws_size, hipStream_t stream) {
    static int grid = 0;
    if (grid == 0) {
        if (n_in != 21 || out_size != (int)O_END || ws_size < WS_END) { fprintf(stderr, "kernel_launch: unexpected shapes: n_in %d out %d ws %zu (need %zu)\n", n_in, out_size, ws_size, (size_t)WS_END); grid = -1; return; }
        int dev = 0, cus = 0, per_cu = 0;
        if (hipGetDevice(&dev) != hipSuccess || hipDeviceGetAttribute(&cus, hipDeviceAttributeMultiprocessorCount, dev) != hipSuccess) { grid = -1; return; }
        if (hipFuncSetAttribute((const void*)mk_fwd, hipFuncAttributeMaxDynamicSharedMemorySize, LDS_BYTES) != hipSuccess) { fprintf(stderr, "kernel_launch: hipFuncSetAttribute failed\n"); grid = -1; return; }
        if (hipOccupancyMaxActiveBlocksPerMultiprocessor(&per_cu, (const void*)mk_fwd, 512, LDS_BYTES) != hipSuccess || per_cu < 1) { fprintf(stderr, "kernel_launch: occupancy query says %d blocks/CU\n", per_cu); per_cu = 1; }
        (void)hipGetLastError();
        grid = cus;
    }
    if (grid < 0) return;
    (void)hipMemsetAsync((char*)d_ws + WS_CTL, 0, CTL_ZERO_BYTES, stream);
    Args a{};
    for (int i = 0; i < 21; ++i) a.in[i] = (const float*)d_in[i];
    a.out = (float*)d_out; a.ws = (unsigned char*)d_ws;
#if MK_ONE_LAUNCH
    a.ph_lo = 0; a.ph_hi = NPH;
    void* kargs[] = {&a};
    hipError_t e = hipLaunchCooperativeKernel((const void*)mk_fwd, dim3(grid), dim3(512), kargs, LDS_BYTES, stream);
    if (e != hipSuccess) fprintf(stderr, "kernel_launch: cooperative launch failed: %s\n", hipGetErrorString(e));
#else
    for (int ph = 0; ph < NPH; ++ph) { a.ph_lo = ph; a.ph_hi = ph + 1; hipLaunchKernelGGL(mk_fwd, dim3(grid), dim3(512), LDS_BYTES, stream, a); }
#endif
}
```

```cpp
#include <hip/hip_runtime.h>
#include <cstdio>
#include <cstdint>
#include <cstddef>

#ifndef MK_ONE_LAUNCH
#define MK_ONE_LAUNCH 1
#endif

#define LAS __attribute__((address_space(3)))
#define GAS __attribute__((address_space(1)))
typedef unsigned short bf16_t;
typedef short bf16x8 __attribute__((ext_vector_type(8)));
typedef short s16x4 __attribute__((ext_vector_type(4)));
typedef float f32x2 __attribute__((ext_vector_type(2)));
typedef float f32x4 __attribute__((ext_vector_type(4)));
typedef float f32x16 __attribute__((ext_vector_type(16)));
typedef unsigned u32x2 __attribute__((ext_vector_type(2)));
typedef unsigned u32x4 __attribute__((ext_vector_type(4)));
typedef __bf16 bf16x2_t __attribute__((ext_vector_type(2)));

constexpr int DM = 1024, NB = 2, SEQ = 8192, DEPTH = 4, SB = 128, ST = 8, WIN = 128;
constexpr int MP = NB * SEQ, MS = SB * ST, M = MP + MS;
constexpr int NIN = 5120, C_Q = 0, C_K = 1024, C_V = 1280, C_GU = 1536, C_GV = 2304, C_GA = 3072, C_GB = 4096;
constexpr int KM = 1792, NUP = 5632, DFF = 2816, GW = 768;
constexpr float EPS = 1e-5f, LOG2E = 1.4426950408889634f, C2 = 0.125f * 1.4426950408889634f, NEGBIG = -1e30f;
#ifndef MK_NWORKERS
#define MK_NWORKERS 24
#endif
constexpr int NPH = 26, NWORKERS = MK_NWORKERS;

constexpr size_t O_Y = 0, O_WKP = 17825792, O_WVP = 18087936, O_CVP = 18350080, O_WKS = 18440192, O_WVS = 35217408, O_CVS = 51994624, O_GVS = 57761792, O_END = 60907520;

constexpr size_t MiB = 1u << 20;
constexpr size_t WS_CTL = 0, CTL_ZERO_BYTES = 64 * 1024, WS_XSQ = 1 * MiB  , WS_GVST = 2 * MiB + 512 * 1024, WS_WSB = 5 * MiB, WS_WIN = 8 * MiB, WS_WM = 48 * MiB, WS_WOUT = 62 * MiB,
                 WS_WUP = 70 * MiB, WS_WDN = 114 * MiB, WS_XB = 136 * MiB, WS_RA = 170 * MiB, WS_RB = 357 * MiB, WS_MG = WS_RB + 60 * MiB, WS_END = 451 * MiB;
static_assert((size_t)M * NUP * 2 <= WS_RB - WS_RA && (size_t)M * DFF * 2 <= WS_END - WS_RB && (size_t)M * KM * 2 <= 60 * MiB && WS_MG + (size_t)M * DM * 2 <= WS_END, "ws map");

constexpr int RING_OFF = 0, RING_BYTES = 131072, RED_OFF = RING_BYTES, RED_BYTES = 20480, LDSCTL_OFF = RED_OFF + RED_BYTES, MISC_OFF = LDSCTL_OFF + 320, LDS_BYTES = 155648;

__device__ __forceinline__ unsigned cvtpk(float lo, float hi) { f32x2 v = {lo, hi}; bf16x2_t b = __builtin_convertvector(v, bf16x2_t); return __builtin_bit_cast(unsigned, b); }
__device__ __forceinline__ float bflo(unsigned u) { return __uint_as_float(u << 16); }
__device__ __forceinline__ float bfhi(unsigned u) { return __uint_as_float(u & 0xffff0000u); }
__device__ __forceinline__ float gelu_t(float x) { const float t = x * (-2.302208198f + -0.1029432398f * x * x); return x * __builtin_amdgcn_rcpf(1.0f + __builtin_amdgcn_exp2f(t)); }
__device__ __forceinline__ float sigm(float x) { return __builtin_amdgcn_rcpf(1.0f + __builtin_amdgcn_exp2f(-LOG2E * x)); }
__device__ __forceinline__ int crow(int r, int hi) { return (r & 3) + 8 * (r >> 2) + 4 * hi; }
template <int MASK> __device__ __forceinline__ float xadd(float v) {
    if constexpr (MASK == 32) { auto rr = __builtin_amdgcn_permlane32_swap(__float_as_uint(v), __float_as_uint(v), false, false); return __uint_as_float(rr[0]) + __uint_as_float(rr[1]); }
    else return v + __int_as_float(__builtin_amdgcn_ds_swizzle(__float_as_int(v), (MASK << 10) | 0x1f));
}
__device__ __forceinline__ int tid_from_wave(int s_wave) { int lane; asm volatile("v_mbcnt_lo_u32_b32 %0, -1, 0\n\tv_mbcnt_hi_u32_b32 %0, -1, %0" : "=v"(lane)); return s_wave * 64 + lane; }

namespace pg8 {
#define PG8_LAS __attribute__((address_space(3)))
constexpr int BM = 256, BK = 64, HALF = 128, HTB = HALF * BK * 2  , STAGE_BYTES = 8 * HTB, NXCD = 8, WGM = 8;
__host__ __device__ __forceinline__ int lds_byte(int r, int c) { const int st = (r >> 4) * 2 + (c >> 5), rr = r & 15, cc = c & 31, ob = rr * 64 + cc * 2; return st * 1024 + (ob ^ (((ob >> 9) & 1) << 5)); }
__host__ __device__ __forceinline__ void stage_rc(int b, int& R, int& C) { const int st = b / 1024, sb = b % 1024, swz = sb ^ (((sb >> 9) & 1) << 5); R = (st >> 1) * 16 + swz / 64; C = (st & 1) * 32 + (swz % 64) / 2; }
__host__ __device__ __forceinline__ int perm32(int rho) { const int n = rho >> 4, i = rho & 15; return 8 * (i >> 2) + 4 * n + (i & 3); }

struct Unit { int pm, pn; };
struct Gemm { const bf16_t* A; const bf16_t* Bt; int M, N, K; };
struct StaticOrder {
    int nM, nN, nwg, G, c;
    __host__ __device__ void init(int M_, int N_, int G_, int c_) { nM = M_ / BM; nN = N_ / BM; nwg = nM * nN; G = G_; c = c_; }
    __host__ __device__ bool next(int i, Unit& u) const {
        const long L = (long)i * G + c; if (L >= nwg) return false;
        int wgid = (int)L; { const int q = nwg / NXCD, r = nwg % NXCD, xcd = wgid % NXCD, off = wgid / NXCD; wgid = (xcd < r ? xcd * (q + 1) : r * (q + 1) + (xcd - r) * q) + off; }
        const int nig = WGM * nN, gid = wgid / nig, fm = gid * WGM, gsz = (nM - fm) < WGM ? (nM - fm) : WGM;
        u.pm = fm + ((wgid % nig) % gsz); u.pn = (wgid % nig) / gsz; return true;
    }
};


struct RsPf { f32x4 a, b; };
__device__ __forceinline__ void rs_issue(RsPf& p, const float* xsq, int pm, int tid) { const float* q = xsq + (size_t)(pm * BM + (tid >> 1)) * 16 + 8 * (tid & 1); p.a = *(const f32x4*)q; p.b = *(const f32x4*)(q + 4); }
__device__ __forceinline__ void rs_write(const RsPf& p, PG8_LAS float* R, int tid) {
    float s = ((p.a[0] + p.a[1]) + (p.a[2] + p.a[3])) + ((p.b[0] + p.b[1]) + (p.b[2] + p.b[3])); s = xadd<1>(s);
    if ((tid & 1) == 0) R[tid >> 1] = __builtin_amdgcn_rsqf(s * (1.0f / DM) + EPS);
}
struct EpiAct {
    static constexpr bool PERM = true, IDEMP = true; static constexpr int MID_T = -1;
    bf16_t* O; int ldc; const float* xsq; float* gvst; int mode;
    __device__ __forceinline__ void mid(f32x4 (&)[2][2][4][2], const Unit&, int, int, int, int) const {}
    template <int KIND> __device__ __forceinline__ void body(const f32x4 (&acc)[2][2][4][2], const Unit& u, int wr, int wc, int fr, int fq, const PG8_LAS float* R) const {
        const int row0 = u.pm * BM + wr * 64 + fr, col0 = u.pn * BM + wc * 32 + 8 * fq;
#pragma unroll
        for (int ai = 0; ai < 2; ++ai)
#pragma unroll
            for (int m = 0; m < 4; ++m) {
                const int row = row0 + ai * HALF + m * 16;
                float rs = R[ai * HALF + wr * 64 + m * 16 + fr];
                if (KIND == 0) rs *= C2;
                float s1 = 0.f, s2 = 0.f;
                bf16_t* rowp = O + (size_t)row * ldc + col0;
                float v[2][8];
#pragma unroll
                for (int bj = 0; bj < 2; ++bj)
#pragma unroll
                    for (int e = 0; e < 8; ++e) { float x = acc[ai][bj][m][e >> 2][e & 3] * rs;
                        if (KIND == 2 || KIND == 3) x = gelu_t(x);
                        if (KIND == 4) x = fminf(1.0f + __builtin_amdgcn_exp2f(-LOG2E * x), 1e30f);
                        v[bj][e] = x; }
                if (KIND == 4) {
#pragma unroll
                    for (int e = 0; e < 8; ++e) { const float ta = v[0][e], tb = v[1][e]; v[0][e] = tb * __builtin_amdgcn_rcpf(ta); v[1][e] = __builtin_amdgcn_rcpf(tb); } }
#pragma unroll
                for (int bj = 0; bj < 2; ++bj) {
                    u32x4 w; w.x = cvtpk(v[bj][0], v[bj][1]); w.y = cvtpk(v[bj][2], v[bj][3]); w.z = cvtpk(v[bj][4], v[bj][5]); w.w = cvtpk(v[bj][6], v[bj][7]);
                    if (KIND == 3) {
#pragma unroll
                        for (int e = 0; e < 4; ++e) { const unsigned q = e == 0 ? w.x : e == 1 ? w.y : e == 2 ? w.z : w.w; const float a = bflo(q), b = bfhi(q); s1 += a + b; s2 += a * a + b * b; } }
                    *(u32x4*)(rowp + bj * HALF) = w;
                }
                if (KIND == 3) {
                    s1 = xadd<16>(s1); s1 = xadd<32>(s1); s2 = xadd<16>(s2); s2 = xadd<32>(s2);
                    if (fq == 0) *(f32x2*)(gvst + (size_t)row * 24 + ((u.pn - 9) * 4 + wc) * 2) = (f32x2){s1, s2};
                }
            }
    }
    static constexpr bool USES_R = true;
    __device__ __forceinline__ void prep(const Unit& u, PG8_LAS unsigned char* red, int tid) const { RsPf p; rs_issue(p, xsq, u.pm, tid); rs_write(p, (PG8_LAS float*)red, tid); }
    __device__ __forceinline__ void run(f32x4 (&acc)[2][2][4][2], const Unit& u, int wr, int wc, int fr, int fq, PG8_LAS unsigned char* red, int tid, const Unit* nxt, int par) const {
        asm volatile("" : "+v"(fr), "+v"(fq), "+v"(tid));
        const PG8_LAS float* R = (const PG8_LAS float*)red + par * 256;
        RsPf pf; rs_issue(pf, xsq, nxt ? nxt->pm : u.pm, tid);
        run2(acc, u, wr, wc, fr, fq, R);
        rs_write(pf, (PG8_LAS float*)red + (par ^ 1) * 256, tid);
    }
    __device__ __forceinline__ void run2(f32x4 (&acc)[2][2][4][2], const Unit& u, int wr, int wc, int fr, int fq, const PG8_LAS float* R) const {
        if (mode == 0) { body<1>(acc, u, wr, wc, fr, fq, R); return; }
        const int pn = u.pn;
        if (pn < 4) body<0>(acc, u, wr, wc, fr, fq, R);
        else if (pn < 6) body<1>(acc, u, wr, wc, fr, fq, R);
        else if (pn < 9) body<2>(acc, u, wr, wc, fr, fq, R);
        else if (pn < 12) body<3>(acc, u, wr, wc, fr, fq, R);
        else body<4>(acc, u, wr, wc, fr, fq, R);
    }
};

#ifndef MK_WT_SINGLE
#define MK_WT_SINGLE 0
#endif
__device__ __forceinline__ void st16wt(void* p, u32x4 v) {
#if MK_WT_SINGLE
    asm volatile("global_store_dwordx4 %0, %1, off sc1\n\ts_nop 1" :: "v"(p), "v"(v) : "memory");
#else
    *(u32x4*)p = v;
#endif
}
struct EpiMerge {
    static constexpr bool PERM = true, IDEMP = false; static constexpr int MID_T = 16;
    const bf16_t* Z; bf16_t* O;
    template <int WHICH> __device__ __forceinline__ void scale(f32x4 (&acc)[2][2][4][2], const Unit& u, int wr, int wc, int fr, int fq) const {
        asm volatile("" : "+v"(fr), "+v"(fq));
        const int row0 = u.pm * BM + wr * 64 + fr, gc0 = C_GA + 512 * u.pn + WHICH * 128 + wc * 32 + 8 * fq;
        u32x4 gt[2][4][2];
#pragma unroll
        for (int ai = 0; ai < 2; ++ai)
#pragma unroll
            for (int m = 0; m < 4; ++m) { const bf16_t* zr = Z + (size_t)(row0 + ai * HALF + m * 16) * NIN + gc0;
#pragma unroll
                for (int bj = 0; bj < 2; ++bj) gt[ai][m][bj] = *(const u32x4*)(zr + bj * 256); }
        __builtin_amdgcn_sched_barrier(0);
#pragma unroll
        for (int ai = 0; ai < 2; ++ai)
#pragma unroll
            for (int m = 0; m < 4; ++m)
#pragma unroll
                for (int bj = 0; bj < 2; ++bj) { const u32x4 a = gt[ai][m][bj];
#pragma unroll
                    for (int e = 0; e < 4; ++e) { const unsigned qa = e == 0 ? a.x : e == 1 ? a.y : e == 2 ? a.z : a.w;
                        acc[ai][bj][m][e >> 1][(e & 1) * 2] *= bflo(qa); acc[ai][bj][m][e >> 1][(e & 1) * 2 + 1] *= bfhi(qa); } }
    }
    __device__ __forceinline__ void mid(f32x4 (&acc)[2][2][4][2], const Unit& u, int wr, int wc, int fr, int fq) const { scale<0>(acc, u, wr, wc, fr, fq); }
    template <int WHICH> __device__ __forceinline__ void scalex(f32x4 (&accx)[2], const Unit& u, int wr, int wc, int fr, int fq) const {
        asm volatile("" : "+v"(fr), "+v"(fq));
        const u32x4 a = *(const u32x4*)(Z + (size_t)(MP + 16 * u.pm + fr) * NIN + C_GA + 512 * u.pn + 256 * wr + WHICH * 128 + wc * 32 + 8 * fq);
#pragma unroll
        for (int e = 0; e < 4; ++e) { const unsigned qa = e == 0 ? a.x : e == 1 ? a.y : e == 2 ? a.z : a.w; accx[e >> 1][(e & 1) * 2] *= bflo(qa); accx[e >> 1][(e & 1) * 2 + 1] *= bfhi(qa); }
    }
    __device__ __forceinline__ void midx(f32x4 (&accx)[2], const Unit& u, int wr, int wc, int fr, int fq) const { scalex<0>(accx, u, wr, wc, fr, fq); }
    __device__ __forceinline__ void runx(f32x4 (&accx)[2], const Unit& u, int wr, int wc, int fr, int fq, PG8_LAS unsigned char*, int) const {
        scalex<1>(accx, u, wr, wc, fr, fq);
        asm volatile("" : "+v"(fr), "+v"(fq));
        u32x4 w; w.x = cvtpk(accx[0][0], accx[0][1]); w.y = cvtpk(accx[0][2], accx[0][3]); w.z = cvtpk(accx[1][0], accx[1][1]); w.w = cvtpk(accx[1][2], accx[1][3]);
        st16wt(O + (size_t)(MP + 16 * u.pm + fr) * DM + u.pn * BM + 128 * wr + wc * 32 + 8 * fq, w);
    }
    static constexpr bool USES_R = false;
    __device__ __forceinline__ void prep(const Unit&, PG8_LAS unsigned char*, int) const {}
    __device__ __forceinline__ void run(f32x4 (&acc)[2][2][4][2], const Unit& u, int wr, int wc, int fr, int fq, PG8_LAS unsigned char*, int, const Unit*, int) const {
        scale<1>(acc, u, wr, wc, fr, fq);
        asm volatile("" : "+v"(fr), "+v"(fq));
        const int row0 = u.pm * BM + wr * 64 + fr, col0 = u.pn * BM + wc * 32 + 8 * fq;
#pragma unroll
        for (int ai = 0; ai < 2; ++ai)
#pragma unroll
            for (int m = 0; m < 4; ++m) {
                const int row = row0 + ai * HALF + m * 16;
#pragma unroll
                for (int bj = 0; bj < 2; ++bj) {
                    u32x4 w; w.x = cvtpk(acc[ai][bj][m][0][0], acc[ai][bj][m][0][1]); w.y = cvtpk(acc[ai][bj][m][0][2], acc[ai][bj][m][0][3]);
                    w.z = cvtpk(acc[ai][bj][m][1][0], acc[ai][bj][m][1][1]); w.w = cvtpk(acc[ai][bj][m][1][2], acc[ai][bj][m][1][3]);
                    st16wt(O + (size_t)row * DM + col0 + bj * HALF, w);
                }
            }
    }
};

struct EpiResid {
    static constexpr bool PERM = true, IDEMP = false; static constexpr int MID_T = -1;
    bf16_t* XB; float* xsq;
    __device__ __forceinline__ void mid(f32x4 (&)[2][2][4][2], const Unit&, int, int, int, int) const {}
    __device__ __forceinline__ void midx(f32x4 (&)[2], const Unit&, int, int, int, int) const {}
    __device__ __forceinline__ void runx(f32x4 (&accx)[2], const Unit& u, int wr, int wc, int fr, int fq, PG8_LAS unsigned char* red, int tid) const {
        asm volatile("" : "+v"(fr), "+v"(fq), "+v"(tid));
        const int row = MP + 16 * u.pm + fr; bf16_t* xr = XB + (size_t)row * DM + u.pn * BM + 128 * wr + wc * 32 + 8 * fq;
        const u32x4 o = *(const u32x4*)xr; u32x4 w; float ss = 0.f;
#pragma unroll
        for (int e = 0; e < 4; ++e) { const unsigned q = e == 0 ? o.x : e == 1 ? o.y : e == 2 ? o.z : o.w;
            const unsigned r = cvtpk(bflo(q) + accx[e >> 1][(e & 1) * 2], bfhi(q) + accx[e >> 1][(e & 1) * 2 + 1]);
            const float a = bflo(r), b = bfhi(r); ss += a * a + b * b;
            if (e == 0) w.x = r; else if (e == 1) w.y = r; else if (e == 2) w.z = r; else w.w = r; }
        st16wt(xr, w);
        ss = xadd<16>(ss); ss = xadd<32>(ss);
        PG8_LAS float* RX = (PG8_LAS float*)(red + 4096);
        if (fq == 0) RX[(wr * 4 + wc) * 16 + fr] = ss;
        asm volatile("s_waitcnt lgkmcnt(0)" ::: "memory"); __builtin_amdgcn_s_barrier(); asm volatile("" ::: "memory");
        if (tid < 16) { float s = 0.f;
#pragma unroll
            for (int w8 = 0; w8 < 8; ++w8) s += RX[w8 * 16 + tid];
            xsq[(size_t)(MP + 16 * u.pm + tid) * 16 + u.pn] = s; }
    }
    static constexpr bool USES_R = false;
    __device__ __forceinline__ void prep(const Unit&, PG8_LAS unsigned char*, int) const {}
    __device__ __forceinline__ void run(f32x4 (&acc)[2][2][4][2], const Unit& u, int wr, int wc, int fr, int fq, PG8_LAS unsigned char*, int, const Unit*, int) const {
        asm volatile("" : "+v"(fr), "+v"(fq));
        const int row0 = u.pm * BM + wr * 64 + fr, col0 = u.pn * BM + wc * 32 + 8 * fq;
        u32x4 xo[2][4][2];
#pragma unroll
        for (int ai = 0; ai < 2; ++ai)
#pragma unroll
            for (int m = 0; m < 4; ++m)
#pragma unroll
                for (int bj = 0; bj < 2; ++bj) xo[ai][m][bj] = *(const u32x4*)(XB + (size_t)(row0 + ai * HALF + m * 16) * DM + col0 + bj * HALF);
        __builtin_amdgcn_sched_barrier(0);
#pragma unroll
        for (int ai = 0; ai < 2; ++ai)
#pragma unroll
            for (int m = 0; m < 4; ++m) {
                const int row = row0 + ai * HALF + m * 16;
                bf16_t* xr = XB + (size_t)row * DM + col0;
                float ss = 0.f;
#pragma unroll
                for (int bj = 0; bj < 2; ++bj) {
                    const u32x4 o = xo[ai][m][bj];
                    u32x4 w;
#pragma unroll
                    for (int e = 0; e < 4; ++e) { const unsigned q = e == 0 ? o.x : e == 1 ? o.y : e == 2 ? o.z : o.w;
                        const unsigned r = cvtpk(bflo(q) + acc[ai][bj][m][e >> 1][(e & 1) * 2], bfhi(q) + acc[ai][bj][m][e >> 1][(e & 1) * 2 + 1]);
                        const float a = bflo(r), b = bfhi(r); ss += a * a + b * b;
                        if (e == 0) w.x = r; else if (e == 1) w.y = r; else if (e == 2) w.z = r; else w.w = r; }
                    st16wt(xr + bj * HALF, w);
                }
                ss = xadd<16>(ss); ss = xadd<32>(ss);
                if (fq == 0) xsq[(size_t)row * 16 + u.pn * 4 + wc] = ss;
            }
    }
};

template <int CTRL> __device__ __forceinline__ unsigned dppu(unsigned old, unsigned src) { return (unsigned)__builtin_amdgcn_update_dpp((int)old, (int)src, CTRL, 0xf, 0xf, false); }
template <int CTRL> __device__ __forceinline__ float dppf(float old, float src) { return __int_as_float(__builtin_amdgcn_update_dpp(__float_as_int(old), __float_as_int(src), CTRL, 0xf, 0xf, false)); }
#ifndef MK_UP_SB
#define MK_UP_SB 1
#endif
#ifndef MK_DOT2
#define MK_DOT2 0
#endif
typedef __attribute__((ext_vector_type(2))) __bf16 bf16v2_t;
__device__ __forceinline__ float dot2bf(unsigned a, unsigned b, float c) { return __builtin_amdgcn_fdot2_f32_bf16(__builtin_bit_cast(bf16v2_t, a), __builtin_bit_cast(bf16v2_t, b), c, false); }
struct EpiUp {
    static constexpr bool PERM = true, IDEMP = true; static constexpr int MID_T = -1;
    unsigned char* ws; const float* cw; const float* cb; float* ocp;
    __device__ __forceinline__ void mid(f32x4 (&)[2][2][4][2], const Unit&, int, int, int, int) const {}
    static constexpr bool USES_R = true;
    __device__ __forceinline__ void stage_cw(int pn, PG8_LAS unsigned char* red, int tid, int par) const {
        if (tid < 256) { const int tp = __builtin_amdgcn_readfirstlane(tid >> 6), hb = (tid >> 5) & 1, c4 = (tid & 31) * 4; const float* srcw = (tp < 3 ? cw + tp * NUP : cb) + hb * DFF + 128 * pn + c4;
            __builtin_amdgcn_global_load_lds((const unsigned*)srcw, (PG8_LAS unsigned*)((PG8_LAS float*)(red + 12288) + par * 1024 + tp * 256), 16, 0, 0); }
    }
    __device__ __forceinline__ void prep(const Unit& u, PG8_LAS unsigned char* red, int tid) const { RsPf p; rs_issue(p, (const float*)(ws + WS_XSQ), u.pm, tid); stage_cw(u.pn, red, tid, 0); rs_write(p, (PG8_LAS float*)red, tid); }
    __device__ __forceinline__ void run(f32x4 (&acc)[2][2][4][2], const Unit& u, int wr, int wc, int fr, int fq, PG8_LAS unsigned char* red, int tid, const Unit* nxt, int par) const {
        asm volatile("" : "+v"(fr), "+v"(fq), "+v"(tid));
        const PG8_LAS float* R = (const PG8_LAS float*)red + par * 256;
        RsPf pf; rs_issue(pf, (const float*)(ws + WS_XSQ), nxt ? nxt->pm : u.pm, tid);
        run2(acc, u, wr, wc, fr, fq, red, R, tid, pf, true, (PG8_LAS float*)red + (par ^ 1) * 256, par);
        if (nxt) { int t2 = tid; asm volatile("" : "+v"(t2)); stage_cw(nxt->pn, red, t2, par ^ 1); }
    }
    __device__ __forceinline__ void run2(f32x4 (&acc)[2][2][4][2], const Unit& u, int wr, int wc, int fr, int fq, PG8_LAS unsigned char* red, const PG8_LAS float* R, int tid, const RsPf& pf, bool has_pf, PG8_LAS float* Rn, int par) const {
        bf16_t* const G = (bf16_t*)(ws + WS_RB); bf16_t* const Z2 = (bf16_t*)(ws + WS_RA); float* const HT = (float*)(ws + WS_RA);
        const int row0 = u.pm * BM + wr * 64 + fr, jc = 128 * u.pn + 32 * wc + 8 * fq;
        if (u.pm >= MP / BM) {
#pragma unroll
            for (int ai = 0; ai < 2; ++ai)
#pragma unroll
                for (int m = 0; m < 4; ++m) { const int row = row0 + ai * HALF + m * 16; const float rs = R[ai * HALF + wr * 64 + m * 16 + fr];
#pragma unroll
                    for (int bj = 0; bj < 2; ++bj) { u32x4 w; w.x = cvtpk(acc[ai][bj][m][0][0] * rs, acc[ai][bj][m][0][1] * rs); w.y = cvtpk(acc[ai][bj][m][0][2] * rs, acc[ai][bj][m][0][3] * rs);
                        w.z = cvtpk(acc[ai][bj][m][1][0] * rs, acc[ai][bj][m][1][1] * rs); w.w = cvtpk(acc[ai][bj][m][1][2] * rs, acc[ai][bj][m][1][3] * rs);
                        *(u32x4*)(Z2 + (size_t)row * NUP + bj * DFF + jc) = w; } }
            if (has_pf) rs_write(pf, Rn, tid);
            return;
        }
        const float rs3[2] = {R[wr * 64 + 48 + fr], R[HALF + wr * 64 + 48 + fr]}; const float rs00 = R[wr * 64 + fr];
        PG8_LAS float* H = (PG8_LAS float*)(red + 4096);
        const PG8_LAS float* CW = (const PG8_LAS float*)(red + 12288) + par * 1024;
        if (fr >= 14) {
#pragma unroll
            for (int ai = 0; ai < 2; ++ai)
#pragma unroll
                for (int bj = 0; bj < 2; ++bj)
#pragma unroll
                    for (int n = 0; n < 2; ++n) *(PG8_LAS f32x4*)(H + ((2 * ai + wr) * 2 + (fr - 14)) * 256 + bj * HALF + 32 * wc + 8 * fq + 4 * n) = acc[ai][bj][3][n] * rs3[ai];
        }
        if (has_pf) rs_write(pf, Rn, tid);
        asm volatile("s_waitcnt lgkmcnt(0)" ::: "memory"); __builtin_amdgcn_s_barrier(); asm volatile("" ::: "memory");
        if (fr >= 14 && wr == 1) {
            float* t = HT + ((size_t)u.pm * 4 + 2 + (fr - 14)) * NUP + jc;
#pragma unroll
            for (int bj = 0; bj < 2; ++bj)
#pragma unroll
                for (int n = 0; n < 2; ++n) *(f32x4*)(t + bj * DFF + 4 * n) = acc[1][bj][3][n] * rs3[1];
            if ((u.pm & 31) == 31) { float* o = ocp + ((size_t)(u.pm >> 5) * 2 + (fr - 14)) * NUP + jc;
#pragma unroll
                for (int bj = 0; bj < 2; ++bj)
#pragma unroll
                    for (int n = 0; n < 2; ++n) *(f32x4*)(o + bj * DFF + 4 * n) = acc[1][bj][3][n] * rs3[1]; }
        }
        if (fr < 2 && wr == 0) { float* t = HT + ((size_t)u.pm * 4 + fr) * NUP + jc;
#pragma unroll
            for (int bj = 0; bj < 2; ++bj)
#pragma unroll
                for (int n = 0; n < 2; ++n) *(f32x4*)(t + bj * DFF + 4 * n) = acc[0][bj][0][n] * rs00; }
        u32x2 zp[2][2][4][2];
#pragma unroll
        for (int ai = 0; ai < 2; ++ai)
#pragma unroll
            for (int m = 0; m < 4; ++m) { const float rs = R[ai * HALF + wr * 64 + m * 16 + fr];
#pragma unroll
                for (int bj = 0; bj < 2; ++bj)
#pragma unroll
                    for (int n = 0; n < 2; ++n) { zp[ai][bj][m][n].x = cvtpk(acc[ai][bj][m][n][0] * rs, acc[ai][bj][m][n][1] * rs); zp[ai][bj][m][n].y = cvtpk(acc[ai][bj][m][n][2] * rs, acc[ai][bj][m][n][3] * rs); } }
#ifndef MK_UP_ST16
#define MK_UP_ST16 0
#endif
#if MK_UP_ST16
#pragma unroll
        for (int ai = 0; ai < 2; ++ai) {
            const int cid = 2 * ai + wr;
            u32x2 keep[4];
#pragma unroll
            for (int n = 0; n < 2; ++n) {
                f32x4 wa[3], wb[3], ba, bb;
#pragma unroll
                for (int j = 0; j < 3; ++j) { wa[j] = *(const PG8_LAS f32x4*)(CW + (j * 2 + 0) * 128 + 32 * wc + 8 * fq + 4 * n); wb[j] = *(const PG8_LAS f32x4*)(CW + (j * 2 + 1) * 128 + 32 * wc + 8 * fq + 4 * n); }
                ba = *(const PG8_LAS f32x4*)(CW + 6 * 128 + 32 * wc + 8 * fq + 4 * n); bb = *(const PG8_LAS f32x4*)(CW + 7 * 128 + 32 * wc + 8 * fq + 4 * n);
                u32x2 h1a = {0u, 0u}, h2a = h1a, h1b = h1a, h2b = h1a;
                if (cid > 0 && fr < 2) { const PG8_LAS float* hb = H + (cid - 1) * 512 + 32 * wc + 8 * fq + 4 * n;
                    const f32x4 x2a = *(const PG8_LAS f32x4*)(hb), x1a = *(const PG8_LAS f32x4*)(hb + 256), x2b = *(const PG8_LAS f32x4*)(hb + HALF), x1b = *(const PG8_LAS f32x4*)(hb + 256 + HALF);
                    h2a.x = cvtpk(x2a[0], x2a[1]); h2a.y = cvtpk(x2a[2], x2a[3]); h1a.x = cvtpk(x1a[0], x1a[1]); h1a.y = cvtpk(x1a[2], x1a[3]);
                    h2b.x = cvtpk(x2b[0], x2b[1]); h2b.y = cvtpk(x2b[2], x2b[3]); h1b.x = cvtpk(x1b[0], x1b[1]); h1b.y = cvtpk(x1b[2], x1b[3]); }
#pragma unroll
                for (int m = 0; m < 4; ++m) {
                    float g4[4];
#pragma unroll
                    for (int hx = 0; hx < 2; ++hx) {
                        const unsigned za = hx ? zp[ai][0][m][n].y : zp[ai][0][m][n].x, zb = hx ? zp[ai][1][m][n].y : zp[ai][1][m][n].x;
                        unsigned o1a, o2a, o1b, o2b;
                        if (m == 0) { const unsigned q1a = hx ? h1a.y : h1a.x, q2a = hx ? h2a.y : h2a.x, q1b = hx ? h1b.y : h1b.x, q2b = hx ? h2b.y : h2b.x; o1a = q1a; o1b = q1b; o2a = fr == 0 ? q2a : q1a; o2b = fr == 0 ? q2b : q1b; }
                        else { const unsigned pa = hx ? zp[ai][0][m - 1][n].y : zp[ai][0][m - 1][n].x, pb = hx ? zp[ai][1][m - 1][n].y : zp[ai][1][m - 1][n].x;
                            o1a = dppu<0x121>(pa, pa); o2a = dppu<0x122>(pa, pa); o1b = dppu<0x121>(pb, pb); o2b = dppu<0x122>(pb, pb); }
                        const unsigned p1a = dppu<0x111>(o1a, za), p2a = dppu<0x112>(o2a, za), p1b = dppu<0x111>(o1b, zb), p2b = dppu<0x112>(o2b, zb);
                        const int e0 = 2 * hx, e1 = 2 * hx + 1;
                        const float ca0 = ba[e0] + wa[0][e0] * bflo(p2a) + wa[1][e0] * bflo(p1a) + wa[2][e0] * bflo(za), cb0 = bb[e0] + wb[0][e0] * bflo(p2b) + wb[1][e0] * bflo(p1b) + wb[2][e0] * bflo(zb);
                        const float ca1 = ba[e1] + wa[0][e1] * bfhi(p2a) + wa[1][e1] * bfhi(p1a) + wa[2][e1] * bfhi(za), cb1 = bb[e1] + wb[0][e1] * bfhi(p2b) + wb[1][e1] * bfhi(p1b) + wb[2][e1] * bfhi(zb);
                        g4[e0] = gelu_t(ca0) * cb0; g4[e1] = gelu_t(ca1) * cb1;
                    }
                    u32x2 w2; w2.x = cvtpk(g4[0], g4[1]); w2.y = cvtpk(g4[2], g4[3]);
                    if (n == 0) keep[m] = w2;
                    else { const bool deferred = (cid == 0) && (m == 0) && (fr < 2) && ((u.pm & 31) != 0);
                        u32x4 w4; w4.x = keep[m].x; w4.y = keep[m].y; w4.z = w2.x; w4.w = w2.y;
                        if (!deferred) *(u32x4*)(G + (size_t)(row0 + ai * HALF + m * 16) * DFF + jc) = w4; }
                    __builtin_amdgcn_sched_barrier(0);
                }
            }
        }
#else
#if defined(MK_UP_MAIN_REPS)
        for (int mr_ = 0; mr_ < MK_UP_MAIN_REPS; ++mr_)
#endif
#pragma unroll
        for (int n = 0; n < 2; ++n) {
            f32x4 wa[3], wb[3], ba, bb;
#pragma unroll
            for (int j = 0; j < 3; ++j) { wa[j] = *(const PG8_LAS f32x4*)(CW + (j * 2 + 0) * 128 + 32 * wc + 8 * fq + 4 * n); wb[j] = *(const PG8_LAS f32x4*)(CW + (j * 2 + 1) * 128 + 32 * wc + 8 * fq + 4 * n); }
            ba = *(const PG8_LAS f32x4*)(CW + 6 * 128 + 32 * wc + 8 * fq + 4 * n); bb = *(const PG8_LAS f32x4*)(CW + 7 * 128 + 32 * wc + 8 * fq + 4 * n);
#if MK_DOT2
            unsigned wap[3][4], wbp[3][4];
#pragma unroll
            for (int j = 0; j < 3; ++j)
#pragma unroll
                for (int e = 0; e < 4; ++e) { wap[j][e] = (e & 1) ? cvtpk(0.f, wa[j][e]) : cvtpk(wa[j][e], 0.f); wbp[j][e] = (e & 1) ? cvtpk(0.f, wb[j][e]) : cvtpk(wb[j][e], 0.f); }
#endif
#pragma unroll
            for (int ai = 0; ai < 2; ++ai) {
                const int cid = 2 * ai + wr;
                u32x2 h1a = {0u, 0u}, h2a = h1a, h1b = h1a, h2b = h1a;
                if (cid > 0 && fr < 2) { const PG8_LAS float* hb = H + (cid - 1) * 512 + 32 * wc + 8 * fq + 4 * n;
                    const f32x4 x2a = *(const PG8_LAS f32x4*)(hb), x1a = *(const PG8_LAS f32x4*)(hb + 256), x2b = *(const PG8_LAS f32x4*)(hb + HALF), x1b = *(const PG8_LAS f32x4*)(hb + 256 + HALF);
                    h2a.x = cvtpk(x2a[0], x2a[1]); h2a.y = cvtpk(x2a[2], x2a[3]); h1a.x = cvtpk(x1a[0], x1a[1]); h1a.y = cvtpk(x1a[2], x1a[3]);
                    h2b.x = cvtpk(x2b[0], x2b[1]); h2b.y = cvtpk(x2b[2], x2b[3]); h1b.x = cvtpk(x1b[0], x1b[1]); h1b.y = cvtpk(x1b[2], x1b[3]); }
#pragma unroll
                for (int m = 0; m < 4; ++m) {
                    float g4[4];
#pragma unroll
                    for (int hx = 0; hx < 2; ++hx) {
                        const unsigned za = hx ? zp[ai][0][m][n].y : zp[ai][0][m][n].x, zb = hx ? zp[ai][1][m][n].y : zp[ai][1][m][n].x;
                        unsigned o1a, o2a, o1b, o2b;
                        if (m == 0) { const unsigned q1a = hx ? h1a.y : h1a.x, q2a = hx ? h2a.y : h2a.x, q1b = hx ? h1b.y : h1b.x, q2b = hx ? h2b.y : h2b.x; o1a = q1a; o1b = q1b; o2a = fr == 0 ? q2a : q1a; o2b = fr == 0 ? q2b : q1b; }
                        else { const unsigned pa = hx ? zp[ai][0][m - 1][n].y : zp[ai][0][m - 1][n].x, pb = hx ? zp[ai][1][m - 1][n].y : zp[ai][1][m - 1][n].x;
                            o1a = dppu<0x121>(pa, pa); o2a = dppu<0x122>(pa, pa); o1b = dppu<0x121>(pb, pb); o2b = dppu<0x122>(pb, pb); }
                        const unsigned p1a = dppu<0x111>(o1a, za), p2a = dppu<0x112>(o2a, za), p1b = dppu<0x111>(o1b, zb), p2b = dppu<0x112>(o2b, zb);
                        const int e0 = 2 * hx, e1 = 2 * hx + 1;
#if MK_DOT2
                        const float ca0 = dot2bf(za, wap[2][e0], dot2bf(p1a, wap[1][e0], dot2bf(p2a, wap[0][e0], ba[e0]))), cb0 = dot2bf(zb, wbp[2][e0], dot2bf(p1b, wbp[1][e0], dot2bf(p2b, wbp[0][e0], bb[e0])));
                        const float ca1 = dot2bf(za, wap[2][e1], dot2bf(p1a, wap[1][e1], dot2bf(p2a, wap[0][e1], ba[e1]))), cb1 = dot2bf(zb, wbp[2][e1], dot2bf(p1b, wbp[1][e1], dot2bf(p2b, wbp[0][e1], bb[e1])));
#else
                        const float ca0 = ba[e0] + wa[0][e0] * bflo(p2a) + wa[1][e0] * bflo(p1a) + wa[2][e0] * bflo(za), cb0 = bb[e0] + wb[0][e0] * bflo(p2b) + wb[1][e0] * bflo(p1b) + wb[2][e0] * bflo(zb);
                        const float ca1 = ba[e1] + wa[0][e1] * bfhi(p2a) + wa[1][e1] * bfhi(p1a) + wa[2][e1] * bfhi(za), cb1 = bb[e1] + wb[0][e1] * bfhi(p2b) + wb[1][e1] * bfhi(p1b) + wb[2][e1] * bfhi(zb);
#endif
                        g4[e0] = gelu_t(ca0) * cb0; g4[e1] = gelu_t(ca1) * cb1;
                    }
                    u32x2 w2; w2.x = cvtpk(g4[0], g4[1]); w2.y = cvtpk(g4[2], g4[3]);
                    { const bool deferred = (cid == 0) && (m == 0) && (fr < 2) && ((u.pm & 31) != 0);
                        if (!deferred) *(u32x2*)(G + (size_t)(row0 + ai * HALF + m * 16) * DFF + jc + 4 * n) = w2;
#if defined(MK_UP_ST2)
                        if (!deferred) { asm volatile("" ::: "memory"); *(u32x2*)(G + (size_t)(row0 + ai * HALF + m * 16) * DFF + jc + 4 * n) = w2; asm volatile("" ::: "memory"); }
#endif
                    }
#if MK_UP_SB == 1
                    __builtin_amdgcn_sched_barrier(0);
#elif MK_UP_SB == 2
                    if (m & 1) __builtin_amdgcn_sched_barrier(0);
#endif
                }
            }
        }
#endif
    }
};

#ifndef MK_FRESH_SKIP
#define MK_FRESH_SKIP 1
#endif
template <class Epi, class Sched>
__device__ __forceinline__ void gemm_phase(PG8_LAS unsigned char* lds, PG8_LAS unsigned char* red, const Gemm g, const Sched& S, const Epi& E, int s_wave) {
    int tid_ = tid_from_wave(s_wave); asm volatile("" : "+v"(tid_));
    const int tid = tid_, wid = __builtin_amdgcn_readfirstlane(tid >> 6), lane = tid & 63, wr = wid >> 2, wc = wid & 3, fr = lane & 15, fq = lane >> 4;
    const int K = g.K, nt = K / BK;
    unsigned voffA[2], voffB[2];
#pragma unroll
    for (int i = 0; i < 2; ++i) { int R, C; stage_rc(tid * 16 + i * 8192, R, C); const int Rb = Epi::PERM ? ((R & ~31) + perm32(R & 31)) : R;
        voffA[i] = (unsigned)(R * K + C) * 2u; voffB[i] = (unsigned)(Rb * K + C) * 2u; }
    const size_t kstep = (size_t)(BK * 2);
    const size_t hstep = (size_t)HALF * K * 2;
    const size_t tstep = 2 * hstep;
    const unsigned ldsw = (unsigned)wid * 1024u;
    const int aoff = lds_byte(wr * 64 + fr, fq * 8), boff = lds_byte(wc * 32 + fr, fq * 8);
#define PG8_SA(b, h) (((b) * 2 + (h)) * HTB)
#define PG8_SB(b, h) ((4 + (b) * 2 + (h)) * HTB)
#define PG8_STAGE(bufoff, gbase, voff) do { _Pragma("unroll") for (int _i = 0; _i < 2; ++_i) \
        __builtin_amdgcn_global_load_lds((const unsigned*)((const char*)(gbase) + (voff)[_i]), (PG8_LAS unsigned*)(lds + (bufoff) + ldsw + _i * 8192), 16, 0, 0); } while (0)
#define PG8_LDA(dst, b, h) do { _Pragma("unroll") for (int m = 0; m < 4; ++m) _Pragma("unroll") for (int k = 0; k < 2; ++k) dst[m][k] = *(const PG8_LAS bf16x8*)(lds + PG8_SA(b, h) + aoff + m * 2048 + k * 1024); } while (0)
#define PG8_LDB(dst, b, h) do { _Pragma("unroll") for (int n = 0; n < 2; ++n) _Pragma("unroll") for (int k = 0; k < 2; ++k) dst[n][k] = *(const PG8_LAS bf16x8*)(lds + PG8_SB(b, h) + boff + n * 2048 + k * 1024); } while (0)
#define PG8_MMA(ai, bj, At, Bt) do { __builtin_amdgcn_s_setprio(1); _Pragma("unroll") for (int m = 0; m < 4; ++m) _Pragma("unroll") for (int n = 0; n < 2; ++n) _Pragma("unroll") for (int k = 0; k < 2; ++k) \
        acc[ai][bj][m][n] = __builtin_amdgcn_mfma_f32_16x16x32_bf16(Bt[n][k], At[m][k], acc[ai][bj][m][n], 0, 0, 0); __builtin_amdgcn_s_setprio(0); } while (0)
#define PG8_WAIT_V(n) asm volatile("s_waitcnt vmcnt(" #n ")" ::: "memory")
#define PG8_WAIT_V8_UNLESS(f) asm volatile("s_cmp_lg_u32 %0, 0\n\ts_cbranch_scc1 .Lsk%=\n\ts_waitcnt vmcnt(8)\n.Lsk%=:" :: "s"(f) : "scc", "memory")
#define PG8_WAIT_L(n) asm volatile("s_waitcnt lgkmcnt(" #n ")" ::: "memory")
#define PG8_BAR __builtin_amdgcn_s_barrier()
#define PG8_SCHED __builtin_amdgcn_sched_barrier(0)
#if defined(MK_DUP_KLOOP)
#define PG8_NEXT(i, u) (Epi::IDEMP ? S.next((i) >> 1, u) : S.next((i), u))
#define PG8_SKIP_EPI(i) (Epi::IDEMP && (((i) & 1) == 0))
#else
#define PG8_NEXT(i, u) S.next((i), u)
#define PG8_SKIP_EPI(i) false
#endif
    Unit cur, nxt; int ui = 0;
    if (!PG8_NEXT(0, cur)) return;
    if constexpr (Epi::USES_R) E.prep(cur, red, tid);
    f32x4 acc[2][2][4][2];
#pragma unroll
    for (int a = 0; a < 2; ++a)
#pragma unroll
        for (int b = 0; b < 2; ++b)
#pragma unroll
            for (int m = 0; m < 4; ++m)
#pragma unroll
                for (int n = 0; n < 2; ++n) acc[a][b][m][n] = (f32x4){0.f, 0.f, 0.f, 0.f};
    bf16x8 At[4][2], B0[2][2], B1[2][2];
    const char* cA = (const char*)g.A + (size_t)cur.pm * tstep; const char* cB = (const char*)g.Bt + (size_t)cur.pn * tstep;
    PG8_STAGE(PG8_SB(0, 0), cB, voffB); PG8_STAGE(PG8_SB(0, 1), cB + hstep, voffB); PG8_STAGE(PG8_SA(0, 0), cA, voffA); PG8_STAGE(PG8_SA(0, 1), cA + hstep, voffA);
    if (wr == 1) PG8_BAR;
    PG8_WAIT_V(2); PG8_BAR;
    PG8_STAGE(PG8_SB(1, 0), cB + kstep, voffB); PG8_STAGE(PG8_SA(1, 0), cA + kstep, voffA); PG8_STAGE(PG8_SB(1, 1), cB + hstep + kstep, voffB);
    PG8_WAIT_V(6); PG8_BAR;
    for (;;) {
        const bool has_next = PG8_NEXT(ui + 1, nxt);
        const char* nA = has_next ? (const char*)g.A + (size_t)nxt.pm * tstep : cA; const char* nB = has_next ? (const char*)g.Bt + (size_t)nxt.pn * tstep : cB;
        for (int t = 0; t < nt; t += 2) {
            const bool last = (t == nt - 2);
            const char* a1 = cA + (size_t)(t + 1) * kstep;
            const char* a2 = last ? nA : cA + (size_t)(t + 2) * kstep; const char* b2 = last ? nB : cB + (size_t)(t + 2) * kstep;
            const char* a3 = a2 + kstep; const char* b3 = b2 + kstep;
            if constexpr (Epi::MID_T >= 0) { if (t == Epi::MID_T) E.mid(acc, cur, wr, wc, fr, fq); }
            const int fresh_ = __builtin_amdgcn_readfirstlane((MK_FRESH_SKIP && ui != 0 && t == 0) ? 1 : 0);
            PG8_LDB(B0, 0, 0); PG8_LDB(B1, 0, 1); PG8_SCHED; PG8_LDA(At, 0, 0); PG8_STAGE(PG8_SA(1, 1), a1 + hstep, voffA);
            PG8_WAIT_V8_UNLESS(fresh_); PG8_WAIT_L(0); PG8_BAR; PG8_MMA(0, 0, At, B0); PG8_MMA(0, 1, At, B1); PG8_BAR; PG8_SCHED;
            PG8_LDA(At, 0, 1); PG8_STAGE(PG8_SB(0, 0), b2, voffB); PG8_STAGE(PG8_SB(0, 1), b2 + hstep, voffB); PG8_STAGE(PG8_SA(0, 0), a2, voffA);
            PG8_WAIT_V8_UNLESS(fresh_); PG8_WAIT_L(0); PG8_BAR; PG8_MMA(1, 0, At, B0); PG8_MMA(1, 1, At, B1); PG8_BAR; PG8_SCHED;
            PG8_LDB(B0, 1, 0); PG8_LDB(B1, 1, 1); PG8_SCHED; PG8_LDA(At, 1, 0); PG8_STAGE(PG8_SA(0, 1), a2 + hstep, voffA);
            PG8_WAIT_V(8); PG8_WAIT_L(0); PG8_BAR; PG8_MMA(0, 0, At, B0); PG8_MMA(0, 1, At, B1); PG8_BAR; PG8_SCHED;
            PG8_LDA(At, 1, 1); PG8_STAGE(PG8_SB(1, 0), b3, voffB); PG8_STAGE(PG8_SB(1, 1), b3 + hstep, voffB); PG8_STAGE(PG8_SA(1, 0), a3, voffA);
            PG8_WAIT_V(8); PG8_WAIT_L(0); PG8_BAR; PG8_MMA(1, 0, At, B0); PG8_MMA(1, 1, At, B1); PG8_BAR; PG8_SCHED;
        }
        if (wr == 0) PG8_BAR;
#if MK_FRESH_SKIP
        PG8_WAIT_V(0);
#endif
        if (!PG8_SKIP_EPI(ui)) E.run(acc, cur, wr, wc, fr, fq, red, tid, has_next ? &nxt : nullptr, ui & 1);
#if defined(MK_EPI_TWICE)
        if constexpr (Epi::MID_T < 0 && Epi::IDEMP) { for (int er_ = 1; er_ < MK_EPI_TWICE; ++er_) { asm volatile("s_waitcnt lgkmcnt(0)" ::: "memory"); __builtin_amdgcn_s_barrier(); E.run(acc, cur, wr, wc, fr, fq, red, tid, has_next ? &nxt : nullptr, ui & 1); } }
#endif
        if (!has_next) break;
#pragma unroll
        for (int a = 0; a < 2; ++a)
#pragma unroll
            for (int b = 0; b < 2; ++b)
#pragma unroll
                for (int m = 0; m < 4; ++m)
#pragma unroll
                    for (int n = 0; n < 2; ++n) acc[a][b][m][n] = (f32x4){0.f, 0.f, 0.f, 0.f};
        cur = nxt; cA = nA; cB = nB; ++ui;
        if (wr == 1) PG8_BAR;
    }
    PG8_WAIT_V(0);
    PG8_BAR;
#undef PG8_SA
#undef PG8_SB
#undef PG8_STAGE
#undef PG8_LDA
#undef PG8_LDB
#undef PG8_MMA
#undef PG8_WAIT_V
#undef PG8_WAIT_V8_UNLESS
#undef PG8_WAIT_L
#undef PG8_BAR
#undef PG8_SCHED
}
template <class Epi>
__device__ __forceinline__ void gemm_phase_x(PG8_LAS unsigned char* lds, PG8_LAS unsigned char* red, const Gemm g, const Unit cur, const Epi& E, int s_wave) {
    int tid_ = tid_from_wave(s_wave); asm volatile("" : "+v"(tid_));
    const int tid = tid_, wid = __builtin_amdgcn_readfirstlane(tid >> 6), lane = tid & 63, wr = wid >> 2, wc = wid & 3, fr = lane & 15, fq = lane >> 4;
    const int K = g.K, nt = K / BK;
    unsigned voffA[2], voffB[2], voffX;
#pragma unroll
    for (int i = 0; i < 2; ++i) { int R, C; stage_rc(tid * 16 + i * 8192, R, C); const int Rb = Epi::PERM ? ((R & ~31) + perm32(R & 31)) : R;
        voffA[i] = (unsigned)(R * K + C) * 2u; voffB[i] = (unsigned)(Rb * K + C) * 2u; }
    { int R, C; stage_rc(tid * 4, R, C); voffX = (unsigned)(R * K + C) * 2u; }
    const size_t kstep = (size_t)(BK * 2);
    const size_t hstep = (size_t)HALF * K * 2;
    const size_t tstep = 2 * hstep;
    const unsigned ldsw = (unsigned)wid * 1024u;
    const int aoff = lds_byte(wr * 64 + fr, fq * 8), boff = lds_byte(wc * 32 + fr, fq * 8), xoff = lds_byte(fr, fq * 8);
    constexpr int XA_OFF = RING_BYTES + 4096;
#define PGX_SA(b, h) (((b) * 2 + (h)) * HTB)
#define PGX_SB(b, h) ((4 + (b) * 2 + (h)) * HTB)
#define PGX_STAGE(bufoff, gbase, voff) do { _Pragma("unroll") for (int _i = 0; _i < 2; ++_i) \
        __builtin_amdgcn_global_load_lds((const unsigned*)((const char*)(gbase) + (voff)[_i]), (PG8_LAS unsigned*)(lds + (bufoff) + ldsw + _i * 8192), 16, 0, 0); } while (0)
#define PGX_STAGEX(b, gbase) __builtin_amdgcn_global_load_lds((const unsigned*)((const char*)(gbase) + voffX), (PG8_LAS unsigned*)(lds + XA_OFF + (b) * 2048 + wid * 256), 4, 0, 0)
#define PGX_LDA(dst, b, h) do { _Pragma("unroll") for (int m = 0; m < 4; ++m) _Pragma("unroll") for (int k = 0; k < 2; ++k) dst[m][k] = *(const PG8_LAS bf16x8*)(lds + PGX_SA(b, h) + aoff + m * 2048 + k * 1024); } while (0)
#define PGX_LDB(dst, b, h) do { _Pragma("unroll") for (int n = 0; n < 2; ++n) _Pragma("unroll") for (int k = 0; k < 2; ++k) dst[n][k] = *(const PG8_LAS bf16x8*)(lds + PGX_SB(b, h) + boff + n * 2048 + k * 1024); } while (0)
#define PGX_LDX(dst, b) do { _Pragma("unroll") for (int k = 0; k < 2; ++k) dst[k] = *(const PG8_LAS bf16x8*)(lds + XA_OFF + (b) * 2048 + xoff + k * 1024); } while (0)
#define PGX_MMA(ai, bj, At, Bt) do { __builtin_amdgcn_s_setprio(1); _Pragma("unroll") for (int m = 0; m < 4; ++m) _Pragma("unroll") for (int n = 0; n < 2; ++n) _Pragma("unroll") for (int k = 0; k < 2; ++k) \
        acc[ai][bj][m][n] = __builtin_amdgcn_mfma_f32_16x16x32_bf16(Bt[n][k], At[m][k], acc[ai][bj][m][n], 0, 0, 0); __builtin_amdgcn_s_setprio(0); } while (0)
#define PGX_MMAX(Bt) do { _Pragma("unroll") for (int n = 0; n < 2; ++n) _Pragma("unroll") for (int k = 0; k < 2; ++k) accx[n] = __builtin_amdgcn_mfma_f32_16x16x32_bf16(Bt[n][k], Xt[k], accx[n], 0, 0, 0); } while (0)
#define PGX_WAIT_V(n) asm volatile("s_waitcnt vmcnt(" #n ")" ::: "memory")
#define PGX_WAIT_L(n) asm volatile("s_waitcnt lgkmcnt(" #n ")" ::: "memory")
#define PGX_BAR __builtin_amdgcn_s_barrier()
#define PGX_SCHED __builtin_amdgcn_sched_barrier(0)
    f32x4 acc[2][2][4][2], accx[2];
    bf16x8 At[4][2], B0[2][2], B1[2][2], Xt[2];
    const char* cA = (const char*)g.A + (size_t)cur.pm * tstep; const char* cB = (const char*)g.Bt + (size_t)cur.pn * tstep;
    const char* cX = (const char*)g.A + (size_t)(MP + 16 * cur.pm) * K * 2;
#pragma unroll
    for (int a = 0; a < 2; ++a)
#pragma unroll
        for (int b = 0; b < 2; ++b)
#pragma unroll
            for (int m = 0; m < 4; ++m)
#pragma unroll
                for (int n = 0; n < 2; ++n) acc[a][b][m][n] = (f32x4){0.f, 0.f, 0.f, 0.f};
    accx[0] = (f32x4){0.f, 0.f, 0.f, 0.f}; accx[1] = (f32x4){0.f, 0.f, 0.f, 0.f};
#ifndef MK_PRETOUCH
#define MK_PRETOUCH 0
#endif
#if MK_PRETOUCH > 0
    { const int ia = cur.pn * 512 + tid, ib = (cur.pm & 3) * 512 + tid;
      const char* pa = cA + (size_t)(ia & 255) * K * 2 + (size_t)(2 + (ia >> 8)) * kstep; const char* pb = cB + (size_t)(ib & 255) * K * 2 + (size_t)(2 + (ib >> 8)) * kstep;
      __builtin_amdgcn_global_load_lds((const unsigned*)pa, (PG8_LAS unsigned*)(lds + PGX_SB(1, 1) + wid * 256), 4, 0, 0);
      __builtin_amdgcn_global_load_lds((const unsigned*)pb, (PG8_LAS unsigned*)(lds + PGX_SB(1, 1) + 2048 + wid * 256), 4, 0, 0); }
#endif
    PGX_STAGEX(0, cX); PGX_STAGE(PGX_SB(0, 0), cB, voffB); PGX_STAGE(PGX_SB(0, 1), cB + hstep, voffB); PGX_STAGE(PGX_SA(0, 0), cA, voffA); PGX_STAGE(PGX_SA(0, 1), cA + hstep, voffA);
    if (wr == 1) PGX_BAR;
    PGX_WAIT_V(2); PGX_BAR;
    PGX_STAGEX(1, cX + kstep); PGX_STAGE(PGX_SB(1, 0), cB + kstep, voffB); PGX_STAGE(PGX_SA(1, 0), cA + kstep, voffA); PGX_STAGE(PGX_SB(1, 1), cB + hstep + kstep, voffB);
    PGX_WAIT_V(7); PGX_BAR;
#if defined(MK_X_KREPS)
    for (int t_ = 0; t_ < nt * 2; t_ += 2) { const int t = t_ >= nt ? t_ - nt : t_;
        if (t == 0 && t_ > 0) { float z0_ = 0.f; asm volatile("" : "+v"(z0_));
#pragma unroll
            for (int a = 0; a < 2; ++a)
#pragma unroll
                for (int b = 0; b < 2; ++b)
#pragma unroll
                    for (int m = 0; m < 4; ++m)
#pragma unroll
                        for (int n = 0; n < 2; ++n) acc[a][b][m][n] *= z0_;
            accx[0] *= z0_; accx[1] *= z0_; }
#else
    for (int t = 0; t < nt; t += 2) {
#endif
        const bool last = (t == nt - 2);
        const char* a1 = cA + (size_t)(t + 1) * kstep;
        const char* a2 = last ? cA : cA + (size_t)(t + 2) * kstep; const char* b2 = last ? cB : cB + (size_t)(t + 2) * kstep; const char* x2 = last ? cX : cX + (size_t)(t + 2) * kstep;
        const char* a3 = a2 + kstep; const char* b3 = b2 + kstep; const char* x3 = x2 + kstep;
        if constexpr (Epi::MID_T >= 0) { if (t == Epi::MID_T) { E.mid(acc, cur, wr, wc, fr, fq); E.midx(accx, cur, wr, wc, fr, fq); } }
        PGX_LDB(B0, 0, 0); PGX_LDB(B1, 0, 1); PGX_SCHED; PGX_LDA(At, 0, 0); PGX_LDX(Xt, 0); PGX_STAGE(PGX_SA(1, 1), a1 + hstep, voffA);
        PGX_WAIT_V(9); PGX_WAIT_L(0); PGX_BAR; PGX_MMA(0, 0, At, B0); PGX_MMA(0, 1, At, B1); if (wr == 0) PGX_MMAX(B0); else PGX_MMAX(B1); PGX_BAR; PGX_SCHED;
        PGX_LDA(At, 0, 1); PGX_STAGEX(0, x2); PGX_STAGE(PGX_SB(0, 0), b2, voffB); PGX_STAGE(PGX_SB(0, 1), b2 + hstep, voffB); PGX_STAGE(PGX_SA(0, 0), a2, voffA);
        PGX_WAIT_V(9); PGX_WAIT_L(0); PGX_BAR; PGX_MMA(1, 0, At, B0); PGX_MMA(1, 1, At, B1); PGX_BAR; PGX_SCHED;
        PGX_LDB(B0, 1, 0); PGX_LDB(B1, 1, 1); PGX_SCHED; PGX_LDA(At, 1, 0); PGX_LDX(Xt, 1); PGX_STAGE(PGX_SA(0, 1), a2 + hstep, voffA);
        PGX_WAIT_V(9); PGX_WAIT_L(0); PGX_BAR; PGX_MMA(0, 0, At, B0); PGX_MMA(0, 1, At, B1); if (wr == 0) PGX_MMAX(B0); else PGX_MMAX(B1); PGX_BAR; PGX_SCHED;
        PGX_LDA(At, 1, 1); PGX_STAGEX(1, x3); PGX_STAGE(PGX_SB(1, 0), b3, voffB); PGX_STAGE(PGX_SB(1, 1), b3 + hstep, voffB); PGX_STAGE(PGX_SA(1, 0), a3, voffA);
        PGX_WAIT_V(9); PGX_WAIT_L(0); PGX_BAR; PGX_MMA(1, 0, At, B0); PGX_MMA(1, 1, At, B1); PGX_BAR; PGX_SCHED;
    }
    if (wr == 0) PGX_BAR;
    PGX_WAIT_V(0); PGX_BAR;
    E.run(acc, cur, wr, wc, fr, fq, red, tid, nullptr, 0);
    E.runx(accx, cur, wr, wc, fr, fq, red, tid);
    PGX_BAR;
#undef PGX_SA
#undef PGX_SB
#undef PGX_STAGE
#undef PGX_STAGEX
#undef PGX_LDA
#undef PGX_LDB
#undef PGX_LDX
#undef PGX_MMA
#undef PGX_MMAX
#undef PGX_WAIT_V
#undef PGX_WAIT_L
#undef PGX_BAR
#undef PGX_SCHED
}
}

typedef GAS unsigned gu32;
#define RLX_AGENT __ATOMIC_RELAXED, __HIP_MEMORY_SCOPE_AGENT
#define LDS_WAIT() asm volatile("s_waitcnt lgkmcnt(0)" ::: "memory")
#define VM_WAIT() asm volatile("s_waitcnt vmcnt(0)" ::: "memory")

#define XB_TMO      128
#define XB_XCNT(j)  (256  + 64 * (j))
#define XB_XSUB(j)  (1280 + 64 * (j))
#define XB_XGEN(j)  (2304 + 64 * (j))
#define XB_TOP      3328
#define XB_TOPGEN   3392
#define XCD_BAR_WORDS 3456
#define XB_SPIN_CAP (1u << 18)
__device__ __forceinline__ unsigned xb_ld(unsigned* p)              { return __hip_atomic_load(p, __ATOMIC_RELAXED, __HIP_MEMORY_SCOPE_AGENT); }
__device__ __forceinline__ unsigned xb_add(unsigned* p, unsigned v) { return __hip_atomic_fetch_add(p, v, __ATOMIC_RELAXED, __HIP_MEMORY_SCOPE_AGENT); }
__device__ __forceinline__ unsigned xb_xcc_id() { return (unsigned)__builtin_amdgcn_s_getreg((3 << 11) | 20) & 0xFu; }
#define XB_SPIN(cond, bar) do { unsigned _sp = 0; while (cond) { __builtin_amdgcn_s_sleep(1); \
    if ((++_sp & 255u) == 0u) { if (xb_ld(&(bar)[XB_TMO])) break; if (_sp > XB_SPIN_CAP) { atomicAdd(&(bar)[XB_TMO], 1u); break; } } } } while (0)
struct XcdBarrier { unsigned* bar; unsigned x; volatile LAS unsigned* st; };
__device__ __forceinline__ XcdBarrier xcd_barrier_post(unsigned* bar, volatile LAS unsigned* st, bool leader) {
    XcdBarrier b; b.bar = bar; b.x = xb_xcc_id(); b.st = st;
    if (leader) (void)xb_add(&bar[XB_XCNT(b.x)], 1u);
    return b;
}
__device__ __forceinline__ void xcd_barrier_complete(unsigned* bar, unsigned x, unsigned& nloc, unsigned& nx) {
    const unsigned G = gridDim.x * gridDim.y * gridDim.z;
    unsigned sum, cnt, mine, sp = 0u;
    for (;;) {
        sum = 0u; cnt = 0u; mine = 0u;
#pragma unroll
        for (unsigned j = 0; j < 16; ++j) { const unsigned c = xb_ld(&bar[XB_XCNT(j)]); sum += c; cnt += (c > 0u) ? 1u : 0u; mine = (j == x) ? c : mine; }
        if (sum == G) break;
        __builtin_amdgcn_s_sleep(1);
        if ((++sp & 255u) == 0u) { if (xb_ld(&bar[XB_TMO])) break; if (sp > XB_SPIN_CAP) { atomicAdd(&bar[XB_TMO], 1u); break; } }
    }
    nloc = mine > 0u ? mine : 1u; nx = cnt > 0u ? cnt : 1u;
}
__device__ __forceinline__ void xcd_barrier(const XcdBarrier& b, bool leader) {
    asm volatile("s_waitcnt vmcnt(0)" ::: "memory");
    __syncthreads();
    if (leader) {
        unsigned* bar = b.bar;
        __builtin_amdgcn_s_waitcnt(0);
        unsigned nloc = b.st[0], nx = b.st[1];
        if (nloc == 0u) { xcd_barrier_complete(bar, b.x, nloc, nx); b.st[0] = nloc; b.st[1] = nx; }
        const unsigned old = xb_add(&bar[XB_XSUB(b.x)], 1u);
        const unsigned gen = old / nloc;
        if (old + 1u == (gen + 1u) * nloc) {
            __builtin_amdgcn_fence(__ATOMIC_RELEASE, "agent");
            asm volatile("s_waitcnt vmcnt(0)" ::: "memory");
            const unsigned og = xb_add(&bar[XB_TOP], 1u);
            const unsigned tg = og / nx;
            if (og + 1u == (tg + 1u) * nx) xb_add(&bar[XB_TOPGEN], 1u);
            else XB_SPIN(xb_ld(&bar[XB_TOPGEN]) == tg, bar);
            __builtin_amdgcn_fence(__ATOMIC_ACQUIRE, "agent");
            xb_add(&bar[XB_XGEN(b.x)], 1u);
            asm volatile("s_waitcnt vmcnt(0)" ::: "memory");
        } else {
            XB_SPIN(xb_ld(&bar[XB_XGEN(b.x)]) == gen, bar);
            __builtin_amdgcn_fence(__ATOMIC_ACQUIRE, "agent");
            asm volatile("s_waitcnt vmcnt(0)" ::: "memory");
        }
    }
    __syncthreads();
}

struct Frame { LAS unsigned char* lds; int tid, lane, wave, vcu, G; };
__device__ __forceinline__ Frame make_frame(LAS unsigned char* lds, int s_wave) {
    Frame F; F.lds = lds; int t = tid_from_wave(s_wave); asm volatile("" : "+v"(t)); F.tid = t; F.lane = t & 63; F.wave = __builtin_amdgcn_readfirstlane(t >> 6);
    F.G = gridDim.x; { const int bx = blockIdx.x; F.vcu = (F.G % 8 == 0) ? (bx % 8) * (F.G / 8) + bx / 8 : bx; }
    return F;
}

__device__ __forceinline__ float wave_sum(float v) {
    v = xadd<1>(v); v = xadd<2>(v); v = xadd<4>(v); v = xadd<8>(v); v = xadd<16>(v); v = xadd<32>(v);
    return v;
}

struct Ptrs {
    const float *xp, *xs, *ck, *cv, *sc, *nmix, *w_in, *sinks, *lng, *lnb, *gws, *gbs, *wpa, *wpb, *wout, *nffn, *wup, *cw, *cb, *wdn, *nfin;
    float* out; unsigned char* ws;
};

struct TItem { const float* W; bf16_t* WT; const float* gain; int N, ldt, col_off, k0, n0, n0d; };
__device__ __forceinline__ void titem_decode(const Ptrs& P, int it, TItem& t) {
    constexpr int I_IN = 16 * 160, I_PA = 16 * 32, I_PB = 12 * 32, I_OUT = 16 * 32, I_UP = 16 * 176, I_DN = 44 * 32, I_L = I_IN + I_PA + I_PB + I_OUT + I_UP + I_DN;
    const int l = it / I_L; int r = it % I_L; int remap = 0;
    if (r < I_IN) { t.W = P.w_in + (size_t)l * DM * NIN; t.N = NIN; t.WT = (bf16_t*)(P.ws + WS_WIN) + (size_t)l * NIN * DM; t.ldt = DM; t.col_off = 0; t.gain = P.nmix + l * DM; remap = 1; }
    else if ((r -= I_IN) < I_PA) { t.W = P.wpa + (size_t)l * DM * DM; t.N = DM; t.WT = (bf16_t*)(P.ws + WS_WM) + (size_t)l * DM * KM; t.ldt = KM; t.col_off = 0; t.gain = nullptr; }
    else if ((r -= I_PA) < I_PB) { t.W = P.wpb + (size_t)l * GW * DM; t.N = DM; t.WT = (bf16_t*)(P.ws + WS_WM) + (size_t)l * DM * KM; t.ldt = KM; t.col_off = 1024; t.gain = nullptr; }
    else if ((r -= I_PB) < I_OUT) { t.W = P.wout + (size_t)l * DM * DM; t.N = DM; t.WT = (bf16_t*)(P.ws + WS_WOUT) + (size_t)l * DM * DM; t.ldt = DM; t.col_off = 0; t.gain = nullptr; }
    else if ((r -= I_OUT) < I_UP) { t.W = P.wup + (size_t)l * DM * NUP; t.N = NUP; t.WT = (bf16_t*)(P.ws + WS_WUP) + (size_t)l * NUP * DM; t.ldt = DM; t.col_off = 0; t.gain = P.nffn + l * DM; remap = 2; }
    else { r -= I_UP; t.W = P.wdn + (size_t)l * DFF * DM; t.N = DM; t.WT = (bf16_t*)(P.ws + WS_WDN) + (size_t)l * DM * DFF; t.ldt = DFF; t.col_off = 0; t.gain = nullptr; }
    const int nblk = t.N / 32, kb = r / nblk, nb = r % nblk; t.k0 = 64 * kb; t.n0 = 32 * nb; t.n0d = t.n0;
    if (remap == 1 && t.n0 >= C_GA) { const int h = t.n0 >= C_GB, a = t.n0 - (h ? C_GB : C_GA); t.n0d = C_GA + 256 * (a >> 7) + 128 * h + (a & 127); }
    if (remap == 2) { const int h = t.n0 >= DFF, a = t.n0 - (h ? DFF : 0); t.n0d = 256 * (a >> 7) + 128 * h + (a & 127); }
}
__device__ __forceinline__ void titem_load(const TItem& t, f32x4 (&v)[8], int lane) {
    const float* p = t.W + (size_t)(t.k0 + (lane >> 3)) * t.N + t.n0 + (lane & 7) * 4;
#pragma unroll
#ifndef MK_WT_NT
#define MK_WT_NT 2
#endif
#if MK_WT_NT >= 1
    for (int i = 0; i < 8; ++i) v[i] = __builtin_nontemporal_load((const f32x4*)(p + (size_t)(8 * i) * t.N));
#else
    for (int i = 0; i < 8; ++i) v[i] = *(const f32x4*)(p + (size_t)(8 * i) * t.N);
#endif
}
__device__ __forceinline__ void titem_finish(const TItem& t, const f32x4 (&v)[8], LAS float* scr, int lane) {
#pragma unroll
    for (int i = 0; i < 8; ++i) { const int kk = 8 * i + (lane >> 3); const float gsc = t.gain ? t.gain[t.k0 + kk] : 1.0f; LAS float* s = scr + kk * 33 + (lane & 7) * 4;
        s[0] = v[i][0] * gsc; s[1] = v[i][1] * gsc; s[2] = v[i][2] * gsc; s[3] = v[i][3] * gsc; }
    LDS_WAIT(); asm volatile("" ::: "memory");
    const int c = lane & 7;
#pragma unroll
    for (int j = 0; j < 4; ++j) { const int n = (lane >> 3) + 8 * j; const LAS float* s = scr + (8 * c) * 33 + n;
        u32x4 o; o.x = cvtpk(s[0 * 33], s[1 * 33]); o.y = cvtpk(s[2 * 33], s[3 * 33]); o.z = cvtpk(s[4 * 33], s[5 * 33]); o.w = cvtpk(s[6 * 33], s[7 * 33]);
#if MK_WT_NT >= 2
        __builtin_nontemporal_store(o, (GAS u32x4*)(t.WT + (size_t)(t.n0d + n) * t.ldt + t.col_off + t.k0 + 8 * c)); }
#else
        *(GAS u32x4*)(t.WT + (size_t)(t.n0d + n) * t.ldt + t.col_off + t.k0 + 8 * c) = o; }
#endif
    LDS_WAIT(); asm volatile("" ::: "memory");
}
__device__ __forceinline__ void job_weights(const Ptrs& P, int l, LAS float* scr, int gw, int NGW, int lane) {
    constexpr int I_L = 8192; const int beg = l * I_L, end = beg + I_L;
    int it = beg + gw; TItem ta, tb; f32x4 va[8], vb[8];
    if (it < end) { titem_decode(P, it, ta); titem_load(ta, va, lane); }
    while (it < end) {
        const int it1 = it + NGW; if (it1 < end) { titem_decode(P, it1, tb); titem_load(tb, vb, lane); }
        titem_finish(ta, va, scr, lane);
        if (it1 >= end) break;
        const int it2 = it1 + NGW; if (it2 < end) { titem_decode(P, it2, ta); titem_load(ta, va, lane); }
        titem_finish(tb, vb, scr, lane);
        it = it2;
    }
}
__device__ __forceinline__ void job_cache_copy(const Ptrs& P, int l, int gt, int NT) {
    constexpr int PER = 7680, TOT = 2 * SB * PER;
    const float* ckl = P.ck + (size_t)l * SB * 32768; const float* cvl = P.cv + (size_t)l * SB * 32768; float* okl = P.out + O_WKS + (size_t)l * SB * 32768; float* ovl = P.out + O_WVS + (size_t)l * SB * 32768;
    for (int e0 = gt; e0 < TOT; e0 += 8 * NT) {
        f32x4 v[8];
#pragma unroll
        for (int q = 0; q < 8; ++q) { const int e = e0 + q * NT; if (e < TOT) { const int which = e >= SB * PER, r = which ? e - SB * PER : e, b = r / PER, o = r % PER; v[q] = *(const f32x4*)((which ? cvl : ckl) + (size_t)b * 32768 + 2048 + (size_t)o * 4); } }
#pragma unroll
        for (int q = 0; q < 8; ++q) { const int e = e0 + q * NT; if (e < TOT) { const int which = e >= SB * PER, r = which ? e - SB * PER : e, b = r / PER, o = r % PER; *(f32x4*)((which ? ovl : okl) + (size_t)b * 32768 + (size_t)o * 4) = v[q]; } }
    }
}

__device__ __forceinline__ void p0_prologue(LAS unsigned char* lds_, const Ptrs& P, int s_wave) {
    const Frame F = make_frame(lds_, s_wave);
    LAS float* scr = (LAS float*)(F.lds + RING_OFF + F.wave * 16384);
    const int gw = F.vcu * 8 + F.wave, NGW = F.G * 8;
    job_weights(P, 0, scr, gw, NGW, F.lane);
    { bf16_t* WSB = (bf16_t*)(P.ws + WS_WSB); const int gt = gw * 64 + F.lane, NT = NGW * 64;
      for (int e = gt; e < DEPTH * 6 * 128 * 64; e += NT) { const int s = (e & 63) * 2, t = (e >> 6) & 127; const f32x2 w = *(const f32x2*)(P.gws + (size_t)e * 2);
          *(unsigned*)(WSB + (size_t)e * 2) = cvtpk(s <= t ? w[0] : 0.f, s + 1 <= t ? w[1] : 0.f); } }
    { bf16_t* XB = (bf16_t*)(P.ws + WS_XB); float* xsq = (float*)(P.ws + WS_XSQ);
      for (int m0 = gw; m0 < M; m0 += 2 * NGW) {
          f32x4 v[2][4];
#pragma unroll
          for (int q = 0; q < 2; ++q) { const int m = m0 + q * NGW; if (m < M) { const float* src = m < MP ? P.xp + (size_t)m * DM : P.xs + (size_t)(m - MP) * DM;
#pragma unroll
              for (int j = 0; j < 4; ++j) v[q][j] = __builtin_nontemporal_load((const f32x4*)(src + 4 * F.lane + 256 * j)); } }
#pragma unroll
          for (int q = 0; q < 2; ++q) { const int m = m0 + q * NGW; if (m < M) { float s = 0.f;
#pragma unroll
              for (int j = 0; j < 4; ++j) { u32x2 w; w.x = cvtpk(v[q][j][0], v[q][j][1]); w.y = cvtpk(v[q][j][2], v[q][j][3]); *(u32x2*)(XB + (size_t)m * DM + 4 * F.lane + 256 * j) = w;
                  const float a = bflo(w.x), b = bfhi(w.x), c = bflo(w.y), d = bfhi(w.y); s += (a * a + b * b) + (c * c + d * d); }
              s = wave_sum(s);
              if (F.lane < 4) *(f32x4*)(xsq + (size_t)m * 16 + 4 * F.lane) = (f32x4){F.lane == 0 ? s : 0.f, 0.f, 0.f, 0.f}; } }
      } }
}
__device__ __forceinline__ void p1_workers(LAS unsigned char* lds_, const Ptrs& P, int l, int widx, int nworkers, int s_wave) {
    const Frame F = make_frame(lds_, s_wave);
    LAS float* scr = (LAS float*)(F.lds + RING_OFF + F.wave * 16384);
    if (l + 1 < DEPTH) job_weights(P, l + 1, scr, widx * 8 + F.wave, nworkers * 8, F.lane);
}

constexpr int AT_K = 0, AT_V = 24576, AT_BUF = 49152, AT_WS = 2 * AT_BUF, AT_OST = AT_WS + 2048;
constexpr int GM_VN = 0, GM_ST = 32768, GM_OST = 34816;
__device__ __forceinline__ f32x16 zero16() { float z = 0.f; asm volatile("" : "+v"(z)); f32x16 r;
#pragma unroll
    for (int i = 0; i < 16; ++i) r[i] = z;
    return r; }
__device__ __forceinline__ f32x16 mfma32(bf16x8 a, bf16x8 b, f32x16 c) { return __builtin_amdgcn_mfma_f32_32x32x16_bf16(a, b, c, 0, 0, 0); }
typedef short v4i16_t __attribute__((ext_vector_type(4)));
__device__ __forceinline__ s16x4 vtr(LAS const unsigned char* p) { return __builtin_bit_cast(s16x4, __builtin_amdgcn_ds_read_tr16_b64_v4i16((LAS v4i16_t*)p)); }
#define PK8(lo, hi) (bf16x8){lo[0], lo[1], lo[2], lo[3], hi[0], hi[1], hi[2], hi[3]}
__device__ __forceinline__ bf16x8 pack8(float a0, float a1, float a2, float a3, float a4, float a5, float a6, float a7) {
    u32x4 w; w.x = cvtpk(a0, a1); w.y = cvtpk(a2, a3); w.z = cvtpk(a4, a5); w.w = cvtpk(a6, a7); return __builtin_bit_cast(bf16x8, w); }

#ifndef MK_SM_PK
#define MK_SM_PK 1
#endif
__device__ __forceinline__ float softmax5(f32x16 (&p)[5], float sink2) {
    float m = sink2;
#pragma unroll
    for (int j = 0; j < 5; ++j)
#pragma unroll
        for (int r = 0; r < 16; ++r) m = fmaxf(m, p[j][r]);
    { auto rr = __builtin_amdgcn_permlane32_swap(__float_as_uint(m), __float_as_uint(m), false, false); m = fmaxf(__uint_as_float(rr[0]), __uint_as_float(rr[1])); }
    float l = 0.f;
#if MK_SM_PK
    { f32x2 l2 = {0.f, 0.f}; const f32x2 m2 = {m, m};
#pragma unroll
      for (int j = 0; j < 5; ++j)
#pragma unroll
          for (int r = 0; r < 16; r += 2) { const f32x2 d = (f32x2){p[j][r], p[j][r + 1]} - m2; f32x2 e; e[0] = __builtin_amdgcn_exp2f(d[0]); e[1] = __builtin_amdgcn_exp2f(d[1]); p[j][r] = e[0]; p[j][r + 1] = e[1]; l2 += e; }
      l = l2[0] + l2[1]; }
#else
#pragma unroll
    for (int j = 0; j < 5; ++j)
#pragma unroll
        for (int r = 0; r < 16; ++r) { p[j][r] = __builtin_amdgcn_exp2f(p[j][r] - m); l += p[j][r]; }
#endif
    { auto rr = __builtin_amdgcn_permlane32_swap(__float_as_uint(l), __float_as_uint(l), false, false); l = __uint_as_float(rr[0]) + __uint_as_float(rr[1]); }
    return l + __builtin_amdgcn_exp2f(sink2 - m);
}

__device__ __forceinline__ void attn_prompt_load(const Frame& F, const bf16_t* Z, int U, int bo, bf16x8 (&qr)[4]) {
    LAS unsigned char* lds = F.lds + bo;
    const int b = U >> 9, kvh = (U >> 7) & 3, qb = U & 127;
    const int lane = F.lane, wid = F.wave, r32 = lane & 31, hi = lane >> 5, g = wid >> 1, rh = wid & 1;
    const int pos0 = 64 * qb - 128; const size_t rowb = (size_t)b * SEQ;
#pragma unroll
    for (int tl = 0; tl < 3; ++tl) {
        int pk = pos0 + 64 * tl + lane; pk = pk < 0 ? 0 : pk;
        __builtin_amdgcn_global_load_lds((const unsigned*)(Z + (rowb + pk) * NIN + C_K + kvh * 64 + wid * 8), (LAS unsigned*)(lds + AT_K + tl * 8192 + wid * 1024), 16, 0, 0);
        int pv = pos0 + 64 * tl + 16 * (wid & 3) + (lane >> 2); pv = pv < 0 ? 0 : pv;
        __builtin_amdgcn_global_load_lds((const unsigned*)(Z + (rowb + pv) * NIN + C_V + kvh * 64 + (wid >> 2) * 32 + (lane & 3) * 8), (LAS unsigned*)(lds + AT_V + tl * 8192 + wid * 1024), 16, 0, 0);
    }
    const size_t qrow = rowb + 64 * qb + 32 * rh + r32;
#pragma unroll
    for (int d0 = 0; d0 < 4; ++d0) qr[d0] = *(const bf16x8*)(Z + qrow * NIN + C_Q + (kvh * 4 + g) * 64 + d0 * 16 + hi * 8);
}
__device__ __forceinline__ void attn_prompt_compute(const Frame& F, bf16_t* OS, float* owk, float* owv, const float* sinks_l, int U, int bo, const bf16x8 (&qr)[4]) {
    LAS unsigned char* lds = F.lds + bo;
    const int b = U >> 9, kvh = (U >> 7) & 3, qb = U & 127;
    const int lane = F.lane, wid = F.wave, r32 = lane & 31, hi = lane >> 5, g = wid >> 1, rh = wid & 1;
    const int pos0 = 64 * qb - 128; const size_t rowb = (size_t)b * SEQ;
    f32x16 p[5];
    const f32x16 Z0 = zero16();
    float ng_ = NEGBIG; asm volatile("" : "+v"(ng_));
#pragma unroll
    for (int j = 0; j < 5; ++j) {
        const int kbk = rh + j; LAS const unsigned char* kb = lds + AT_K + (kbk >> 1) * 8192 + hi * 1024 + ((kbk & 1) * 32 + r32) * 16;
        f32x16 a = Z0;
#pragma unroll
        for (int d0 = 0; d0 < 4; ++d0) a = mfma32(*(LAS const bf16x8*)(kb + d0 * 2048), qr[d0], a);
        p[j] = a;
    }
#pragma unroll
    for (int r = 0; r < 16; ++r) { const int cr = crow(r, hi); if (cr <= r32) p[0][r] = ng_; if (cr > r32) p[4][r] = ng_; }
    if (qb < 2) {
#pragma unroll
        for (int j = 0; j < 5; ++j)
#pragma unroll
            for (int r = 0; r < 16; ++r) if (pos0 + 32 * (rh + j) + crow(r, hi) < 0) p[j][r] = ng_;
    }
    const float l = softmax5(p, sinks_l[kvh * 4 + g] * LOG2E);
    f32x16 o0 = Z0, o1 = Z0;
    const int vlane = ((lane >> 4) & 1) * 32 + (lane & 3) * 8 + (4 * hi + ((lane & 15) >> 2)) * 64;
#pragma unroll
    for (int j = 0; j < 5; ++j) {
        const int kbk = rh + j;
#pragma unroll
        for (int s = 0; s < 2; ++s) {
            const bf16x8 pa = pack8(p[j][8 * s + 0], p[j][8 * s + 1], p[j][8 * s + 2], p[j][8 * s + 3], p[j][8 * s + 4], p[j][8 * s + 5], p[j][8 * s + 6], p[j][8 * s + 7]);
            LAS const unsigned char* vb = lds + AT_V + (kbk >> 1) * 8192 + (2 * (kbk & 1) + s) * 1024 + vlane;
            { const s16x4 lo = vtr(vb), hh = vtr(vb + 512); o0 = mfma32(pa, PK8(lo, hh), o0); }
            { const s16x4 lo = vtr(vb + 4096), hh = vtr(vb + 4096 + 512); o1 = mfma32(pa, PK8(lo, hh), o1); }
        }
    }
    LAS float* wsf = (LAS float*)(F.lds + AT_WS) + wid * 64;
    if (hi == 0) wsf[r32] = l;
    LDS_WAIT();
    LAS bf16_t* stg = (LAS bf16_t*)(F.lds + AT_OST) + wid * 2048;
#pragma unroll
    for (int r = 0; r < 16; ++r) { const int orow = crow(r, hi); const float rl = __builtin_amdgcn_rcpf(wsf[orow]);
        stg[orow * 64 + r32] = (bf16_t)(cvtpk(o0[r] * rl, 0.f) & 0xffffu); stg[orow * 64 + 32 + r32] = (bf16_t)(cvtpk(o1[r] * rl, 0.f) & 0xffffu); }
    LDS_WAIT();
    bf16_t* Ow = OS + (rowb + 64 * qb + 32 * rh) * KM + (kvh * 4 + g) * 64;
#pragma unroll
    for (int i = 0; i < 4; ++i) { const int row = i * 8 + (lane >> 3), ch = lane & 7; const u32x4 v = *(LAS const u32x4*)(stg + row * 64 + ch * 8); *(u32x4*)(Ow + (size_t)row * KM + ch * 8) = v; }
    if (qb >= 126) {
        const int row = F.tid & 63, c = F.tid >> 6, j = 64 * (qb - 126) + row;
        const u32x4 kk = *(LAS const u32x4*)(lds + AT_K + 2 * 8192 + c * 1024 + row * 16);
        const u32x4 vv = *(LAS const u32x4*)(lds + AT_V + 2 * 8192 + (c >> 2) * 4096 + (row >> 4) * 1024 + (row & 15) * 64 + (c & 3) * 16);
        float* dk = owk + ((size_t)(b * WIN + j)) * 256 + kvh * 64 + c * 8; float* dv = owv + ((size_t)(b * WIN + j)) * 256 + kvh * 64 + c * 8;
        *(f32x4*)dk = (f32x4){bflo(kk.x), bfhi(kk.x), bflo(kk.y), bfhi(kk.y)}; *(f32x4*)(dk + 4) = (f32x4){bflo(kk.z), bfhi(kk.z), bflo(kk.w), bfhi(kk.w)};
        *(f32x4*)dv = (f32x4){bflo(vv.x), bfhi(vv.x), bflo(vv.y), bfhi(vv.y)}; *(f32x4*)(dv + 4) = (f32x4){bflo(vv.z), bfhi(vv.z), bflo(vv.w), bfhi(vv.w)};
    }
}

constexpr int SA_K = 0, SA_V = 32768, SA_WS = 65536, SA_OST = 65536 + 2048;
__device__ __forceinline__ void sample_stage_kv(const Frame& F, const float* ck, const float* cv, float* owk, float* owv, int b, int hp) {
    LAS unsigned char* lds = F.lds;
    f32x4 kx[4][2], vx[4][2];
#pragma unroll
    for (int q = 0; q < 4; ++q) { const int idx = F.tid + 512 * q, key = idx >> 4, hl = (idx >> 3) & 1, c = idx & 7;
        const size_t off = ((size_t)(b * WIN + key) * 4 + 2 * hp + hl) * 64 + c * 8;
        kx[q][0] = *(const f32x4*)(ck + off); kx[q][1] = *(const f32x4*)(ck + off + 4); vx[q][0] = *(const f32x4*)(cv + off); vx[q][1] = *(const f32x4*)(cv + off + 4); }
#pragma unroll
    for (int q = 0; q < 4; ++q) { const int idx = F.tid + 512 * q, key = idx >> 4, hl = (idx >> 3) & 1, c = idx & 7;
        u32x4 wk, wv; wk.x = cvtpk(kx[q][0][0], kx[q][0][1]); wk.y = cvtpk(kx[q][0][2], kx[q][0][3]); wk.z = cvtpk(kx[q][1][0], kx[q][1][1]); wk.w = cvtpk(kx[q][1][2], kx[q][1][3]);
        wv.x = cvtpk(vx[q][0][0], vx[q][0][1]); wv.y = cvtpk(vx[q][0][2], vx[q][0][3]); wv.z = cvtpk(vx[q][1][0], vx[q][1][1]); wv.w = cvtpk(vx[q][1][2], vx[q][1][3]);
        *(LAS u32x4*)(lds + SA_K + hl * 16384 + (key >> 6) * 8192 + c * 1024 + (key & 63) * 16) = wk;
        *(LAS u32x4*)(lds + SA_V + hl * 16384 + (key >> 6) * 8192 + (c >> 2) * 4096 + ((key & 63) >> 4) * 1024 + (key & 15) * 64 + (c & 3) * 16) = wv;
        if (key >= 8) {
            const size_t oo = ((size_t)(b * WIN + key - 8) * 4 + 2 * hp + hl) * 64 + c * 8;
            *(f32x4*)(owk + oo) = kx[q][0]; *(f32x4*)(owk + oo + 4) = kx[q][1]; *(f32x4*)(owv + oo) = vx[q][0]; *(f32x4*)(owv + oo + 4) = vx[q][1]; } }
}
__device__ __forceinline__ void attn_sample_wave(const Frame& F, const bf16_t* Z, bf16_t* OS, float* owk, float* owv, const float* sinks_l, int b, int kvh, int hl) {
    LAS unsigned char* lds = F.lds;
    const int lane = F.lane, wid = F.wave, r32 = lane & 31, hi = lane >> 5, g = r32 >> 3, qi = r32 & 7;
    const size_t qrow = (size_t)MP + b * 8 + qi;
    bf16x8 qr[4];
#pragma unroll
    for (int d0 = 0; d0 < 4; ++d0) qr[d0] = *(const bf16x8*)(Z + qrow * NIN + C_Q + (kvh * 4 + g) * 64 + d0 * 16 + hi * 8);
    f32x16 p[5];
    float ng_ = NEGBIG; asm volatile("" : "+v"(ng_));
#pragma unroll
    for (int j = 0; j < 4; ++j) {
        LAS const unsigned char* kb = lds + SA_K + hl * 16384 + (j >> 1) * 8192 + hi * 1024 + ((j & 1) * 32 + r32) * 16;
        f32x16 a = zero16();
#pragma unroll
        for (int d0 = 0; d0 < 4; ++d0) a = mfma32(*(LAS const bf16x8*)(kb + d0 * 2048), qr[d0], a);
        p[j] = a;
    }
    { const size_t krow = (size_t)MP + b * 8 + (r32 < 8 ? r32 : 7); f32x16 a = zero16();
#pragma unroll
      for (int d0 = 0; d0 < 4; ++d0) a = mfma32(*(const bf16x8*)(Z + krow * NIN + C_K + kvh * 64 + d0 * 16 + hi * 8), qr[d0], a);
      p[4] = a; }
#pragma unroll
    for (int r = 0; r < 16; ++r) { const int cr = crow(r, hi); if (cr <= qi) p[0][r] = ng_; if (cr > qi) p[4][r] = ng_; }
    const float l = softmax5(p, sinks_l[kvh * 4 + g] * LOG2E);
    f32x16 o0 = zero16(), o1 = zero16();
    const int vlane = ((lane >> 4) & 1) * 32 + (lane & 3) * 8 + (4 * hi + ((lane & 15) >> 2)) * 64;
#pragma unroll
    for (int j = 0; j < 4; ++j)
#pragma unroll
        for (int s = 0; s < 2; ++s) {
            const bf16x8 pa = pack8(p[j][8 * s + 0], p[j][8 * s + 1], p[j][8 * s + 2], p[j][8 * s + 3], p[j][8 * s + 4], p[j][8 * s + 5], p[j][8 * s + 6], p[j][8 * s + 7]);
            LAS const unsigned char* vb = lds + SA_V + hl * 16384 + (j >> 1) * 8192 + (2 * (j & 1) + s) * 1024 + vlane;
            { const s16x4 lo = vtr(vb), hh = vtr(vb + 512); o0 = mfma32(pa, PK8(lo, hh), o0); }
            { const s16x4 lo = vtr(vb + 4096), hh = vtr(vb + 4096 + 512); o1 = mfma32(pa, PK8(lo, hh), o1); }
        }
    { const bf16x8 pa = pack8(p[4][0], p[4][1], p[4][2], p[4][3], p[4][4], p[4][5], p[4][6], p[4][7]);
      const bf16_t* vp = Z + ((size_t)MP + b * 8 + 4 * hi) * NIN + C_V + kvh * 64 + r32;
      u32x4 x = {0u, 0u, 0u, 0u}, y = {0u, 0u, 0u, 0u};
      x.x = (unsigned)vp[0] | ((unsigned)vp[NIN] << 16); x.y = (unsigned)vp[2 * NIN] | ((unsigned)vp[3 * NIN] << 16);
      y.x = (unsigned)vp[32] | ((unsigned)vp[NIN + 32] << 16); y.y = (unsigned)vp[2 * NIN + 32] | ((unsigned)vp[3 * NIN + 32] << 16);
      o0 = mfma32(pa, __builtin_bit_cast(bf16x8, x), o0); o1 = mfma32(pa, __builtin_bit_cast(bf16x8, y), o1); }
    LAS float* wsf = (LAS float*)(lds + SA_WS) + wid * 64;
    if (hi == 0) wsf[r32] = l;
    LDS_WAIT();
    LAS bf16_t* stg = (LAS bf16_t*)(lds + SA_OST) + wid * 2048;
#pragma unroll
    for (int r = 0; r < 16; ++r) { const int orow = crow(r, hi); const float rl = __builtin_amdgcn_rcpf(wsf[orow]);
        stg[orow * 64 + r32] = (bf16_t)(cvtpk(o0[r] * rl, 0.f) & 0xffffu); stg[orow * 64 + 32 + r32] = (bf16_t)(cvtpk(o1[r] * rl, 0.f) & 0xffffu); }
    LDS_WAIT();
#pragma unroll
    for (int i = 0; i < 4; ++i) { const int row = i * 8 + (lane >> 3), ch = lane & 7; const u32x4 v = *(LAS const u32x4*)(stg + row * 64 + ch * 8);
        *(u32x4*)(OS + ((size_t)MP + b * 8 + (row & 7)) * KM + (kvh * 4 + (row >> 3)) * 64 + ch * 8) = v; }
    { const int i = lane >> 3, c = (lane & 7) * 8; const bf16_t* zr = Z + ((size_t)MP + b * 8 + i) * NIN + kvh * 64 + c;
      const u32x4 kk = *(const u32x4*)(zr + C_K), vv = *(const u32x4*)(zr + C_V);
      float* dk = owk + ((size_t)(b * WIN + 120 + i)) * 256 + kvh * 64 + c; float* dv = owv + ((size_t)(b * WIN + 120 + i)) * 256 + kvh * 64 + c;
      *(f32x4*)dk = (f32x4){bflo(kk.x), bfhi(kk.x), bflo(kk.y), bfhi(kk.y)}; *(f32x4*)(dk + 4) = (f32x4){bflo(kk.z), bfhi(kk.z), bflo(kk.w), bfhi(kk.w)};
      *(f32x4*)dv = (f32x4){bflo(vv.x), bfhi(vv.x), bflo(vv.y), bfhi(vv.y)}; *(f32x4*)(dv + 4) = (f32x4){bflo(vv.z), bfhi(vv.z), bflo(vv.w), bfhi(vv.w)}; }
}

__device__ __forceinline__ void gmlp_prompt_unit(const Frame& F, const bf16_t* Z, bf16_t* OS, const float* gvst, const float* lng, const float* lnb, const bf16_t* wsb_l, const float* bs_l, int b, int ch, int g) {
    LAS unsigned char* lds = F.lds;
    const int tid = F.tid, lane = F.lane, wid = F.wave, r32 = lane & 31, hi = lane >> 5, tb = wid >> 1, chh = wid & 1;
    const size_t R0 = (size_t)b * SEQ + 128 * ch;
    LAS f32x2* st = (LAS f32x2*)(lds + GM_ST);
    f32x4 sp[6];
    if (tid < 128) { const float* pp = gvst + (R0 + tid) * 24;
#pragma unroll
        for (int k = 0; k < 6; ++k) sp[k] = *(const f32x4*)(pp + 4 * k); }
    const int c8 = (tid & 15) * 8;
    u32x4 xg[4];
#pragma unroll
    for (int it = 0; it < 4; ++it) xg[it] = *(const u32x4*)(Z + (R0 + (tid >> 4) + 32 * it) * NIN + C_GV + 128 * g + c8);
    const f32x4 g0 = *(const f32x4*)(lng + 128 * g + c8), g1 = *(const f32x4*)(lng + 128 * g + c8 + 4), b0 = *(const f32x4*)(lnb + 128 * g + c8), b1 = *(const f32x4*)(lnb + 128 * g + c8 + 4);
    const int nks = 2 * (tb + 1);
    bf16x8 wf[8];
    { const bf16_t* wrow = wsb_l + ((size_t)g * 128 + 32 * tb + r32) * 128 + 8 * hi;
#pragma unroll
      for (int ks = 0; ks < 8; ++ks) if (ks < nks) wf[ks] = *(const bf16x8*)(wrow + 16 * ks); }
    u32x4 gu[4];
#pragma unroll
    for (int i = 0; i < 4; ++i) gu[i] = *(const u32x4*)(Z + (R0 + 32 * tb + i * 8 + (lane >> 3)) * NIN + C_GU + 128 * g + 64 * chh + (lane & 7) * 8);
    float bsv[16];
#pragma unroll
    for (int r = 0; r < 16; ++r) bsv[r] = bs_l[g * 128 + 32 * tb + crow(r, hi)];
    if (tid < 128) { float s1 = 0.f, s2 = 0.f;
#pragma unroll
        for (int k = 0; k < 6; ++k) { s1 += sp[k][0] + sp[k][2]; s2 += sp[k][1] + sp[k][3]; }
        const float mean = s1 * (1.0f / GW), var = fmaxf(s2 * (1.0f / GW) - mean * mean, 0.f); st[tid] = (f32x2){mean, __builtin_amdgcn_rsqf(var + EPS)}; }
    __syncthreads();
#pragma unroll
    for (int it = 0; it < 4; ++it) {
        const int s = (tid >> 4) + 32 * it; const u32x4 x = xg[it];
        const f32x2 ms = st[s];
        const float v0 = (bflo(x.x) - ms[0]) * ms[1] * g0[0] + b0[0], v1 = (bfhi(x.x) - ms[0]) * ms[1] * g0[1] + b0[1], v2 = (bflo(x.y) - ms[0]) * ms[1] * g0[2] + b0[2], v3 = (bfhi(x.y) - ms[0]) * ms[1] * g0[3] + b0[3];
        const float v4 = (bflo(x.z) - ms[0]) * ms[1] * g1[0] + b1[0], v5 = (bfhi(x.z) - ms[0]) * ms[1] * g1[1] + b1[1], v6 = (bflo(x.w) - ms[0]) * ms[1] * g1[2] + b1[2], v7 = (bfhi(x.w) - ms[0]) * ms[1] * g1[3] + b1[3];
        u32x4 w; w.x = cvtpk(v0, v1); w.y = cvtpk(v2, v3); w.z = cvtpk(v4, v5); w.w = cvtpk(v6, v7);
        *(LAS u32x4*)(lds + GM_VN + ((c8 >> 5) * 8 + (s >> 4)) * 1024 + (s & 15) * 64 + (c8 & 31) * 2) = w;
    }
    __syncthreads();
    f32x16 a0 = zero16(), a1 = zero16();
    const int vlane = ((lane >> 4) & 1) * 32 + (lane & 3) * 8 + (8 * hi + ((lane & 15) >> 2)) * 64;
#pragma unroll
    for (int ks = 0; ks < 8; ++ks) if (ks < nks) {
        LAS const unsigned char* vb = lds + GM_VN + ((2 * chh) * 8 + ks) * 1024 + vlane;
        { const s16x4 lo = vtr(vb), hh = vtr(vb + 256); a0 = mfma32(wf[ks], PK8(lo, hh), a0); }
        { const s16x4 lo = vtr(vb + 8192), hh = vtr(vb + 8192 + 256); a1 = mfma32(wf[ks], PK8(lo, hh), a1); }
    }
    LAS bf16_t* stg = (LAS bf16_t*)(lds + GM_OST) + wid * 2048;
#pragma unroll
    for (int r = 0; r < 16; ++r) { const int orow = crow(r, hi);
        stg[orow * 64 + r32] = (bf16_t)(cvtpk(a0[r] + bsv[r], 0.f) & 0xffffu); stg[orow * 64 + 32 + r32] = (bf16_t)(cvtpk(a1[r] + bsv[r], 0.f) & 0xffffu); }
    LDS_WAIT();
#pragma unroll
    for (int i = 0; i < 4; ++i) { const int row = i * 8 + (lane >> 3), cc = (lane & 7) * 8; const u32x4 mx = *(LAS const u32x4*)(stg + row * 64 + cc);
        const size_t grow = R0 + 32 * tb + row; const u32x4 q = gu[i];
        u32x4 w; w.x = cvtpk(bflo(mx.x) * bflo(q.x), bfhi(mx.x) * bfhi(q.x)); w.y = cvtpk(bflo(mx.y) * bflo(q.y), bfhi(mx.y) * bfhi(q.y));
        w.z = cvtpk(bflo(mx.z) * bflo(q.z), bfhi(mx.z) * bfhi(q.z)); w.w = cvtpk(bflo(mx.w) * bflo(q.w), bfhi(mx.w) * bfhi(q.w));
        *(u32x4*)(OS + grow * KM + 1024 + 128 * g + 64 * chh + cc) = w; }
}

__device__ __forceinline__ void gmlp_sample_wave(const Frame& F, const bf16_t* Z, bf16_t* OS, const float* gvst, const float* lng, const float* lnb, const float* gws_l, const float* bs_l, float* ogv, int b, int c0) {
    const int lane = F.lane; const size_t R0 = (size_t)MP + b * 8;
    const int c = c0 + lane, g = c0 >> 7;
    unsigned short xv[8], xu[8];
#pragma unroll
    for (int i = 0; i < 8; ++i) { xv[i] = Z[(R0 + i) * NIN + C_GV + c]; xu[i] = Z[(R0 + i) * NIN + C_GU + c]; }
    float mean = 0.f, rstd = 0.f;
    { const float* pp = gvst + (R0 + (lane & 7)) * 24; float s1 = 0.f, s2 = 0.f;
#pragma unroll
      for (int k = 0; k < 6; ++k) { const f32x4 v = *(const f32x4*)(pp + 4 * k); s1 += v[0] + v[2]; s2 += v[1] + v[3]; }
      mean = s1 * (1.0f / GW); const float var = fmaxf(s2 * (1.0f / GW) - mean * mean, 0.f); rstd = __builtin_amdgcn_rsqf(var + EPS); }
    const float gg = lng[c], bb = lnb[c];
    float vn[8];
#pragma unroll
    for (int i = 0; i < 8; ++i) { const float mu = __uint_as_float(__builtin_amdgcn_readlane(__float_as_uint(mean), i)), rs = __uint_as_float(__builtin_amdgcn_readlane(__float_as_uint(rstd), i)); vn[i] = (bflo((unsigned)xv[i]) - mu) * rs * gg + bb; ogv[((size_t)b * 8 + i) * GW + c] = vn[i]; }
#pragma unroll
    for (int t = 0; t < 8; ++t) { float mx = bs_l[g * 128 + t];
#pragma unroll
        for (int s = 0; s <= t; ++s) mx += gws_l[(size_t)g * 16384 + t * 128 + s] * vn[s];
        OS[(R0 + t) * KM + 1024 + c] = (bf16_t)(cvtpk(bflo((unsigned)xu[t]) * mx, 0.f) & 0xffffu); }
}

__device__ __forceinline__ void p2_mixer(LAS unsigned char* lds_, const Ptrs& P, int l, int s_wave) {
    const Frame F = make_frame(lds_, s_wave);
    const bf16_t* Z = (const bf16_t*)(P.ws + WS_RA); bf16_t* OS = (bf16_t*)(P.ws + WS_RB); const float* gvst = (const float*)(P.ws + WS_GVST);
    const bf16_t* wsb_l = (const bf16_t*)(P.ws + WS_WSB) + (size_t)l * 6 * 16384;
    const float* sinks_l = P.sinks + l * 16; const float* lng = P.lng + l * GW; const float* lnb = P.lnb + l * GW; const float* bs_l = P.gbs + l * GW; const float* gws_l = P.gws + (size_t)l * 6 * 16384;
    float* owkp = P.out + O_WKP + (size_t)l * NB * WIN * 256; float* owvp = P.out + O_WVP + (size_t)l * NB * WIN * 256;
    float* owks = P.out + O_WKS + (size_t)l * SB * WIN * 256; float* owvs = P.out + O_WVS + (size_t)l * SB * WIN * 256;
    const float* ck = P.ck + (size_t)l * SB * WIN * 256; const float* cv = P.cv + (size_t)l * SB * WIN * 256; float* ogv = P.out + O_GVS + (size_t)l * SB * 8 * GW;
    constexpr int NU = 1024 + 768 + 256;
#ifndef MK_P2_REPS
#define MK_P2_REPS 1
#define MK_P2_CLASS 0
#endif
    for (int prep_ = 0; prep_ < MK_P2_REPS; ++prep_) {
    if (prep_ == 0 || (MK_P2_CLASS & 1)) {
        int U = F.vcu, bo = 0; bf16x8 qc[4], qn[4];
        __syncthreads();
#ifndef MK_P2X
#define MK_P2X 0
#endif
        constexpr int ALIM = (MK_P2X & 1) ? 2048 : 1024;
        if (U < ALIM) attn_prompt_load(F, Z, U & 1023, bo, qc);
        while (U < ALIM) {
            const int Un = U + F.G;
            VM_WAIT(); __syncthreads();
            if (Un < ALIM) attn_prompt_load(F, Z, Un & 1023, bo ^ AT_BUF, qn);
            attn_prompt_compute(F, OS, owkp, owvp, sinks_l, U & 1023, bo, qc);
#pragma unroll
            for (int d0 = 0; d0 < 4; ++d0) qc[d0] = qn[d0];
            U = Un; bo ^= AT_BUF;
        }
    }
    for (int U_ = F.vcu + ((1024 - F.vcu + F.G - 1) / F.G) * F.G; U_ < NU + ((MK_P2X & 2) ? 768 : (MK_P2X & 4) ? 256 : 0); U_ += F.G) {
        const int U = U_ < NU ? U_ : ((MK_P2X & 2) ? U_ - 1024 : U_ - 256);
        if (prep_ > 0) { const int cls = U < 1792 ? 2 : 4; if (!(cls & MK_P2_CLASS)) continue; }
        __syncthreads();
        if (false) {}
        else if (U < 1792) { const int V = U - 1024; gmlp_prompt_unit(F, Z, OS, gvst, lng, lnb, wsb_l, bs_l, V / 384, (V / 6) % 64, V % 6); }
        else { const int V = U - 1792, b = V >> 1, hp = V & 1;
            sample_stage_kv(F, ck, cv, owks, owvs, b, hp);
            LDS_WAIT(); __syncthreads();
            if (F.wave < 2) attn_sample_wave(F, Z, OS, owks, owvs, sinks_l, b, 2 * hp + F.wave, F.wave);
            else gmlp_sample_wave(F, Z, OS, gvst, lng, lnb, gws_l, bs_l, ogv, b, 384 * hp + 64 * (F.wave - 2)); }
    }
    }
}

__device__ __forceinline__ void ld8(const bf16_t* p, float (&v)[8]) { const u32x4 x = *(const u32x4*)p; v[0] = bflo(x.x); v[1] = bfhi(x.x); v[2] = bflo(x.y); v[3] = bfhi(x.y); v[4] = bflo(x.z); v[5] = bfhi(x.z); v[6] = bflo(x.w); v[7] = bfhi(x.w); }
__device__ __forceinline__ void ld8f(const float* p, float (&v)[8]) { const f32x4 a = *(const f32x4*)p, b = *(const f32x4*)(p + 4); v[0] = a[0]; v[1] = a[1]; v[2] = a[2]; v[3] = a[3]; v[4] = b[0]; v[5] = b[1]; v[6] = b[2]; v[7] = b[3]; }
__device__ __forceinline__ void st8f(float* p, const float (&v)[8]) { *(f32x4*)p = (f32x4){v[0], v[1], v[2], v[3]}; *(f32x4*)(p + 4) = (f32x4){v[4], v[5], v[6], v[7]}; }
__device__ __forceinline__ void st8f_nt(float* p, const float (&v)[8]) { __builtin_nontemporal_store((f32x4){v[0], v[1], v[2], v[3]}, (f32x4*)p); __builtin_nontemporal_store((f32x4){v[4], v[5], v[6], v[7]}, (f32x4*)(p + 4)); }
__device__ __forceinline__ void cv8(const u32x4 x, float (&v)[8]) { v[0] = bflo(x.x); v[1] = bfhi(x.x); v[2] = bflo(x.y); v[3] = bfhi(x.y); v[4] = bflo(x.z); v[5] = bfhi(x.z); v[6] = bflo(x.w); v[7] = bfhi(x.w); }
__device__ __forceinline__ u32x4 pk8f(const float* p) { const f32x4 a = *(const f32x4*)p, b = *(const f32x4*)(p + 4); u32x4 w; w.x = cvtpk(a[0], a[1]); w.y = cvtpk(a[2], a[3]); w.z = cvtpk(b[0], b[1]); w.w = cvtpk(b[2], b[3]); return w; }
__device__ __forceinline__ void p7_pre(LAS unsigned char* lds_, const Ptrs& P, int l, int pm_lo, int pm_hi, int s_wave) {
    const Frame F = make_frame(lds_, s_wave);
    const bf16_t* Z2 = (const bf16_t*)(P.ws + WS_RA); bf16_t* G = (bf16_t*)(P.ws + WS_RB); const float* HT = (const float*)(P.ws + WS_RA);
    const float* cw = P.cw + (size_t)l * 3 * NUP; const float* cb = P.cb + (size_t)l * NUP; const float* sc = P.sc + (size_t)l * SB * 2 * NUP;
    float* ocs = P.out + O_CVS + (size_t)l * SB * 2 * NUP;
    if (F.tid < 352) {
    const int c = F.tid * 8;
    float wa[3][8], wb[3][8], ba[8], bb[8];
#pragma unroll
    for (int j = 0; j < 3; ++j) { ld8f(cw + j * NUP + c, wa[j]); ld8f(cw + j * NUP + DFF + c, wb[j]); }
    ld8f(cb + c, ba); ld8f(cb + DFF + c, bb);
    for (int pm = pm_lo; pm < pm_hi; ++pm)
    for (int part = 0; part < 3; ++part) {
        if (part < 2) { const int U = 2 * pm + part;
            const int r0 = MP + U * 8;
            u32x4 ra[10], rb[10];
#pragma unroll
            for (int i = 2; i < 10; ++i) { ra[i] = *(const u32x4*)(Z2 + (size_t)(r0 + i - 2) * NUP + c); rb[i] = *(const u32x4*)(Z2 + (size_t)(r0 + i - 2) * NUP + DFF + c); }
            { const float* s0 = sc + (size_t)U * 2 * NUP; ra[0] = pk8f(s0 + c); ra[1] = pk8f(s0 + NUP + c); rb[0] = pk8f(s0 + DFF + c); rb[1] = pk8f(s0 + NUP + DFF + c); }
#pragma unroll
            for (int i = 2; i < 10; ++i) {
                float a2[8], a1[8], a0[8], b2[8], b1[8], b0[8], o[8];
                cv8(ra[i - 2], a2); cv8(ra[i - 1], a1); cv8(ra[i], a0); cv8(rb[i - 2], b2); cv8(rb[i - 1], b1); cv8(rb[i], b0);
#pragma unroll
                for (int e = 0; e < 8; ++e) { const float ca = ba[e] + wa[0][e] * a2[e] + wa[1][e] * a1[e] + wa[2][e] * a0[e], cbv = bb[e] + wb[0][e] * b2[e] + wb[1][e] * b1[e] + wb[2][e] * b0[e]; o[e] = gelu_t(ca) * cbv; }
                u32x4 w; w.x = cvtpk(o[0], o[1]); w.y = cvtpk(o[2], o[3]); w.z = cvtpk(o[4], o[5]); w.w = cvtpk(o[6], o[7]);
                *(u32x4*)(G + (size_t)(r0 + i - 2) * DFF + c) = w;
            }
            float* d = ocs + (size_t)U * 2 * NUP;
#pragma unroll
            for (int j = 0; j < 2; ++j) { float va[8], vb[8]; cv8(ra[8 + j], va); cv8(rb[8 + j], vb); st8f(d + j * NUP + c, va); st8f(d + j * NUP + DFF + c, vb); }
        } else if ((pm & 31) != 0) {
            float t0a[8], t1a[8], h0a[8], h1a[8], t0b[8], t1b[8], h0b[8], h1b[8];
            const float* tp = HT + ((size_t)(pm - 1) * 4 + 2) * NUP; const float* hp = HT + (size_t)pm * 4 * NUP;
            ld8f(tp + c, t0a); ld8f(tp + NUP + c, t1a); ld8f(hp + c, h0a); ld8f(hp + NUP + c, h1a);
            ld8f(tp + DFF + c, t0b); ld8f(tp + NUP + DFF + c, t1b); ld8f(hp + DFF + c, h0b); ld8f(hp + NUP + DFF + c, h1b);
            float o0[8], o1[8];
#pragma unroll
            for (int e = 0; e < 8; ++e) {
                const float ca0 = ba[e] + wa[0][e] * t0a[e] + wa[1][e] * t1a[e] + wa[2][e] * h0a[e], cb0 = bb[e] + wb[0][e] * t0b[e] + wb[1][e] * t1b[e] + wb[2][e] * h0b[e];
                const float ca1 = ba[e] + wa[0][e] * t1a[e] + wa[1][e] * h0a[e] + wa[2][e] * h1a[e], cb1 = bb[e] + wb[0][e] * t1b[e] + wb[1][e] * h0b[e] + wb[2][e] * h1b[e];
                o0[e] = gelu_t(ca0) * cb0; o1[e] = gelu_t(ca1) * cb1; }
            u32x4 w; w.x = cvtpk(o0[0], o0[1]); w.y = cvtpk(o0[2], o0[3]); w.z = cvtpk(o0[4], o0[5]); w.w = cvtpk(o0[6], o0[7]);
            *(u32x4*)(G + (size_t)(pm * 256) * DFF + c) = w;
            w.x = cvtpk(o1[0], o1[1]); w.y = cvtpk(o1[2], o1[3]); w.z = cvtpk(o1[4], o1[5]); w.w = cvtpk(o1[6], o1[7]);
            *(u32x4*)(G + (size_t)(pm * 256 + 1) * DFF + c) = w;
        }
    }
}
}

__device__ __forceinline__ void p_final(LAS unsigned char* lds_, const Ptrs& P, int s_wave) {
    const Frame F = make_frame(lds_, s_wave);
    float* Y = P.out + O_Y; const bf16_t* XB = (const bf16_t*)(P.ws + WS_XB); const float* xsq = (const float*)(P.ws + WS_XSQ);
    const int gw = F.vcu * 8 + F.wave, NGW = F.G * 8;
    float gn[2][8];
#pragma unroll
    for (int j = 0; j < 2; ++j) ld8f(P.nfin + 8 * F.lane + 512 * j, gn[j]);
    for (int m = gw; m < M; m += NGW) {
        float s = 0.f;
        { const f32x4 a = *(const f32x4*)(xsq + (size_t)m * 16 + 4 * (F.lane & 3)); s = (a[0] + a[1]) + (a[2] + a[3]); s = xadd<1>(s); s = xadd<2>(s); }
        const float rs = __builtin_amdgcn_rsqf(s * (1.0f / DM) + EPS);
#pragma unroll
        for (int j = 0; j < 2; ++j) { float v[8]; ld8(XB + (size_t)m * DM + 8 * F.lane + 512 * j, v);
#pragma unroll
            for (int e = 0; e < 8; ++e) v[e] = v[e] * rs * gn[j][e];
            st8f_nt(Y + (size_t)m * DM + 8 * F.lane + 512 * j, v); }
    }
}

struct SFrag { bf16x8 a[4], b[4]; };
__device__ __forceinline__ void small_ld(SFrag& f, const bf16_t* ap, const bf16_t* bp, size_t lda16, size_t ldb16) {
#pragma unroll
    for (int i = 0; i < 4; ++i) { f.a[i] = *(const bf16x8*)(ap + i * lda16); f.b[i] = *(const bf16x8*)(bp + i * ldb16); }
}
__device__ __forceinline__ void small_mma(f32x4 (&acc)[4][4], const SFrag& f) {
#pragma unroll
    for (int i = 0; i < 4; ++i)
#pragma unroll
        for (int j = 0; j < 4; ++j) acc[i][j] = __builtin_amdgcn_mfma_f32_16x16x32_bf16(f.a[i], f.b[j], acc[i][j], 0, 0, 0);
}
__device__ __forceinline__ void small_kslice(f32x4 (&acc)[4][4], const bf16_t* A, int lda, const bf16_t* Bt, int ldb, int k0, int nks, int lane) {
    const bf16_t* ap = A + (size_t)(lane & 15) * lda + k0 + 8 * (lane >> 4); const bf16_t* bp = Bt + (size_t)(lane & 15) * ldb + k0 + 8 * (lane >> 4);
    const size_t lda16 = (size_t)16 * lda, ldb16 = (size_t)16 * ldb;
    for (int s = 0; s < nks; s += 4) {
        SFrag f0, f1, f2, f3;
        small_ld(f0, ap + 32 * s, bp + 32 * s, lda16, ldb16);
        if (s + 1 < nks) small_ld(f1, ap + 32 * (s + 1), bp + 32 * (s + 1), lda16, ldb16);
        if (s + 2 < nks) small_ld(f2, ap + 32 * (s + 2), bp + 32 * (s + 2), lda16, ldb16);
        if (s + 3 < nks) small_ld(f3, ap + 32 * (s + 3), bp + 32 * (s + 3), lda16, ldb16);
        __builtin_amdgcn_sched_barrier(0);
        small_mma(acc, f0);
        if (s + 1 < nks) small_mma(acc, f1);
        if (s + 2 < nks) small_mma(acc, f2);
        if (s + 3 < nks) small_mma(acc, f3);
    }
}
__device__ __forceinline__ void small_zero(f32x4 (&acc)[4][4]) { float z = 0.f; asm volatile("" : "+v"(z));
#pragma unroll
    for (int i = 0; i < 4; ++i)
#pragma unroll
        for (int j = 0; j < 4; ++j) acc[i][j] = (f32x4){z, z, z, z}; }
__device__ __forceinline__ void small_reduce(LAS unsigned char* ring, const f32x4 (&acc)[4][4], const Frame& F, float (&out)[8]) {
    LAS float* slab = (LAS float*)(ring + F.wave * 16384);
    const int rq = 4 * (F.lane >> 4), cl = F.lane & 15;
#pragma unroll
    for (int i = 0; i < 4; ++i)
#pragma unroll
        for (int j = 0; j < 4; ++j)
#pragma unroll
            for (int r = 0; r < 4; ++r) slab[(16 * i + rq + r) * 64 + 16 * j + cl] = acc[i][j][r];
    LDS_WAIT(); __syncthreads();
    const int row = F.tid >> 3, c8 = (F.tid & 7) * 8;
#pragma unroll
    for (int e = 0; e < 8; ++e) out[e] = 0.f;
#pragma unroll
    for (int w = 0; w < 8; ++w) { const f32x4 x = *(LAS const f32x4*)(ring + w * 16384 + (row * 64 + c8) * 4), y = *(LAS const f32x4*)(ring + w * 16384 + (row * 64 + c8) * 4 + 16);
        out[0] += x[0]; out[1] += x[1]; out[2] += x[2]; out[3] += x[3]; out[4] += y[0]; out[5] += y[1]; out[6] += y[2]; out[7] += y[3]; }
    LDS_WAIT(); __syncthreads();
}
__device__ __forceinline__ void small_resid(LAS unsigned char* lds_, const bf16_t* A, int K, const bf16_t* Bt, bf16_t* XB, float* xsq, int s_wave) {
    const Frame F = make_frame(lds_, s_wave);
    for (int t = F.vcu; t < 256; t += F.G) {
        const int rb = 4 * (t >> 6) + ((t >> 3) & 3), cb = 8 * ((t >> 5) & 1) + (t & 7);
        f32x4 acc[4][4]; small_zero(acc);
        small_kslice(acc, A + (size_t)(MP + 64 * rb) * K, K, Bt + (size_t)(64 * cb) * K, K, F.wave * (K / 8), K / 256, F.lane);
        float o[8]; small_reduce(lds_ + RING_OFF, acc, F, o);
        const int row = MP + 64 * rb + (F.tid >> 3), c8 = 64 * cb + (F.tid & 7) * 8;
        float xo[8]; ld8(XB + (size_t)row * DM + c8, xo);
        u32x4 w; float ss = 0.f;
        { const unsigned r0 = cvtpk(xo[0] + o[0], xo[1] + o[1]), r1 = cvtpk(xo[2] + o[2], xo[3] + o[3]), r2 = cvtpk(xo[4] + o[4], xo[5] + o[5]), r3 = cvtpk(xo[6] + o[6], xo[7] + o[7]);
          w.x = r0; w.y = r1; w.z = r2; w.w = r3;
          ss = (bflo(r0) * bflo(r0) + bfhi(r0) * bfhi(r0)) + (bflo(r1) * bflo(r1) + bfhi(r1) * bfhi(r1)) + (bflo(r2) * bflo(r2) + bfhi(r2) * bfhi(r2)) + (bflo(r3) * bflo(r3) + bfhi(r3) * bfhi(r3)); }
        *(u32x4*)(XB + (size_t)row * DM + c8) = w;
        ss = xadd<1>(ss); ss = xadd<2>(ss); ss = xadd<4>(ss);
        if ((F.tid & 7) == 0) xsq[(size_t)row * 16 + cb] = ss;
    }
}
__device__ __forceinline__ void small_merge(LAS unsigned char* lds_, const bf16_t* OS, const bf16_t* WMl, const bf16_t* Z, bf16_t* MG, int s_wave) {
    const Frame F = make_frame(lds_, s_wave);
    for (int t = F.vcu; t < 256; t += F.G) {
        const int rb = 4 * (t >> 6) + ((t >> 3) & 3), cb = 8 * ((t >> 5) & 1) + (t & 7);
        const bf16_t* A = OS + (size_t)(MP + 64 * rb) * KM; const bf16_t* Bt = WMl + (size_t)(64 * cb) * KM;
        float o[8], s[8];
        { f32x4 acc[4][4]; small_zero(acc); small_kslice(acc, A, KM, Bt, KM, F.wave * 128, 4, F.lane); small_reduce(lds_ + RING_OFF, acc, F, o); }
        { f32x4 acc[4][4]; small_zero(acc); small_kslice(acc, A, KM, Bt, KM, 1024 + F.wave * 96, 3, F.lane); small_reduce(lds_ + RING_OFF, acc, F, s); }
        const int row = MP + 64 * rb + (F.tid >> 3), c8 = 64 * cb + (F.tid & 7) * 8;
        float ga[8], gb[8]; { const int gc = C_GA + 256 * (c8 >> 7) + (c8 & 127); ld8(Z + (size_t)row * NIN + gc, ga); ld8(Z + (size_t)row * NIN + gc + 128, gb); }
        u32x4 w; w.x = cvtpk(gb[0] * (ga[0] * o[0] + s[0]), gb[1] * (ga[1] * o[1] + s[1])); w.y = cvtpk(gb[2] * (ga[2] * o[2] + s[2]), gb[3] * (ga[3] * o[3] + s[3]));
        w.z = cvtpk(gb[4] * (ga[4] * o[4] + s[4]), gb[5] * (ga[5] * o[5] + s[5])); w.w = cvtpk(gb[6] * (ga[6] * o[6] + s[6]), gb[7] * (ga[7] * o[7] + s[7]));
        *(u32x4*)(MG + (size_t)row * DM + c8) = w;
    }
}

struct Args { const float* in[21]; float* out; unsigned char* ws; int ph_lo, ph_hi; };
static_assert(offsetof(Args, out) == 21 * 8 && offsetof(Args, ws) == 22 * 8, "Args layout");
__global__ void __launch_bounds__(512, 2) mk_fwd(Args args) {
    extern __shared__ __attribute__((aligned(16))) unsigned char lds_raw[];
    LAS unsigned char* const lds = (LAS unsigned char*)lds_raw; const int G = gridDim.x;
    volatile LAS unsigned* MISC = (volatile LAS unsigned*)(lds + MISC_OFF);
    const int s_wave = __builtin_amdgcn_readfirstlane((int)threadIdx.x >> 6);
    for (int u = tid_from_wave(s_wave); u < (LDS_BYTES - LDSCTL_OFF) / 4; u += 512) ((LAS unsigned*)(lds + LDSCTL_OFF))[u] = 0u;
    __syncthreads();
    const int lo = args.ph_lo, hi = args.ph_hi;
    XcdBarrier bar; bar.bar = (unsigned*)(args.ws + WS_CTL) + 4096; bar.x = 0; bar.st = nullptr;
    if (hi - lo > 1) bar = xcd_barrier_post((unsigned*)(args.ws + WS_CTL) + 4096, MISC + 8, tid_from_wave(s_wave) == 0);
    LAS unsigned char* ring = lds + RING_OFF; LAS unsigned char* red = lds + RED_OFF;
    for (int ph = lo; ph < hi; ++ph) {
        int z_ = 0; asm volatile("" : "+s"(z_));
        Ptrs P; P.xp = args.in[0 + z_]; P.xs = args.in[1 + z_]; P.ck = args.in[2 + z_]; P.cv = args.in[3 + z_]; P.sc = args.in[4 + z_]; P.nmix = args.in[5 + z_]; P.w_in = args.in[6 + z_]; P.sinks = args.in[7 + z_];
        P.lng = args.in[8 + z_]; P.lnb = args.in[9 + z_]; P.gws = args.in[10 + z_]; P.gbs = args.in[11 + z_]; P.wpa = args.in[12 + z_]; P.wpb = args.in[13 + z_]; P.wout = args.in[14 + z_]; P.nffn = args.in[15 + z_];
        P.wup = args.in[16 + z_]; P.cw = args.in[17 + z_]; P.cb = args.in[18 + z_]; P.wdn = args.in[19 + z_]; P.nfin = args.in[20 + z_]; P.out = (float*)args.in[21 + z_]; P.ws = (unsigned char*)args.in[22 + z_];
        bf16_t* XB = (bf16_t*)(P.ws + WS_XB); float* xsq = (float*)(P.ws + WS_XSQ);
#if defined(MK_REP_K)
      const int nrep_ = ((ph == 0 && MK_REP_K == 100) || (ph > 0 && ph < NPH - 1 && (ph - 1) % 6 == MK_REP_K)) ? MK_REP_N : 1;
      for (int rep_ = 0; rep_ < nrep_; ++rep_) {
        if (rep_ > 0) xcd_barrier(bar, tid_from_wave(s_wave) == 0);
#endif
#if defined(MK_REP_K)
        bf16_t* XBo = rep_ > 0 ? (bf16_t*)(P.ws + ((size_t)460 << 20)) : XB; float* xsqo = rep_ > 0 ? (float*)(P.ws + ((size_t)500 << 20)) : xsq;
#else
        bf16_t* XBo = XB; float* xsqo = xsq;
#endif
        if (ph == 0) p0_prologue(lds, P, s_wave);
        else if (ph == NPH - 1) p_final(lds, P, s_wave);
        else {
            const int l = (ph - 1) / 6, k = (ph - 1) % 6;
            if (k == 0) { const int NGm = G - NWORKERS;
                if ((int)blockIdx.x < NGm) { pg8::Gemm g{XB, (const bf16_t*)(P.ws + WS_WIN) + (size_t)l * NIN * DM, M, NIN, DM}; pg8::StaticOrder S; S.init(M, NIN, NGm, (int)blockIdx.x);
                    pg8::EpiAct E{(bf16_t*)(P.ws + WS_RA), NIN, xsq, (float*)(P.ws + WS_GVST), 1}; pg8::gemm_phase(ring, red, g, S, E, s_wave); }
#if defined(MK_REP_K) && defined(MK_WORK_ONCE)
                else if (rep_ == 0) p1_workers(lds, P, l, (int)blockIdx.x - NGm, NWORKERS, s_wave); }
#else
                else p1_workers(lds, P, l, (int)blockIdx.x - NGm, NWORKERS, s_wave); }
#endif
            else if (k == 1) p2_mixer(lds, P, l, s_wave);
            else if (k == 2) { pg8::Gemm g{(const bf16_t*)(P.ws + WS_RB), (const bf16_t*)(P.ws + WS_WM) + (size_t)l * DM * KM, MP, DM, KM}; pg8::StaticOrder S; S.init(MP, DM, G, (int)blockIdx.x);
                pg8::EpiMerge E{(const bf16_t*)(P.ws + WS_RA), (bf16_t*)(P.ws + WS_MG)};
                if (G == 256) { pg8::Unit u; S.next(0, u); pg8::gemm_phase_x(ring, red, g, u, E, s_wave); }
                else { pg8::gemm_phase(ring, red, g, S, E, s_wave);
                    small_merge(lds, (const bf16_t*)(P.ws + WS_RB), (const bf16_t*)(P.ws + WS_WM) + (size_t)l * DM * KM, (const bf16_t*)(P.ws + WS_RA), (bf16_t*)(P.ws + WS_MG), s_wave); } }
            else if (k == 3) { pg8::Gemm g{(const bf16_t*)(P.ws + WS_MG), (const bf16_t*)(P.ws + WS_WOUT) + (size_t)l * DM * DM, MP, DM, DM}; pg8::StaticOrder S; S.init(MP, DM, G, (int)blockIdx.x);
                pg8::EpiResid E{XBo, xsqo};
                if (G == 256) { pg8::Unit u; S.next(0, u); pg8::gemm_phase_x(ring, red, g, u, E, s_wave); }
                else { pg8::gemm_phase(ring, red, g, S, E, s_wave); small_resid(lds, (const bf16_t*)(P.ws + WS_MG), DM, (const bf16_t*)(P.ws + WS_WOUT) + (size_t)l * DM * DM, XBo, xsqo, s_wave); } }
            else if (k == 4) { pg8::Gemm g{XB, (const bf16_t*)(P.ws + WS_WUP) + (size_t)l * NUP * DM, M, NUP, DM}; pg8::StaticOrder S; S.init(M, NUP, G, (int)blockIdx.x);
                pg8::EpiUp E{P.ws, P.cw + (size_t)l * 3 * NUP, P.cb + (size_t)l * NUP, P.out + O_CVP + (size_t)l * NB * 2 * NUP};
                pg8::gemm_phase(ring, red, g, S, E, s_wave); }
            else { if (G == 256) { pg8::StaticOrder S0; S0.init(MP, DM, G, (int)blockIdx.x); pg8::Unit u0; S0.next(0, u0); p7_pre(lds, P, l, u0.pm, u0.pm + 1, s_wave); } else p7_pre(lds, P, l, 0, MP / 256, s_wave);
                VM_WAIT(); __syncthreads();
                pg8::Gemm g{(const bf16_t*)(P.ws + WS_RB), (const bf16_t*)(P.ws + WS_WDN) + (size_t)l * DM * DFF, MP, DM, DFF}; pg8::StaticOrder S; S.init(MP, DM, G, (int)blockIdx.x);
                pg8::EpiResid E{XBo, xsqo};
                if (G == 256) { pg8::Unit u; S.next(0, u); pg8::gemm_phase_x(ring, red, g, u, E, s_wave); }
                else { pg8::gemm_phase(ring, red, g, S, E, s_wave); small_resid(lds, (const bf16_t*)(P.ws + WS_RB), DFF, (const bf16_t*)(P.ws + WS_WDN) + (size_t)l * DM * DFF, XBo, xsqo, s_wave); } }
        }
#if defined(MK_REP_K)
      }
#endif
        if (ph + 1 < hi) xcd_barrier(bar, tid_from_wave(s_wave) == 0);
#if defined(MK_BAR_TWICE)
        for (int bb_ = 1; bb_ < MK_BAR_TWICE; ++bb_) if (ph + 1 < hi) xcd_barrier(bar, tid_from_wave(s_wave) == 0);
#endif
    }
}

extern "C" void kernel_launch(void* const* d_in, const int* in_sizes, int n_in, void* d_out, int out_size, void* d_ws, size_t ws_size, hipStream_t stream) {
    static int grid = 0;
    if (grid == 0) {
        if (n_in != 21 || out_size != (int)O_END || ws_size < WS_END) { fprintf(stderr, "kernel_launch: unexpected shapes: n_in %d out %d ws %zu (need %zu)\n", n_in, out_size, ws_size, (size_t)WS_END); grid = -1; return; }
        int dev = 0, cus = 0, per_cu = 0;
        if (hipGetDevice(&dev) != hipSuccess || hipDeviceGetAttribute(&cus, hipDeviceAttributeMultiprocessorCount, dev) != hipSuccess) { grid = -1; return; }
        if (hipFuncSetAttribute((const void*)mk_fwd, hipFuncAttributeMaxDynamicSharedMemorySize, LDS_BYTES) != hipSuccess) { fprintf(stderr, "kernel_launch: hipFuncSetAttribute failed\n"); grid = -1; return; }
        if (hipOccupancyMaxActiveBlocksPerMultiprocessor(&per_cu, (const void*)mk_fwd, 512, LDS_BYTES) != hipSuccess || per_cu < 1) { fprintf(stderr, "kernel_launch: occupancy query says %d blocks/CU\n", per_cu); per_cu = 1; }
        (void)hipGetLastError();
        grid = cus;
    }
    if (grid < 0) return;
    (void)hipMemsetAsync((char*)d_ws + WS_CTL, 0, CTL_ZERO_BYTES, stream);
    Args a{};
    for (int i = 0; i < 21; ++i) a.in[i] = (const float*)d_in[i];
    a.out = (float*)d_out; a.ws = (unsigned char*)d_ws;
#if MK_ONE_LAUNCH
    a.ph_lo = 0; a.ph_hi = NPH;
    void* kargs[] = {&a};
    hipError_t e = hipLaunchCooperativeKernel((const void*)mk_fwd, dim3(grid), dim3(512), kargs, LDS_BYTES, stream);
    if (e != hipSuccess) fprintf(stderr, "kernel_launch: cooperative launch failed: %s\n", hipGetErrorString(e));
#else
    for (int ph = 0; ph < NPH; ++ph) { a.ph_lo = ph; a.ph_hi = ph + 1; hipLaunchKernelGGL(mk_fwd, dim3(grid), dim3(512), LDS_BYTES, stream, a); }
#endif
}
```

```cpp
#include <hip/hip_runtime.h>
#include <cstdio>
#include <cstdint>
#include <cstddef>

#ifndef MK_ONE_LAUNCH
#define MK_ONE_LAUNCH 1
#endif

#define LAS __attribute__((address_space(3)))
#define GAS __attribute__((address_space(1)))
typedef unsigned short bf16_t;
typedef short bf16x8 __attribute__((ext_vector_type(8)));
typedef short s16x4 __attribute__((ext_vector_type(4)));
typedef float f32x2 __attribute__((ext_vector_type(2)));
typedef float f32x4 __attribute__((ext_vector_type(4)));
typedef float f32x16 __attribute__((ext_vector_type(16)));
typedef unsigned u32x2 __attribute__((ext_vector_type(2)));
typedef unsigned u32x4 __attribute__((ext_vector_type(4)));
typedef __bf16 bf16x2_t __attribute__((ext_vector_type(2)));

constexpr int DM = 1024, NB = 2, SEQ = 8192, DEPTH = 4, SB = 128, ST = 8, WIN = 128;
constexpr int MP = NB * SEQ, MS = SB * ST, M = MP + MS;
constexpr int NIN = 5120, C_Q = 0, C_K = 1024, C_V = 1280, C_GU = 1536, C_GV = 2304, C_GA = 3072, C_GB = 4096;
constexpr int KM = 1792, NUP = 5632, DFF = 2816, GW = 768;
constexpr float EPS = 1e-5f, LOG2E = 1.4426950408889634f, C2 = 0.125f * 1.4426950408889634f, NEGBIG = -1e30f;
#ifndef MK_NWORKERS
#define MK_NWORKERS 24
#endif
constexpr int NPH = 26, NWORKERS = MK_NWORKERS;

constexpr size_t O_Y = 0, O_WKP = 17825792, O_WVP = 18087936, O_CVP = 18350080, O_WKS = 18440192, O_WVS = 35217408, O_CVS = 51994624, O_GVS = 57761792, O_END = 60907520;

constexpr size_t MiB = 1u << 20;
constexpr size_t WS_CTL = 0, CTL_ZERO_BYTES = 64 * 1024, WS_XSQ = 1 * MiB  , WS_GVST = 2 * MiB + 512 * 1024, WS_WSB = 5 * MiB, WS_WIN = 8 * MiB, WS_WM = 48 * MiB, WS_WOUT = 62 * MiB,
                 WS_WUP = 70 * MiB, WS_WDN = 114 * MiB, WS_XB = 136 * MiB, WS_RA = 170 * MiB, WS_RB = 357 * MiB, WS_MG = WS_RB + 60 * MiB, WS_END = 451 * MiB;
static_assert((size_t)M * NUP * 2 <= WS_RB - WS_RA && (size_t)M * DFF * 2 <= WS_END - WS_RB && (size_t)M * KM * 2 <= 60 * MiB && WS_MG + (size_t)M * DM * 2 <= WS_END, "ws map");

constexpr int RING_OFF = 0, RING_BYTES = 131072, RED_OFF = RING_BYTES, RED_BYTES = 20480, LDSCTL_OFF = RED_OFF + RED_BYTES, MISC_OFF = LDSCTL_OFF + 320, LDS_BYTES = 155648;

__device__ __forceinline__ unsigned cvtpk(float lo, float hi) { f32x2 v = {lo, hi}; bf16x2_t b = __builtin_convertvector(v, bf16x2_t); return __builtin_bit_cast(unsigned, b); }
__device__ __forceinline__ float bflo(unsigned u) { return __uint_as_float(u << 16); }
__device__ __forceinline__ float bfhi(unsigned u) { return __uint_as_float(u & 0xffff0000u); }
__device__ __forceinline__ float gelu_t(float x) { const float t = x * (-2.302208198f + -0.1029432398f * x * x); return x * __builtin_amdgcn_rcpf(1.0f + __builtin_amdgcn_exp2f(t)); }
__device__ __forceinline__ float sigm(float x) { return __builtin_amdgcn_rcpf(1.0f + __builtin_amdgcn_exp2f(-LOG2E * x)); }
__device__ __forceinline__ int crow(int r, int hi) { return (r & 3) + 8 * (r >> 2) + 4 * hi; }
template <int MASK> __device__ __forceinline__ float xadd(float v) {
    if constexpr (MASK == 32) { auto rr = __builtin_amdgcn_permlane32_swap(__float_as_uint(v), __float_as_uint(v), false, false); return __uint_as_float(rr[0]) + __uint_as_float(rr[1]); }
    else return v + __int_as_float(__builtin_amdgcn_ds_swizzle(__float_as_int(v), (MASK << 10) | 0x1f));
}
__device__ __forceinline__ int tid_from_wave(int s_wave) { int lane; asm volatile("v_mbcnt_lo_u32_b32 %0, -1, 0\n\tv_mbcnt_hi_u32_b32 %0, -1, %0" : "=v"(lane)); return s_wave * 64 + lane; }

namespace pg8 {
#define PG8_LAS __attribute__((address_space(3)))
constexpr int BM = 256, BK = 64, HALF = 128, HTB = HALF * BK * 2  , STAGE_BYTES = 8 * HTB, NXCD = 8, WGM = 8;
__host__ __device__ __forceinline__ int lds_byte(int r, int c) { const int st = (r >> 4) * 2 + (c >> 5), rr = r & 15, cc = c & 31, ob = rr * 64 + cc * 2; return st * 1024 + (ob ^ (((ob >> 9) & 1) << 5)); }
__host__ __device__ __forceinline__ void stage_rc(int b, int& R, int& C) { const int st = b / 1024, sb = b % 1024, swz = sb ^ (((sb >> 9) & 1) << 5); R = (st >> 1) * 16 + swz / 64; C = (st & 1) * 32 + (swz % 64) / 2; }
__host__ __device__ __forceinline__ int perm32(int rho) { const int n = rho >> 4, i = rho & 15; return 8 * (i >> 2) + 4 * n + (i & 3); }

struct Unit { int pm, pn; };
struct Gemm { const bf16_t* A; const bf16_t* Bt; int M, N, K; };
struct StaticOrder {
    int nM, nN, nwg, G, c;
    __host__ __device__ void init(int M_, int N_, int G_, int c_) { nM = M_ / BM; nN = N_ / BM; nwg = nM * nN; G = G_; c = c_; }
    __host__ __device__ bool next(int i, Unit& u) const {
        const long L = (long)i * G + c; if (L >= nwg) return false;
        int wgid = (int)L; { const int q = nwg / NXCD, r = nwg % NXCD, xcd = wgid % NXCD, off = wgid / NXCD; wgid = (xcd < r ? xcd * (q + 1) : r * (q + 1) + (xcd - r) * q) + off; }
        const int nig = WGM * nN, gid = wgid / nig, fm = gid * WGM, gsz = (nM - fm) < WGM ? (nM - fm) : WGM;
        u.pm = fm + ((wgid % nig) % gsz); u.pn = (wgid % nig) / gsz; return true;
    }
};


struct RsPf { f32x4 a, b; };
__device__ __forceinline__ void rs_issue(RsPf& p, const float* xsq, int pm, int tid) { const float* q = xsq + (size_t)(pm * BM + (tid >> 1)) * 16 + 8 * (tid & 1); p.a = *(const f32x4*)q; p.b = *(const f32x4*)(q + 4); }
__device__ __forceinline__ void rs_write(const RsPf& p, PG8_LAS float* R, int tid) {
    float s = ((p.a[0] + p.a[1]) + (p.a[2] + p.a[3])) + ((p.b[0] + p.b[1]) + (p.b[2] + p.b[3])); s = xadd<1>(s);
    if ((tid & 1) == 0) R[tid >> 1] = __builtin_amdgcn_rsqf(s * (1.0f / DM) + EPS);
}
struct EpiAct {
    static constexpr bool PERM = true, IDEMP = true; static constexpr int MID_T = -1;
    bf16_t* O; int ldc; const float* xsq; float* gvst; int mode;
    __device__ __forceinline__ void mid(f32x4 (&)[2][2][4][2], const Unit&, int, int, int, int) const {}
    template <int KIND> __device__ __forceinline__ void body(const f32x4 (&acc)[2][2][4][2], const Unit& u, int wr, int wc, int fr, int fq, const PG8_LAS float* R) const {
        const int row0 = u.pm * BM + wr * 64 + fr, col0 = u.pn * BM + wc * 32 + 8 * fq;
#pragma unroll
        for (int ai = 0; ai < 2; ++ai)
#pragma unroll
            for (int m = 0; m < 4; ++m) {
                const int row = row0 + ai * HALF + m * 16;
                float rs = R[ai * HALF + wr * 64 + m * 16 + fr];
                if (KIND == 0) rs *= C2;
                float s1 = 0.f, s2 = 0.f;
                bf16_t* rowp = O + (size_t)row * ldc + col0;
                float v[2][8];
#pragma unroll
                for (int bj = 0; bj < 2; ++bj)
#pragma unroll
                    for (int e = 0; e < 8; ++e) { float x = acc[ai][bj][m][e >> 2][e & 3] * rs;
                        if (KIND == 2 || KIND == 3) x = gelu_t(x);
                        if (KIND == 4) x = fminf(1.0f + __builtin_amdgcn_exp2f(-LOG2E * x), 1e30f);
                        v[bj][e] = x; }
                if (KIND == 4) {
#pragma unroll
                    for (int e = 0; e < 8; ++e) { const float ta = v[0][e], tb = v[1][e]; v[0][e] = tb * __builtin_amdgcn_rcpf(ta); v[1][e] = __builtin_amdgcn_rcpf(tb); } }
#pragma unroll
                for (int bj = 0; bj < 2; ++bj) {
                    u32x4 w; w.x = cvtpk(v[bj][0], v[bj][1]); w.y = cvtpk(v[bj][2], v[bj][3]); w.z = cvtpk(v[bj][4], v[bj][5]); w.w = cvtpk(v[bj][6], v[bj][7]);
                    if (KIND == 3) {
#pragma unroll
                        for (int e = 0; e < 4; ++e) { const unsigned q = e == 0 ? w.x : e == 1 ? w.y : e == 2 ? w.z : w.w; const float a = bflo(q), b = bfhi(q); s1 += a + b; s2 += a * a + b * b; } }
                    *(u32x4*)(rowp + bj * HALF) = w;
                }
                if (KIND == 3) {
                    s1 = xadd<16>(s1); s1 = xadd<32>(s1); s2 = xadd<16>(s2); s2 = xadd<32>(s2);
                    if (fq == 0) *(f32x2*)(gvst + (size_t)row * 24 + ((u.pn - 9) * 4 + wc) * 2) = (f32x2){s1, s2};
                }
            }
    }
    static constexpr bool USES_R = true;
    __device__ __forceinline__ void prep(const Unit& u, PG8_LAS unsigned char* red, int tid) const { RsPf p; rs_issue(p, xsq, u.pm, tid); rs_write(p, (PG8_LAS float*)red, tid); }
    __device__ __forceinline__ void run(f32x4 (&acc)[2][2][4][2], const Unit& u, int wr, int wc, int fr, int fq, PG8_LAS unsigned char* red, int tid, const Unit* nxt, int par) const {
        asm volatile("" : "+v"(fr), "+v"(fq), "+v"(tid));
        const PG8_LAS float* R = (const PG8_LAS float*)red + par * 256;
        RsPf pf; rs_issue(pf, xsq, nxt ? nxt->pm : u.pm, tid);
        run2(acc, u, wr, wc, fr, fq, R);
        rs_write(pf, (PG8_LAS float*)red + (par ^ 1) * 256, tid);
    }
    __device__ __forceinline__ void run2(f32x4 (&acc)[2][2][4][2], const Unit& u, int wr, int wc, int fr, int fq, const PG8_LAS float* R) const {
        if (mode == 0) { body<1>(acc, u, wr, wc, fr, fq, R); return; }
        const int pn = u.pn;
        if (pn < 4) body<0>(acc, u, wr, wc, fr, fq, R);
        else if (pn < 6) body<1>(acc, u, wr, wc, fr, fq, R);
        else if (pn < 9) body<2>(acc, u, wr, wc, fr, fq, R);
        else if (pn < 12) body<3>(acc, u, wr, wc, fr, fq, R);
        else body<4>(acc, u, wr, wc, fr, fq, R);
    }
};

#ifndef MK_WT_SINGLE
#define MK_WT_SINGLE 0
#endif
__device__ __forceinline__ void st16wt(void* p, u32x4 v) {
#if MK_WT_SINGLE
    asm volatile("global_store_dwordx4 %0, %1, off sc1\n\ts_nop 1" :: "v"(p), "v"(v) : "memory");
#else
    *(u32x4*)p = v;
#endif
}
struct EpiMerge {
    static constexpr bool PERM = true, IDEMP = false; static constexpr int MID_T = 16;
    const bf16_t* Z; bf16_t* O;
    template <int WHICH> __device__ __forceinline__ void scale(f32x4 (&acc)[2][2][4][2], const Unit& u, int wr, int wc, int fr, int fq) const {
        asm volatile("" : "+v"(fr), "+v"(fq));
        const int row0 = u.pm * BM + wr * 64 + fr, gc0 = C_GA + 512 * u.pn + WHICH * 128 + wc * 32 + 8 * fq;
        u32x4 gt[2][4][2];
#pragma unroll
        for (int ai = 0; ai < 2; ++ai)
#pragma unroll
            for (int m = 0; m < 4; ++m) { const bf16_t* zr = Z + (size_t)(row0 + ai * HALF + m * 16) * NIN + gc0;
#pragma unroll
                for (int bj = 0; bj < 2; ++bj) gt[ai][m][bj] = *(const u32x4*)(zr + bj * 256); }
        __builtin_amdgcn_sched_barrier(0);
#pragma unroll
        for (int ai = 0; ai < 2; ++ai)
#pragma unroll
            for (int m = 0; m < 4; ++m)
#pragma unroll
                for (int bj = 0; bj < 2; ++bj) { const u32x4 a = gt[ai][m][bj];
#pragma unroll
                    for (int e = 0; e < 4; ++e) { const unsigned qa = e == 0 ? a.x : e == 1 ? a.y : e == 2 ? a.z : a.w;
                        acc[ai][bj][m][e >> 1][(e & 1) * 2] *= bflo(qa); acc[ai][bj][m][e >> 1][(e & 1) * 2 + 1] *= bfhi(qa); } }
    }
    __device__ __forceinline__ void mid(f32x4 (&acc)[2][2][4][2], const Unit& u, int wr, int wc, int fr, int fq) const { scale<0>(acc, u, wr, wc, fr, fq); }
    template <int WHICH> __device__ __forceinline__ void scalex(f32x4 (&accx)[2], const Unit& u, int wr, int wc, int fr, int fq) const {
        asm volatile("" : "+v"(fr), "+v"(fq));
        const u32x4 a = *(const u32x4*)(Z + (size_t)(MP + 16 * u.pm + fr) * NIN + C_GA + 512 * u.pn + 256 * wr + WHICH * 128 + wc * 32 + 8 * fq);
#pragma unroll
        for (int e = 0; e < 4; ++e) { const unsigned qa = e == 0 ? a.x : e == 1 ? a.y : e == 2 ? a.z : a.w; accx[e >> 1][(e & 1) * 2] *= bflo(qa); accx[e >> 1][(e & 1) * 2 + 1] *= bfhi(qa); }
    }
    __device__ __forceinline__ void midx(f32x4 (&accx)[2], const Unit& u, int wr, int wc, int fr, int fq) const { scalex<0>(accx, u, wr, wc, fr, fq); }
    __device__ __forceinline__ void runx(f32x4 (&accx)[2], const Unit& u, int wr, int wc, int fr, int fq, PG8_LAS unsigned char*, int) const {
        scalex<1>(accx, u, wr, wc, fr, fq);
        asm volatile("" : "+v"(fr), "+v"(fq));
        u32x4 w; w.x = cvtpk(accx[0][0], accx[0][1]); w.y = cvtpk(accx[0][2], accx[0][3]); w.z = cvtpk(accx[1][0], accx[1][1]); w.w = cvtpk(accx[1][2], accx[1][3]);
        st16wt(O + (size_t)(MP + 16 * u.pm + fr) * DM + u.pn * BM + 128 * wr + wc * 32 + 8 * fq, w);
    }
    static constexpr bool USES_R = false;
    __device__ __forceinline__ void prep(const Unit&, PG8_LAS unsigned char*, int) const {}
    __device__ __forceinline__ void run(f32x4 (&acc)[2][2][4][2], const Unit& u, int wr, int wc, int fr, int fq, PG8_LAS unsigned char*, int, const Unit*, int) const {
        scale<1>(acc, u, wr, wc, fr, fq);
        asm volatile("" : "+v"(fr), "+v"(fq));
        const int row0 = u.pm * BM + wr * 64 + fr, col0 = u.pn * BM + wc * 32 + 8 * fq;
#pragma unroll
        for (int ai = 0; ai < 2; ++ai)
#pragma unroll
            for (int m = 0; m < 4; ++m) {
                const int row = row0 + ai * HALF + m * 16;
#pragma unroll
                for (int bj = 0; bj < 2; ++bj) {
                    u32x4 w; w.x = cvtpk(acc[ai][bj][m][0][0], acc[ai][bj][m][0][1]); w.y = cvtpk(acc[ai][bj][m][0][2], acc[ai][bj][m][0][3]);
                    w.z = cvtpk(acc[ai][bj][m][1][0], acc[ai][bj][m][1][1]); w.w = cvtpk(acc[ai][bj][m][1][2], acc[ai][bj][m][1][3]);
                    st16wt(O + (size_t)row * DM + col0 + bj * HALF, w);
                }
            }
    }
};

struct EpiResid {
    static constexpr bool PERM = true, IDEMP = false; static constexpr int MID_T = -1;
    bf16_t* XB; float* xsq;
    __device__ __forceinline__ void mid(f32x4 (&)[2][2][4][2], const Unit&, int, int, int, int) const {}
    __device__ __forceinline__ void midx(f32x4 (&)[2], const Unit&, int, int, int, int) const {}
    __device__ __forceinline__ void runx(f32x4 (&accx)[2], const Unit& u, int wr, int wc, int fr, int fq, PG8_LAS unsigned char* red, int tid) const {
        asm volatile("" : "+v"(fr), "+v"(fq), "+v"(tid));
        const int row = MP + 16 * u.pm + fr; bf16_t* xr = XB + (size_t)row * DM + u.pn * BM + 128 * wr + wc * 32 + 8 * fq;
        const u32x4 o = *(const u32x4*)xr; u32x4 w; float ss = 0.f;
#pragma unroll
        for (int e = 0; e < 4; ++e) { const unsigned q = e == 0 ? o.x : e == 1 ? o.y : e == 2 ? o.z : o.w;
            const unsigned r = cvtpk(bflo(q) + accx[e >> 1][(e & 1) * 2], bfhi(q) + accx[e >> 1][(e & 1) * 2 + 1]);
            const float a = bflo(r), b = bfhi(r); ss += a * a + b * b;
            if (e == 0) w.x = r; else if (e == 1) w.y = r; else if (e == 2) w.z = r; else w.w = r; }
        st16wt(xr, w);
        ss = xadd<16>(ss); ss = xadd<32>(ss);
        PG8_LAS float* RX = (PG8_LAS float*)(red + 4096);
        if (fq == 0) RX[(wr * 4 + wc) * 16 + fr] = ss;
        asm volatile("s_waitcnt lgkmcnt(0)" ::: "memory"); __builtin_amdgcn_s_barrier(); asm volatile("" ::: "memory");
        if (tid < 16) { float s = 0.f;
#pragma unroll
            for (int w8 = 0; w8 < 8; ++w8) s += RX[w8 * 16 + tid];
            xsq[(size_t)(MP + 16 * u.pm + tid) * 16 + u.pn] = s; }
    }
    static constexpr bool USES_R = false;
    __device__ __forceinline__ void prep(const Unit&, PG8_LAS unsigned char*, int) const {}
    __device__ __forceinline__ void run(f32x4 (&acc)[2][2][4][2], const Unit& u, int wr, int wc, int fr, int fq, PG8_LAS unsigned char*, int, const Unit*, int) const {
        asm volatile("" : "+v"(fr), "+v"(fq));
        const int row0 = u.pm * BM + wr * 64 + fr, col0 = u.pn * BM + wc * 32 + 8 * fq;
        u32x4 xo[2][4][2];
#pragma unroll
        for (int ai = 0; ai < 2; ++ai)
#pragma unroll
            for (int m = 0; m < 4; ++m)
#pragma unroll
                for (int bj = 0; bj < 2; ++bj) xo[ai][m][bj] = *(const u32x4*)(XB + (size_t)(row0 + ai * HALF + m * 16) * DM + col0 + bj * HALF);
        __builtin_amdgcn_sched_barrier(0);
#pragma unroll
        for (int ai = 0; ai < 2; ++ai)
#pragma unroll
            for (int m = 0; m < 4; ++m) {
                const int row = row0 + ai * HALF + m * 16;
                bf16_t* xr = XB + (size_t)row * DM + col0;
                float ss = 0.f;
#pragma unroll
                for (int bj = 0; bj < 2; ++bj) {
                    const u32x4 o = xo[ai][m][bj];
                    u32x4 w;
#pragma unroll
                    for (int e = 0; e < 4; ++e) { const unsigned q = e == 0 ? o.x : e == 1 ? o.y : e == 2 ? o.z : o.w;
                        const unsigned r = cvtpk(bflo(q) + acc[ai][bj][m][e >> 1][(e & 1) * 2], bfhi(q) + acc[ai][bj][m][e >> 1][(e & 1) * 2 + 1]);
                        const float a = bflo(r), b = bfhi(r); ss += a * a + b * b;
                        if (e == 0) w.x = r; else if (e == 1) w.y = r; else if (e == 2) w.z = r; else w.w = r; }
                    st16wt(xr + bj * HALF, w);
                }
                ss = xadd<16>(ss); ss = xadd<32>(ss);
                if (fq == 0) xsq[(size_t)row * 16 + u.pn * 4 + wc] = ss;
            }
    }
};

template <int CTRL> __device__ __forceinline__ unsigned dppu(unsigned old, unsigned src) { return (unsigned)__builtin_amdgcn_update_dpp((int)old, (int)src, CTRL, 0xf, 0xf, false); }
template <int CTRL> __device__ __forceinline__ float dppf(float old, float src) { return __int_as_float(__builtin_amdgcn_update_dpp(__float_as_int(old), __float_as_int(src), CTRL, 0xf, 0xf, false)); }
#ifndef MK_UP_SB
#define MK_UP_SB 1
#endif
#ifndef MK_DOT2
#define MK_DOT2 0
#endif
typedef __attribute__((ext_vector_type(2))) __bf16 bf16v2_t;
__device__ __forceinline__ float dot2bf(unsigned a, unsigned b, float c) { return __builtin_amdgcn_fdot2_f32_bf16(__builtin_bit_cast(bf16v2_t, a), __builtin_bit_cast(bf16v2_t, b), c, false); }
#ifndef MK_UP_T21
#define MK_UP_T21 1
#endif
struct EpiUp {
    static constexpr bool PERM = !MK_UP_T21, IDEMP = true; static constexpr int MID_T = -1;
    unsigned char* ws; const float* cw; const float* cb; float* ocp;
    __device__ __forceinline__ void mid(f32x4 (&)[2][2][4][2], const Unit&, int, int, int, int) const {}
    static constexpr bool USES_R = true;
    __device__ __forceinline__ void stage_cw(int pn, PG8_LAS unsigned char* red, int tid, int par) const {
        if (tid < 256) { const int tp = __builtin_amdgcn_readfirstlane(tid >> 6), hb = (tid >> 5) & 1, c4 = (tid & 31) * 4; const float* srcw = (tp < 3 ? cw + tp * NUP : cb) + hb * DFF + 128 * pn + c4;
            __builtin_amdgcn_global_load_lds((const unsigned*)srcw, (PG8_LAS unsigned*)((PG8_LAS float*)(red + 12288) + par * 1024 + tp * 256), 16, 0, 0); }
    }
    __device__ __forceinline__ void prep(const Unit& u, PG8_LAS unsigned char* red, int tid) const { RsPf p; rs_issue(p, (const float*)(ws + WS_XSQ), u.pm, tid); stage_cw(u.pn, red, tid, 0); rs_write(p, (PG8_LAS float*)red, tid); }
    __device__ __forceinline__ void run(f32x4 (&acc)[2][2][4][2], const Unit& u, int wr, int wc, int fr, int fq, PG8_LAS unsigned char* red, int tid, const Unit* nxt, int par) const {
        asm volatile("" : "+v"(fr), "+v"(fq), "+v"(tid));
        const PG8_LAS float* R = (const PG8_LAS float*)red + par * 256;
        RsPf pf; rs_issue(pf, (const float*)(ws + WS_XSQ), nxt ? nxt->pm : u.pm, tid);
        run2(acc, u, wr, wc, fr, fq, red, R, tid, pf, true, (PG8_LAS float*)red + (par ^ 1) * 256, par);
        if (nxt) { int t2 = tid; asm volatile("" : "+v"(t2)); stage_cw(nxt->pn, red, t2, par ^ 1); }
    }
    __device__ __forceinline__ void run2(f32x4 (&acc)[2][2][4][2], const Unit& u, int wr, int wc, int fr, int fq, PG8_LAS unsigned char* red, const PG8_LAS float* R, int tid, const RsPf& pf, bool has_pf, PG8_LAS float* Rn, int par) const {
        bf16_t* const G = (bf16_t*)(ws + WS_RB); bf16_t* const Z2 = (bf16_t*)(ws + WS_RA); float* const HT = (float*)(ws + WS_RA);
        const int row0 = u.pm * BM + wr * 64 + fr, jcb = 128 * u.pn + 32 * wc;
#define UP_CO(n) (MK_UP_T21 ? 16 * (n) + 4 * fq : 8 * fq + 4 * (n))
        if (u.pm >= MP / BM) {
#pragma unroll
            for (int ai = 0; ai < 2; ++ai)
#pragma unroll
                for (int m = 0; m < 4; ++m) { const int row = row0 + ai * HALF + m * 16; const float rs = R[ai * HALF + wr * 64 + m * 16 + fr];
#pragma unroll
                    for (int bj = 0; bj < 2; ++bj) { u32x4 w; w.x = cvtpk(acc[ai][bj][m][0][0] * rs, acc[ai][bj][m][0][1] * rs); w.y = cvtpk(acc[ai][bj][m][0][2] * rs, acc[ai][bj][m][0][3] * rs);
                        w.z = cvtpk(acc[ai][bj][m][1][0] * rs, acc[ai][bj][m][1][1] * rs); w.w = cvtpk(acc[ai][bj][m][1][2] * rs, acc[ai][bj][m][1][3] * rs);
#if MK_UP_T21
                        *(u32x2*)(Z2 + (size_t)row * NUP + bj * DFF + jcb + UP_CO(0)) = (u32x2){w.x, w.y}; *(u32x2*)(Z2 + (size_t)row * NUP + bj * DFF + jcb + UP_CO(1)) = (u32x2){w.z, w.w}; } }
#else
                        *(u32x4*)(Z2 + (size_t)row * NUP + bj * DFF + jcb + UP_CO(0)) = w; } }
#endif
            if (has_pf) rs_write(pf, Rn, tid);
            return;
        }
        const float rs3[2] = {R[wr * 64 + 48 + fr], R[HALF + wr * 64 + 48 + fr]}; const float rs00 = R[wr * 64 + fr];
        PG8_LAS float* H = (PG8_LAS float*)(red + 4096);
        const PG8_LAS float* CW = (const PG8_LAS float*)(red + 12288) + par * 1024;
        if (fr >= 14) {
#pragma unroll
            for (int ai = 0; ai < 2; ++ai)
#pragma unroll
                for (int bj = 0; bj < 2; ++bj)
#pragma unroll
                    for (int n = 0; n < 2; ++n) *(PG8_LAS f32x4*)(H + ((2 * ai + wr) * 2 + (fr - 14)) * 256 + bj * HALF + 32 * wc + UP_CO(n)) = acc[ai][bj][3][n] * rs3[ai];
        }
        if (has_pf) rs_write(pf, Rn, tid);
        asm volatile("s_waitcnt lgkmcnt(0)" ::: "memory"); __builtin_amdgcn_s_barrier(); asm volatile("" ::: "memory");
        if (fr >= 14 && wr == 1) {
            float* t = HT + ((size_t)u.pm * 4 + 2 + (fr - 14)) * NUP + jcb;
#pragma unroll
            for (int bj = 0; bj < 2; ++bj)
#pragma unroll
                for (int n = 0; n < 2; ++n) *(f32x4*)(t + bj * DFF + UP_CO(n)) = acc[1][bj][3][n] * rs3[1];
            if ((u.pm & 31) == 31) { float* o = ocp + ((size_t)(u.pm >> 5) * 2 + (fr - 14)) * NUP + jcb;
#pragma unroll
                for (int bj = 0; bj < 2; ++bj)
#pragma unroll
                    for (int n = 0; n < 2; ++n) *(f32x4*)(o + bj * DFF + UP_CO(n)) = acc[1][bj][3][n] * rs3[1]; }
        }
        if (fr < 2 && wr == 0) { float* t = HT + ((size_t)u.pm * 4 + fr) * NUP + jcb;
#pragma unroll
            for (int bj = 0; bj < 2; ++bj)
#pragma unroll
                for (int n = 0; n < 2; ++n) *(f32x4*)(t + bj * DFF + UP_CO(n)) = acc[0][bj][0][n] * rs00; }
        u32x2 zp[2][2][4][2];
#pragma unroll
        for (int ai = 0; ai < 2; ++ai)
#pragma unroll
            for (int m = 0; m < 4; ++m) { const float rs = R[ai * HALF + wr * 64 + m * 16 + fr];
#pragma unroll
                for (int bj = 0; bj < 2; ++bj)
#pragma unroll
                    for (int n = 0; n < 2; ++n) { zp[ai][bj][m][n].x = cvtpk(acc[ai][bj][m][n][0] * rs, acc[ai][bj][m][n][1] * rs); zp[ai][bj][m][n].y = cvtpk(acc[ai][bj][m][n][2] * rs, acc[ai][bj][m][n][3] * rs); } }
#if defined(MK_UP_MAIN_REPS)
        for (int mr_ = 0; mr_ < MK_UP_MAIN_REPS; ++mr_)
#endif
#pragma unroll
        for (int n = 0; n < 2; ++n) {
            f32x4 wa[3], wb[3], ba, bb;
#pragma unroll
            for (int j = 0; j < 3; ++j) { wa[j] = *(const PG8_LAS f32x4*)(CW + (j * 2 + 0) * 128 + 32 * wc + UP_CO(n)); wb[j] = *(const PG8_LAS f32x4*)(CW + (j * 2 + 1) * 128 + 32 * wc + UP_CO(n)); }
            ba = *(const PG8_LAS f32x4*)(CW + 6 * 128 + 32 * wc + UP_CO(n)); bb = *(const PG8_LAS f32x4*)(CW + 7 * 128 + 32 * wc + UP_CO(n));
#if MK_DOT2
            unsigned wap[3][4], wbp[3][4];
#pragma unroll
            for (int j = 0; j < 3; ++j)
#pragma unroll
                for (int e = 0; e < 4; ++e) { wap[j][e] = (e & 1) ? cvtpk(0.f, wa[j][e]) : cvtpk(wa[j][e], 0.f); wbp[j][e] = (e & 1) ? cvtpk(0.f, wb[j][e]) : cvtpk(wb[j][e], 0.f); }
#endif
#pragma unroll
            for (int ai = 0; ai < 2; ++ai) {
                const int cid = 2 * ai + wr;
                u32x2 wkeep = {0u, 0u};
                u32x2 h1a = {0u, 0u}, h2a = h1a, h1b = h1a, h2b = h1a;
                if (cid > 0 && fr < 2) { const PG8_LAS float* hb = H + (cid - 1) * 512 + 32 * wc + UP_CO(n);
                    const f32x4 x2a = *(const PG8_LAS f32x4*)(hb), x1a = *(const PG8_LAS f32x4*)(hb + 256), x2b = *(const PG8_LAS f32x4*)(hb + HALF), x1b = *(const PG8_LAS f32x4*)(hb + 256 + HALF);
                    h2a.x = cvtpk(x2a[0], x2a[1]); h2a.y = cvtpk(x2a[2], x2a[3]); h1a.x = cvtpk(x1a[0], x1a[1]); h1a.y = cvtpk(x1a[2], x1a[3]);
                    h2b.x = cvtpk(x2b[0], x2b[1]); h2b.y = cvtpk(x2b[2], x2b[3]); h1b.x = cvtpk(x1b[0], x1b[1]); h1b.y = cvtpk(x1b[2], x1b[3]); }
#pragma unroll
                for (int m = 0; m < 4; ++m) {
                    float g4[4];
#pragma unroll
                    for (int hx = 0; hx < 2; ++hx) {
                        const unsigned za = hx ? zp[ai][0][m][n].y : zp[ai][0][m][n].x, zb = hx ? zp[ai][1][m][n].y : zp[ai][1][m][n].x;
                        unsigned o1a, o2a, o1b, o2b;
                        if (m == 0) { const unsigned q1a = hx ? h1a.y : h1a.x, q2a = hx ? h2a.y : h2a.x, q1b = hx ? h1b.y : h1b.x, q2b = hx ? h2b.y : h2b.x; o1a = q1a; o1b = q1b; o2a = fr == 0 ? q2a : q1a; o2b = fr == 0 ? q2b : q1b; }
                        else { const unsigned pa = hx ? zp[ai][0][m - 1][n].y : zp[ai][0][m - 1][n].x, pb = hx ? zp[ai][1][m - 1][n].y : zp[ai][1][m - 1][n].x;
                            o1a = dppu<0x121>(pa, pa); o2a = dppu<0x122>(pa, pa); o1b = dppu<0x121>(pb, pb); o2b = dppu<0x122>(pb, pb); }
                        const unsigned p1a = dppu<0x111>(o1a, za), p2a = dppu<0x112>(o2a, za), p1b = dppu<0x111>(o1b, zb), p2b = dppu<0x112>(o2b, zb);
                        const int e0 = 2 * hx, e1 = 2 * hx + 1;
#if MK_DOT2
                        const float ca0 = dot2bf(za, wap[2][e0], dot2bf(p1a, wap[1][e0], dot2bf(p2a, wap[0][e0], ba[e0]))), cb0 = dot2bf(zb, wbp[2][e0], dot2bf(p1b, wbp[1][e0], dot2bf(p2b, wbp[0][e0], bb[e0])));
                        const float ca1 = dot2bf(za, wap[2][e1], dot2bf(p1a, wap[1][e1], dot2bf(p2a, wap[0][e1], ba[e1]))), cb1 = dot2bf(zb, wbp[2][e1], dot2bf(p1b, wbp[1][e1], dot2bf(p2b, wbp[0][e1], bb[e1])));
#else
                        const float ca0 = ba[e0] + wa[0][e0] * bflo(p2a) + wa[1][e0] * bflo(p1a) + wa[2][e0] * bflo(za), cb0 = bb[e0] + wb[0][e0] * bflo(p2b) + wb[1][e0] * bflo(p1b) + wb[2][e0] * bflo(zb);
                        const float ca1 = ba[e1] + wa[0][e1] * bfhi(p2a) + wa[1][e1] * bfhi(p1a) + wa[2][e1] * bfhi(za), cb1 = bb[e1] + wb[0][e1] * bfhi(p2b) + wb[1][e1] * bfhi(p1b) + wb[2][e1] * bfhi(zb);
#endif
                        g4[e0] = gelu_t(ca0) * cb0; g4[e1] = gelu_t(ca1) * cb1;
                    }
                    u32x2 w2; w2.x = cvtpk(g4[0], g4[1]); w2.y = cvtpk(g4[2], g4[3]);
#if MK_UP_T21
                    if ((m & 1) == 0) wkeep = w2;
                    else { auto sx = __builtin_amdgcn_permlane16_swap(wkeep.x, w2.x, false, false); auto sy = __builtin_amdgcn_permlane16_swap(wkeep.y, w2.y, false, false);
                        const bool odd = (fq & 1) != 0;
                        u32x4 w4; w4.x = sx[0]; w4.y = sy[0]; w4.z = sx[1]; w4.w = sy[1];
                        const int rowb = row0 + ai * HALF + (odd ? m : m - 1) * 16, colb = jcb + 16 * n + 4 * (fq & 2);
                        const bool deferred = (cid == 0) && (m == 1) && !odd && (fr < 2) && ((u.pm & 31) != 0);
                        if (!deferred) *(u32x4*)(G + (size_t)rowb * DFF + colb) = w4; }
#else
                    { const bool deferred = (cid == 0) && (m == 0) && (fr < 2) && ((u.pm & 31) != 0);
                        if (!deferred) *(u32x2*)(G + (size_t)(row0 + ai * HALF + m * 16) * DFF + jcb + UP_CO(n)) = w2; }
#endif
#if MK_UP_SB == 1
                    __builtin_amdgcn_sched_barrier(0);
#elif MK_UP_SB == 2
                    if (m & 1) __builtin_amdgcn_sched_barrier(0);
#endif
                }
            }
        }
    }
};

#ifndef MK_FRESH_SKIP
#define MK_FRESH_SKIP 1
#endif
template <class Epi, class Sched>
__device__ __forceinline__ void gemm_phase(PG8_LAS unsigned char* lds, PG8_LAS unsigned char* red, const Gemm g, const Sched& S, const Epi& E, int s_wave) {
    int tid_ = tid_from_wave(s_wave); asm volatile("" : "+v"(tid_));
    const int tid = tid_, wid = __builtin_amdgcn_readfirstlane(tid >> 6), lane = tid & 63, wr = wid >> 2, wc = wid & 3, fr = lane & 15, fq = lane >> 4;
    const int K = g.K, nt = K / BK;
    unsigned voffA[2], voffB[2];
#pragma unroll
    for (int i = 0; i < 2; ++i) { int R, C; stage_rc(tid * 16 + i * 8192, R, C); const int Rb = Epi::PERM ? ((R & ~31) + perm32(R & 31)) : R;
        voffA[i] = (unsigned)(R * K + C) * 2u; voffB[i] = (unsigned)(Rb * K + C) * 2u; }
    const size_t kstep = (size_t)(BK * 2);
    const size_t hstep = (size_t)HALF * K * 2;
    const size_t tstep = 2 * hstep;
    const unsigned ldsw = (unsigned)wid * 1024u;
    const int aoff = lds_byte(wr * 64 + fr, fq * 8), boff = lds_byte(wc * 32 + fr, fq * 8);
#define PG8_SA(b, h) (((b) * 2 + (h)) * HTB)
#define PG8_SB(b, h) ((4 + (b) * 2 + (h)) * HTB)
#define PG8_STAGE(bufoff, gbase, voff) do { _Pragma("unroll") for (int _i = 0; _i < 2; ++_i) \
        __builtin_amdgcn_global_load_lds((const unsigned*)((const char*)(gbase) + (voff)[_i]), (PG8_LAS unsigned*)(lds + (bufoff) + ldsw + _i * 8192), 16, 0, 0); } while (0)
#define PG8_LDA(dst, b, h) do { _Pragma("unroll") for (int m = 0; m < 4; ++m) _Pragma("unroll") for (int k = 0; k < 2; ++k) dst[m][k] = *(const PG8_LAS bf16x8*)(lds + PG8_SA(b, h) + aoff + m * 2048 + k * 1024); } while (0)
#define PG8_LDB(dst, b, h) do { _Pragma("unroll") for (int n = 0; n < 2; ++n) _Pragma("unroll") for (int k = 0; k < 2; ++k) dst[n][k] = *(const PG8_LAS bf16x8*)(lds + PG8_SB(b, h) + boff + n * 2048 + k * 1024); } while (0)
#define PG8_MMA(ai, bj, At, Bt) do { __builtin_amdgcn_s_setprio(1); _Pragma("unroll") for (int m = 0; m < 4; ++m) _Pragma("unroll") for (int n = 0; n < 2; ++n) _Pragma("unroll") for (int k = 0; k < 2; ++k) \
        acc[ai][bj][m][n] = __builtin_amdgcn_mfma_f32_16x16x32_bf16(Bt[n][k], At[m][k], acc[ai][bj][m][n], 0, 0, 0); __builtin_amdgcn_s_setprio(0); } while (0)
#define PG8_WAIT_V(n) asm volatile("s_waitcnt vmcnt(" #n ")" ::: "memory")
#define PG8_WAIT_V8_UNLESS(f) asm volatile("s_cmp_lg_u32 %0, 0\n\ts_cbranch_scc1 .Lsk%=\n\ts_waitcnt vmcnt(8)\n.Lsk%=:" :: "s"(f) : "scc", "memory")
#define PG8_WAIT_L(n) asm volatile("s_waitcnt lgkmcnt(" #n ")" ::: "memory")
#define PG8_BAR __builtin_amdgcn_s_barrier()
#define PG8_SCHED __builtin_amdgcn_sched_barrier(0)
#if defined(MK_DUP_KLOOP)
#define PG8_NEXT(i, u) (Epi::IDEMP ? S.next((i) >> 1, u) : S.next((i), u))
#define PG8_SKIP_EPI(i) (Epi::IDEMP && (((i) & 1) == 0))
#else
#define PG8_NEXT(i, u) S.next((i), u)
#define PG8_SKIP_EPI(i) false
#endif
    Unit cur, nxt; int ui = 0;
    if (!PG8_NEXT(0, cur)) return;
    if constexpr (Epi::USES_R) E.prep(cur, red, tid);
    f32x4 acc[2][2][4][2];
#pragma unroll
    for (int a = 0; a < 2; ++a)
#pragma unroll
        for (int b = 0; b < 2; ++b)
#pragma unroll
            for (int m = 0; m < 4; ++m)
#pragma unroll
                for (int n = 0; n < 2; ++n) acc[a][b][m][n] = (f32x4){0.f, 0.f, 0.f, 0.f};
    bf16x8 At[4][2], B0[2][2], B1[2][2];
    const char* cA = (const char*)g.A + (size_t)cur.pm * tstep; const char* cB = (const char*)g.Bt + (size_t)cur.pn * tstep;
    PG8_STAGE(PG8_SB(0, 0), cB, voffB); PG8_STAGE(PG8_SB(0, 1), cB + hstep, voffB); PG8_STAGE(PG8_SA(0, 0), cA, voffA); PG8_STAGE(PG8_SA(0, 1), cA + hstep, voffA);
    if (wr == 1) PG8_BAR;
    PG8_WAIT_V(2); PG8_BAR;
    PG8_STAGE(PG8_SB(1, 0), cB + kstep, voffB); PG8_STAGE(PG8_SA(1, 0), cA + kstep, voffA); PG8_STAGE(PG8_SB(1, 1), cB + hstep + kstep, voffB);
    PG8_WAIT_V(6); PG8_BAR;
    for (;;) {
        const bool has_next = PG8_NEXT(ui + 1, nxt);
        const char* nA = has_next ? (const char*)g.A + (size_t)nxt.pm * tstep : cA; const char* nB = has_next ? (const char*)g.Bt + (size_t)nxt.pn * tstep : cB;
        for (int t = 0; t < nt; t += 2) {
            const bool last = (t == nt - 2);
            const char* a1 = cA + (size_t)(t + 1) * kstep;
            const char* a2 = last ? nA : cA + (size_t)(t + 2) * kstep; const char* b2 = last ? nB : cB + (size_t)(t + 2) * kstep;
            const char* a3 = a2 + kstep; const char* b3 = b2 + kstep;
            if constexpr (Epi::MID_T >= 0) { if (t == Epi::MID_T) E.mid(acc, cur, wr, wc, fr, fq); }
            const int fresh_ = __builtin_amdgcn_readfirstlane((MK_FRESH_SKIP && ui != 0 && t == 0) ? 1 : 0);
            PG8_LDB(B0, 0, 0); PG8_LDB(B1, 0, 1); PG8_SCHED; PG8_LDA(At, 0, 0); PG8_STAGE(PG8_SA(1, 1), a1 + hstep, voffA);
            PG8_WAIT_V8_UNLESS(fresh_); PG8_WAIT_L(0); PG8_BAR; PG8_MMA(0, 0, At, B0); PG8_MMA(0, 1, At, B1); PG8_BAR; PG8_SCHED;
            PG8_LDA(At, 0, 1); PG8_STAGE(PG8_SB(0, 0), b2, voffB); PG8_STAGE(PG8_SB(0, 1), b2 + hstep, voffB); PG8_STAGE(PG8_SA(0, 0), a2, voffA);
            PG8_WAIT_V8_UNLESS(fresh_); PG8_WAIT_L(0); PG8_BAR; PG8_MMA(1, 0, At, B0); PG8_MMA(1, 1, At, B1); PG8_BAR; PG8_SCHED;
            PG8_LDB(B0, 1, 0); PG8_LDB(B1, 1, 1); PG8_SCHED; PG8_LDA(At, 1, 0); PG8_STAGE(PG8_SA(0, 1), a2 + hstep, voffA);
            PG8_WAIT_V(8); PG8_WAIT_L(0); PG8_BAR; PG8_MMA(0, 0, At, B0); PG8_MMA(0, 1, At, B1); PG8_BAR; PG8_SCHED;
            PG8_LDA(At, 1, 1); PG8_STAGE(PG8_SB(1, 0), b3, voffB); PG8_STAGE(PG8_SB(1, 1), b3 + hstep, voffB); PG8_STAGE(PG8_SA(1, 0), a3, voffA);
            PG8_WAIT_V(8); PG8_WAIT_L(0); PG8_BAR; PG8_MMA(1, 0, At, B0); PG8_MMA(1, 1, At, B1); PG8_BAR; PG8_SCHED;
        }
        if (wr == 0) PG8_BAR;
#if MK_FRESH_SKIP
        PG8_WAIT_V(0);
#endif
        if (!PG8_SKIP_EPI(ui)) E.run(acc, cur, wr, wc, fr, fq, red, tid, has_next ? &nxt : nullptr, ui & 1);
#if defined(MK_EPI_TWICE)
        if constexpr (Epi::MID_T < 0 && Epi::IDEMP) { for (int er_ = 1; er_ < MK_EPI_TWICE; ++er_) { asm volatile("s_waitcnt lgkmcnt(0)" ::: "memory"); __builtin_amdgcn_s_barrier(); E.run(acc, cur, wr, wc, fr, fq, red, tid, has_next ? &nxt : nullptr, ui & 1); } }
#endif
        if (!has_next) break;
#pragma unroll
        for (int a = 0; a < 2; ++a)
#pragma unroll
            for (int b = 0; b < 2; ++b)
#pragma unroll
                for (int m = 0; m < 4; ++m)
#pragma unroll
                    for (int n = 0; n < 2; ++n) acc[a][b][m][n] = (f32x4){0.f, 0.f, 0.f, 0.f};
        cur = nxt; cA = nA; cB = nB; ++ui;
        if (wr == 1) PG8_BAR;
    }
    PG8_WAIT_V(0);
    PG8_BAR;
#undef PG8_SA
#undef PG8_SB
#undef PG8_STAGE
#undef PG8_LDA
#undef PG8_LDB
#undef PG8_MMA
#undef PG8_WAIT_V
#undef PG8_WAIT_V8_UNLESS
#undef PG8_WAIT_L
#undef PG8_BAR
#undef PG8_SCHED
}
template <class Epi>
__device__ __forceinline__ void gemm_phase_x(PG8_LAS unsigned char* lds, PG8_LAS unsigned char* red, const Gemm g, const Unit cur, const Epi& E, int s_wave) {
    int tid_ = tid_from_wave(s_wave); asm volatile("" : "+v"(tid_));
    const int tid = tid_, wid = __builtin_amdgcn_readfirstlane(tid >> 6), lane = tid & 63, wr = wid >> 2, wc = wid & 3, fr = lane & 15, fq = lane >> 4;
    const int K = g.K, nt = K / BK;
    unsigned voffA[2], voffB[2], voffX;
#pragma unroll
    for (int i = 0; i < 2; ++i) { int R, C; stage_rc(tid * 16 + i * 8192, R, C); const int Rb = Epi::PERM ? ((R & ~31) + perm32(R & 31)) : R;
        voffA[i] = (unsigned)(R * K + C) * 2u; voffB[i] = (unsigned)(Rb * K + C) * 2u; }
    { int R, C; stage_rc(tid * 4, R, C); voffX = (unsigned)(R * K + C) * 2u; }
    const size_t kstep = (size_t)(BK * 2);
    const size_t hstep = (size_t)HALF * K * 2;
    const size_t tstep = 2 * hstep;
    const unsigned ldsw = (unsigned)wid * 1024u;
    const int aoff = lds_byte(wr * 64 + fr, fq * 8), boff = lds_byte(wc * 32 + fr, fq * 8), xoff = lds_byte(fr, fq * 8);
    constexpr int XA_OFF = RING_BYTES + 4096;
#define PGX_SA(b, h) (((b) * 2 + (h)) * HTB)
#define PGX_SB(b, h) ((4 + (b) * 2 + (h)) * HTB)
#define PGX_STAGE(bufoff, gbase, voff) do { _Pragma("unroll") for (int _i = 0; _i < 2; ++_i) \
        __builtin_amdgcn_global_load_lds((const unsigned*)((const char*)(gbase) + (voff)[_i]), (PG8_LAS unsigned*)(lds + (bufoff) + ldsw + _i * 8192), 16, 0, 0); } while (0)
#define PGX_STAGEX(b, gbase) __builtin_amdgcn_global_load_lds((const unsigned*)((const char*)(gbase) + voffX), (PG8_LAS unsigned*)(lds + XA_OFF + (b) * 2048 + wid * 256), 4, 0, 0)
#define PGX_LDA(dst, b, h) do { _Pragma("unroll") for (int m = 0; m < 4; ++m) _Pragma("unroll") for (int k = 0; k < 2; ++k) dst[m][k] = *(const PG8_LAS bf16x8*)(lds + PGX_SA(b, h) + aoff + m * 2048 + k * 1024); } while (0)
#define PGX_LDB(dst, b, h) do { _Pragma("unroll") for (int n = 0; n < 2; ++n) _Pragma("unroll") for (int k = 0; k < 2; ++k) dst[n][k] = *(const PG8_LAS bf16x8*)(lds + PGX_SB(b, h) + boff + n * 2048 + k * 1024); } while (0)
#define PGX_LDX(dst, b) do { _Pragma("unroll") for (int k = 0; k < 2; ++k) dst[k] = *(const PG8_LAS bf16x8*)(lds + XA_OFF + (b) * 2048 + xoff + k * 1024); } while (0)
#define PGX_MMA(ai, bj, At, Bt) do { __builtin_amdgcn_s_setprio(1); _Pragma("unroll") for (int m = 0; m < 4; ++m) _Pragma("unroll") for (int n = 0; n < 2; ++n) _Pragma("unroll") for (int k = 0; k < 2; ++k) \
        acc[ai][bj][m][n] = __builtin_amdgcn_mfma_f32_16x16x32_bf16(Bt[n][k], At[m][k], acc[ai][bj][m][n], 0, 0, 0); __builtin_amdgcn_s_setprio(0); } while (0)
#define PGX_MMAX(Bt) do { _Pragma("unroll") for (int n = 0; n < 2; ++n) _Pragma("unroll") for (int k = 0; k < 2; ++k) accx[n] = __builtin_amdgcn_mfma_f32_16x16x32_bf16(Bt[n][k], Xt[k], accx[n], 0, 0, 0); } while (0)
#define PGX_WAIT_V(n) asm volatile("s_waitcnt vmcnt(" #n ")" ::: "memory")
#define PGX_WAIT_L(n) asm volatile("s_waitcnt lgkmcnt(" #n ")" ::: "memory")
#define PGX_BAR __builtin_amdgcn_s_barrier()
#define PGX_SCHED __builtin_amdgcn_sched_barrier(0)
    f32x4 acc[2][2][4][2], accx[2];
    bf16x8 At[4][2], B0[2][2], B1[2][2], Xt[2];
    const char* cA = (const char*)g.A + (size_t)cur.pm * tstep; const char* cB = (const char*)g.Bt + (size_t)cur.pn * tstep;
    const char* cX = (const char*)g.A + (size_t)(MP + 16 * cur.pm) * K * 2;
#pragma unroll
    for (int a = 0; a < 2; ++a)
#pragma unroll
        for (int b = 0; b < 2; ++b)
#pragma unroll
            for (int m = 0; m < 4; ++m)
#pragma unroll
                for (int n = 0; n < 2; ++n) acc[a][b][m][n] = (f32x4){0.f, 0.f, 0.f, 0.f};
    accx[0] = (f32x4){0.f, 0.f, 0.f, 0.f}; accx[1] = (f32x4){0.f, 0.f, 0.f, 0.f};
#ifndef MK_PRETOUCH
#define MK_PRETOUCH 0
#endif
#if MK_PRETOUCH > 0
    { const int ia = cur.pn * 512 + tid, ib = (cur.pm & 3) * 512 + tid;
      const char* pa = cA + (size_t)(ia & 255) * K * 2 + (size_t)(2 + (ia >> 8)) * kstep; const char* pb = cB + (size_t)(ib & 255) * K * 2 + (size_t)(2 + (ib >> 8)) * kstep;
      __builtin_amdgcn_global_load_lds((const unsigned*)pa, (PG8_LAS unsigned*)(lds + PGX_SB(1, 1) + wid * 256), 4, 0, 0);
      __builtin_amdgcn_global_load_lds((const unsigned*)pb, (PG8_LAS unsigned*)(lds + PGX_SB(1, 1) + 2048 + wid * 256), 4, 0, 0); }
#endif
    PGX_STAGEX(0, cX); PGX_STAGE(PGX_SB(0, 0), cB, voffB); PGX_STAGE(PGX_SB(0, 1), cB + hstep, voffB); PGX_STAGE(PGX_SA(0, 0), cA, voffA); PGX_STAGE(PGX_SA(0, 1), cA + hstep, voffA);
    if (wr == 1) PGX_BAR;
    PGX_WAIT_V(2); PGX_BAR;
    PGX_STAGEX(1, cX + kstep); PGX_STAGE(PGX_SB(1, 0), cB + kstep, voffB); PGX_STAGE(PGX_SA(1, 0), cA + kstep, voffA); PGX_STAGE(PGX_SB(1, 1), cB + hstep + kstep, voffB);
    PGX_WAIT_V(7); PGX_BAR;
#if defined(MK_X_KREPS)
    for (int t_ = 0; t_ < nt * 2; t_ += 2) { const int t = t_ >= nt ? t_ - nt : t_;
        if (t == 0 && t_ > 0) { float z0_ = 0.f; asm volatile("" : "+v"(z0_));
#pragma unroll
            for (int a = 0; a < 2; ++a)
#pragma unroll
                for (int b = 0; b < 2; ++b)
#pragma unroll
                    for (int m = 0; m < 4; ++m)
#pragma unroll
                        for (int n = 0; n < 2; ++n) acc[a][b][m][n] *= z0_;
            accx[0] *= z0_; accx[1] *= z0_; }
#else
    for (int t = 0; t < nt; t += 2) {
#endif
        const bool last = (t == nt - 2);
        const char* a1 = cA + (size_t)(t + 1) * kstep;
        const char* a2 = last ? cA : cA + (size_t)(t + 2) * kstep; const char* b2 = last ? cB : cB + (size_t)(t + 2) * kstep; const char* x2 = last ? cX : cX + (size_t)(t + 2) * kstep;
        const char* a3 = a2 + kstep; const char* b3 = b2 + kstep; const char* x3 = x2 + kstep;
        if constexpr (Epi::MID_T >= 0) { if (t == Epi::MID_T) { E.mid(acc, cur, wr, wc, fr, fq); E.midx(accx, cur, wr, wc, fr, fq); } }
        PGX_LDB(B0, 0, 0); PGX_LDB(B1, 0, 1); PGX_SCHED; PGX_LDA(At, 0, 0); PGX_LDX(Xt, 0); PGX_STAGE(PGX_SA(1, 1), a1 + hstep, voffA);
        PGX_WAIT_V(9); PGX_WAIT_L(0); PGX_BAR; PGX_MMA(0, 0, At, B0); PGX_MMA(0, 1, At, B1); if (wr == 0) PGX_MMAX(B0); else PGX_MMAX(B1); PGX_BAR; PGX_SCHED;
        PGX_LDA(At, 0, 1); PGX_STAGEX(0, x2); PGX_STAGE(PGX_SB(0, 0), b2, voffB); PGX_STAGE(PGX_SB(0, 1), b2 + hstep, voffB); PGX_STAGE(PGX_SA(0, 0), a2, voffA);
        PGX_WAIT_V(9); PGX_WAIT_L(0); PGX_BAR; PGX_MMA(1, 0, At, B0); PGX_MMA(1, 1, At, B1); PGX_BAR; PGX_SCHED;
        PGX_LDB(B0, 1, 0); PGX_LDB(B1, 1, 1); PGX_SCHED; PGX_LDA(At, 1, 0); PGX_LDX(Xt, 1); PGX_STAGE(PGX_SA(0, 1), a2 + hstep, voffA);
        PGX_WAIT_V(9); PGX_WAIT_L(0); PGX_BAR; PGX_MMA(0, 0, At, B0); PGX_MMA(0, 1, At, B1); if (wr == 0) PGX_MMAX(B0); else PGX_MMAX(B1); PGX_BAR; PGX_SCHED;
        PGX_LDA(At, 1, 1); PGX_STAGEX(1, x3); PGX_STAGE(PGX_SB(1, 0), b3, voffB); PGX_STAGE(PGX_SB(1, 1), b3 + hstep, voffB); PGX_STAGE(PGX_SA(1, 0), a3, voffA);
        PGX_WAIT_V(9); PGX_WAIT_L(0); PGX_BAR; PGX_MMA(1, 0, At, B0); PGX_MMA(1, 1, At, B1); PGX_BAR; PGX_SCHED;
    }
    if (wr == 0) PGX_BAR;
    PGX_WAIT_V(0); PGX_BAR;
    E.run(acc, cur, wr, wc, fr, fq, red, tid, nullptr, 0);
    E.runx(accx, cur, wr, wc, fr, fq, red, tid);
    PGX_BAR;
#undef PGX_SA
#undef PGX_SB
#undef PGX_STAGE
#undef PGX_STAGEX
#undef PGX_LDA
#undef PGX_LDB
#undef PGX_LDX
#undef PGX_MMA
#undef PGX_MMAX
#undef PGX_WAIT_V
#undef PGX_WAIT_L
#undef PGX_BAR
#undef PGX_SCHED
}
}

typedef GAS unsigned gu32;
#define RLX_AGENT __ATOMIC_RELAXED, __HIP_MEMORY_SCOPE_AGENT
#define LDS_WAIT() asm volatile("s_waitcnt lgkmcnt(0)" ::: "memory")
#define VM_WAIT() asm volatile("s_waitcnt vmcnt(0)" ::: "memory")

#define XB_TMO      128
#define XB_XCNT(j)  (256  + 64 * (j))
#define XB_XSUB(j)  (1280 + 64 * (j))
#define XB_XGEN(j)  (2304 + 64 * (j))
#define XB_TOP      3328
#define XB_TOPGEN   3392
#define XCD_BAR_WORDS 3456
#define XB_SPIN_CAP (1u << 18)
__device__ __forceinline__ unsigned xb_ld(unsigned* p)              { return __hip_atomic_load(p, __ATOMIC_RELAXED, __HIP_MEMORY_SCOPE_AGENT); }
__device__ __forceinline__ unsigned xb_add(unsigned* p, unsigned v) { return __hip_atomic_fetch_add(p, v, __ATOMIC_RELAXED, __HIP_MEMORY_SCOPE_AGENT); }
__device__ __forceinline__ unsigned xb_xcc_id() { return (unsigned)__builtin_amdgcn_s_getreg((3 << 11) | 20) & 0xFu; }
#define XB_SPIN(cond, bar) do { unsigned _sp = 0; while (cond) { __builtin_amdgcn_s_sleep(1); \
    if ((++_sp & 255u) == 0u) { if (xb_ld(&(bar)[XB_TMO])) break; if (_sp > XB_SPIN_CAP) { atomicAdd(&(bar)[XB_TMO], 1u); break; } } } } while (0)
struct XcdBarrier { unsigned* bar; unsigned x; volatile LAS unsigned* st; };
__device__ __forceinline__ XcdBarrier xcd_barrier_post(unsigned* bar, volatile LAS unsigned* st, bool leader) {
    XcdBarrier b; b.bar = bar; b.x = xb_xcc_id(); b.st = st;
    if (leader) (void)xb_add(&bar[XB_XCNT(b.x)], 1u);
    return b;
}
__device__ __forceinline__ void xcd_barrier_complete(unsigned* bar, unsigned x, unsigned& nloc, unsigned& nx) {
    const unsigned G = gridDim.x * gridDim.y * gridDim.z;
    unsigned sum, cnt, mine, sp = 0u;
    for (;;) {
        sum = 0u; cnt = 0u; mine = 0u;
#pragma unroll
        for (unsigned j = 0; j < 16; ++j) { const unsigned c = xb_ld(&bar[XB_XCNT(j)]); sum += c; cnt += (c > 0u) ? 1u : 0u; mine = (j == x) ? c : mine; }
        if (sum == G) break;
        __builtin_amdgcn_s_sleep(1);
        if ((++sp & 255u) == 0u) { if (xb_ld(&bar[XB_TMO])) break; if (sp > XB_SPIN_CAP) { atomicAdd(&bar[XB_TMO], 1u); break; } }
    }
    nloc = mine > 0u ? mine : 1u; nx = cnt > 0u ? cnt : 1u;
}
__device__ __forceinline__ void xcd_barrier(const XcdBarrier& b, bool leader) {
    asm volatile("s_waitcnt vmcnt(0)" ::: "memory");
    __syncthreads();
    if (leader) {
        unsigned* bar = b.bar;
        __builtin_amdgcn_s_waitcnt(0);
        unsigned nloc = b.st[0], nx = b.st[1];
        if (nloc == 0u) { xcd_barrier_complete(bar, b.x, nloc, nx); b.st[0] = nloc; b.st[1] = nx; }
        const unsigned old = xb_add(&bar[XB_XSUB(b.x)], 1u);
        const unsigned gen = old / nloc;
        if (old + 1u == (gen + 1u) * nloc) {
            __builtin_amdgcn_fence(__ATOMIC_RELEASE, "agent");
            asm volatile("s_waitcnt vmcnt(0)" ::: "memory");
            const unsigned og = xb_add(&bar[XB_TOP], 1u);
            const unsigned tg = og / nx;
            if (og + 1u == (tg + 1u) * nx) xb_add(&bar[XB_TOPGEN], 1u);
            else XB_SPIN(xb_ld(&bar[XB_TOPGEN]) == tg, bar);
            __builtin_amdgcn_fence(__ATOMIC_ACQUIRE, "agent");
            xb_add(&bar[XB_XGEN(b.x)], 1u);
            asm volatile("s_waitcnt vmcnt(0)" ::: "memory");
        } else {
            XB_SPIN(xb_ld(&bar[XB_XGEN(b.x)]) == gen, bar);
            __builtin_amdgcn_fence(__ATOMIC_ACQUIRE, "agent");
            asm volatile("s_waitcnt vmcnt(0)" ::: "memory");
        }
    }
    __syncthreads();
}

struct Frame { LAS unsigned char* lds; int tid, lane, wave, vcu, G; };
__device__ __forceinline__ Frame make_frame(LAS unsigned char* lds, int s_wave) {
    Frame F; F.lds = lds; int t = tid_from_wave(s_wave); asm volatile("" : "+v"(t)); F.tid = t; F.lane = t & 63; F.wave = __builtin_amdgcn_readfirstlane(t >> 6);
    F.G = gridDim.x; { const int bx = blockIdx.x; F.vcu = (F.G % 8 == 0) ? (bx % 8) * (F.G / 8) + bx / 8 : bx; }
    return F;
}

__device__ __forceinline__ float wave_sum(float v) {
    v = xadd<1>(v); v = xadd<2>(v); v = xadd<4>(v); v = xadd<8>(v); v = xadd<16>(v); v = xadd<32>(v);
    return v;
}

struct Ptrs {
    const float *xp, *xs, *ck, *cv, *sc, *nmix, *w_in, *sinks, *lng, *lnb, *gws, *gbs, *wpa, *wpb, *wout, *nffn, *wup, *cw, *cb, *wdn, *nfin;
    float* out; unsigned char* ws;
};

struct TItem { const float* W; bf16_t* WT; const float* gain; int N, ldt, col_off, k0, n0, n0d; };
__device__ __forceinline__ void titem_decode(const Ptrs& P, int it, TItem& t) {
    constexpr int I_IN = 16 * 160, I_PA = 16 * 32, I_PB = 12 * 32, I_OUT = 16 * 32, I_UP = 16 * 176, I_DN = 44 * 32, I_L = I_IN + I_PA + I_PB + I_OUT + I_UP + I_DN;
    const int l = it / I_L; int r = it % I_L; int remap = 0;
    if (r < I_IN) { t.W = P.w_in + (size_t)l * DM * NIN; t.N = NIN; t.WT = (bf16_t*)(P.ws + WS_WIN) + (size_t)l * NIN * DM; t.ldt = DM; t.col_off = 0; t.gain = P.nmix + l * DM; remap = 1; }
    else if ((r -= I_IN) < I_PA) { t.W = P.wpa + (size_t)l * DM * DM; t.N = DM; t.WT = (bf16_t*)(P.ws + WS_WM) + (size_t)l * DM * KM; t.ldt = KM; t.col_off = 0; t.gain = nullptr; }
    else if ((r -= I_PA) < I_PB) { t.W = P.wpb + (size_t)l * GW * DM; t.N = DM; t.WT = (bf16_t*)(P.ws + WS_WM) + (size_t)l * DM * KM; t.ldt = KM; t.col_off = 1024; t.gain = nullptr; }
    else if ((r -= I_PB) < I_OUT) { t.W = P.wout + (size_t)l * DM * DM; t.N = DM; t.WT = (bf16_t*)(P.ws + WS_WOUT) + (size_t)l * DM * DM; t.ldt = DM; t.col_off = 0; t.gain = nullptr; }
    else if ((r -= I_OUT) < I_UP) { t.W = P.wup + (size_t)l * DM * NUP; t.N = NUP; t.WT = (bf16_t*)(P.ws + WS_WUP) + (size_t)l * NUP * DM; t.ldt = DM; t.col_off = 0; t.gain = P.nffn + l * DM; remap = 2; }
    else { r -= I_UP; t.W = P.wdn + (size_t)l * DFF * DM; t.N = DM; t.WT = (bf16_t*)(P.ws + WS_WDN) + (size_t)l * DM * DFF; t.ldt = DFF; t.col_off = 0; t.gain = nullptr; }
    const int nblk = t.N / 32, kb = r / nblk, nb = r % nblk; t.k0 = 64 * kb; t.n0 = 32 * nb; t.n0d = t.n0;
    if (remap == 1 && t.n0 >= C_GA) { const int h = t.n0 >= C_GB, a = t.n0 - (h ? C_GB : C_GA); t.n0d = C_GA + 256 * (a >> 7) + 128 * h + (a & 127); }
    if (remap == 2) { const int h = t.n0 >= DFF, a = t.n0 - (h ? DFF : 0); t.n0d = 256 * (a >> 7) + 128 * h + (a & 127); }
}
__device__ __forceinline__ void titem_load(const TItem& t, f32x4 (&v)[8], int lane) {
    const float* p = t.W + (size_t)(t.k0 + (lane >> 3)) * t.N + t.n0 + (lane & 7) * 4;
#pragma unroll
#ifndef MK_WT_NT
#define MK_WT_NT 2
#endif
#if MK_WT_NT >= 1
    for (int i = 0; i < 8; ++i) v[i] = __builtin_nontemporal_load((const f32x4*)(p + (size_t)(8 * i) * t.N));
#else
    for (int i = 0; i < 8; ++i) v[i] = *(const f32x4*)(p + (size_t)(8 * i) * t.N);
#endif
}
__device__ __forceinline__ void titem_finish(const TItem& t, const f32x4 (&v)[8], LAS float* scr, int lane) {
#pragma unroll
    for (int i = 0; i < 8; ++i) { const int kk = 8 * i + (lane >> 3); const float gsc = t.gain ? t.gain[t.k0 + kk] : 1.0f; LAS float* s = scr + kk * 33 + (lane & 7) * 4;
        s[0] = v[i][0] * gsc; s[1] = v[i][1] * gsc; s[2] = v[i][2] * gsc; s[3] = v[i][3] * gsc; }
    LDS_WAIT(); asm volatile("" ::: "memory");
    const int c = lane & 7;
#pragma unroll
    for (int j = 0; j < 4; ++j) { const int n = (lane >> 3) + 8 * j; const LAS float* s = scr + (8 * c) * 33 + n;
        u32x4 o; o.x = cvtpk(s[0 * 33], s[1 * 33]); o.y = cvtpk(s[2 * 33], s[3 * 33]); o.z = cvtpk(s[4 * 33], s[5 * 33]); o.w = cvtpk(s[6 * 33], s[7 * 33]);
#if MK_WT_NT >= 2
        __builtin_nontemporal_store(o, (GAS u32x4*)(t.WT + (size_t)(t.n0d + n) * t.ldt + t.col_off + t.k0 + 8 * c)); }
#else
        *(GAS u32x4*)(t.WT + (size_t)(t.n0d + n) * t.ldt + t.col_off + t.k0 + 8 * c) = o; }
#endif
    LDS_WAIT(); asm volatile("" ::: "memory");
}
__device__ __forceinline__ void job_weights(const Ptrs& P, int l, LAS float* scr, int gw, int NGW, int lane) {
    constexpr int I_L = 8192; const int beg = l * I_L, end = beg + I_L;
    int it = beg + gw; TItem ta, tb; f32x4 va[8], vb[8];
#if defined(MK_W_NOPF)
    if (NGW < 2048) { for (; it < end; it += NGW) { titem_decode(P, it, ta); titem_load(ta, va, lane); titem_finish(ta, va, scr, lane); } return; }
#endif
    if (it < end) { titem_decode(P, it, ta); titem_load(ta, va, lane); }
    while (it < end) {
        const int it1 = it + NGW; if (it1 < end) { titem_decode(P, it1, tb); titem_load(tb, vb, lane); }
        titem_finish(ta, va, scr, lane);
        if (it1 >= end) break;
        const int it2 = it1 + NGW; if (it2 < end) { titem_decode(P, it2, ta); titem_load(ta, va, lane); }
        titem_finish(tb, vb, scr, lane);
        it = it2;
    }
}
__device__ __forceinline__ void job_cache_copy(const Ptrs& P, int l, int gt, int NT) {
    constexpr int PER = 7680, TOT = 2 * SB * PER;
    const float* ckl = P.ck + (size_t)l * SB * 32768; const float* cvl = P.cv + (size_t)l * SB * 32768; float* okl = P.out + O_WKS + (size_t)l * SB * 32768; float* ovl = P.out + O_WVS + (size_t)l * SB * 32768;
    for (int e0 = gt; e0 < TOT; e0 += 8 * NT) {
        f32x4 v[8];
#pragma unroll
        for (int q = 0; q < 8; ++q) { const int e = e0 + q * NT; if (e < TOT) { const int which = e >= SB * PER, r = which ? e - SB * PER : e, b = r / PER, o = r % PER; v[q] = *(const f32x4*)((which ? cvl : ckl) + (size_t)b * 32768 + 2048 + (size_t)o * 4); } }
#pragma unroll
        for (int q = 0; q < 8; ++q) { const int e = e0 + q * NT; if (e < TOT) { const int which = e >= SB * PER, r = which ? e - SB * PER : e, b = r / PER, o = r % PER; *(f32x4*)((which ? ovl : okl) + (size_t)b * 32768 + (size_t)o * 4) = v[q]; } }
    }
}

__device__ __forceinline__ void p0_prologue(LAS unsigned char* lds_, const Ptrs& P, int s_wave) {
    const Frame F = make_frame(lds_, s_wave);
    LAS float* scr = (LAS float*)(F.lds + RING_OFF + F.wave * 16384);
    const int gw = F.vcu * 8 + F.wave, NGW = F.G * 8;
    job_weights(P, 0, scr, gw, NGW, F.lane);
    { bf16_t* WSB = (bf16_t*)(P.ws + WS_WSB); const int gt = gw * 64 + F.lane, NT = NGW * 64;
      for (int e = gt; e < DEPTH * 6 * 128 * 64; e += NT) { const int s = (e & 63) * 2, t = (e >> 6) & 127; const f32x2 w = *(const f32x2*)(P.gws + (size_t)e * 2);
          *(unsigned*)(WSB + (size_t)e * 2) = cvtpk(s <= t ? w[0] : 0.f, s + 1 <= t ? w[1] : 0.f); } }
    { bf16_t* XB = (bf16_t*)(P.ws + WS_XB); float* xsq = (float*)(P.ws + WS_XSQ);
      for (int m0 = gw; m0 < M; m0 += 2 * NGW) {
          f32x4 v[2][4];
#pragma unroll
          for (int q = 0; q < 2; ++q) { const int m = m0 + q * NGW; if (m < M) { const float* src = m < MP ? P.xp + (size_t)m * DM : P.xs + (size_t)(m - MP) * DM;
#pragma unroll
              for (int j = 0; j < 4; ++j) v[q][j] = __builtin_nontemporal_load((const f32x4*)(src + 4 * F.lane + 256 * j)); } }
#pragma unroll
          for (int q = 0; q < 2; ++q) { const int m = m0 + q * NGW; if (m < M) { float s = 0.f;
#pragma unroll
              for (int j = 0; j < 4; ++j) { u32x2 w; w.x = cvtpk(v[q][j][0], v[q][j][1]); w.y = cvtpk(v[q][j][2], v[q][j][3]); *(u32x2*)(XB + (size_t)m * DM + 4 * F.lane + 256 * j) = w;
                  const float a = bflo(w.x), b = bfhi(w.x), c = bflo(w.y), d = bfhi(w.y); s += (a * a + b * b) + (c * c + d * d); }
              s = wave_sum(s);
              if (F.lane < 4) *(f32x4*)(xsq + (size_t)m * 16 + 4 * F.lane) = (f32x4){F.lane == 0 ? s : 0.f, 0.f, 0.f, 0.f}; } }
      } }
}
__device__ __forceinline__ void p1_workers(LAS unsigned char* lds_, const Ptrs& P, int l, int widx, int nworkers, int s_wave) {
    const Frame F = make_frame(lds_, s_wave);
    LAS float* scr = (LAS float*)(F.lds + RING_OFF + F.wave * 16384);
    if (l + 1 < DEPTH) job_weights(P, l + 1, scr, widx * 8 + F.wave, nworkers * 8, F.lane);
}

constexpr int AT_K = 0, AT_V = 24576, AT_BUF = 49152, AT_WS = 2 * AT_BUF, AT_OST = AT_WS + 2048;
constexpr int GM_VN = 0, GM_ST = 32768, GM_OST = 34816;
__device__ __forceinline__ f32x16 zero16() { float z = 0.f; asm volatile("" : "+v"(z)); f32x16 r;
#pragma unroll
    for (int i = 0; i < 16; ++i) r[i] = z;
    return r; }
__device__ __forceinline__ f32x16 mfma32(bf16x8 a, bf16x8 b, f32x16 c) { return __builtin_amdgcn_mfma_f32_32x32x16_bf16(a, b, c, 0, 0, 0); }
typedef short v4i16_t __attribute__((ext_vector_type(4)));
__device__ __forceinline__ s16x4 vtr(LAS const unsigned char* p) { return __builtin_bit_cast(s16x4, __builtin_amdgcn_ds_read_tr16_b64_v4i16((LAS v4i16_t*)p)); }
#define PK8(lo, hi) (bf16x8){lo[0], lo[1], lo[2], lo[3], hi[0], hi[1], hi[2], hi[3]}
__device__ __forceinline__ bf16x8 pack8(float a0, float a1, float a2, float a3, float a4, float a5, float a6, float a7) {
    u32x4 w; w.x = cvtpk(a0, a1); w.y = cvtpk(a2, a3); w.z = cvtpk(a4, a5); w.w = cvtpk(a6, a7); return __builtin_bit_cast(bf16x8, w); }

#ifndef MK_SM_PK
#define MK_SM_PK 1
#endif
__device__ __forceinline__ float softmax5(f32x16 (&p)[5], float sink2) {
    float m = sink2;
#pragma unroll
    for (int j = 0; j < 5; ++j)
#pragma unroll
        for (int r = 0; r < 16; ++r) m = fmaxf(m, p[j][r]);
    { auto rr = __builtin_amdgcn_permlane32_swap(__float_as_uint(m), __float_as_uint(m), false, false); m = fmaxf(__uint_as_float(rr[0]), __uint_as_float(rr[1])); }
    float l = 0.f;
#if MK_SM_PK
    { f32x2 l2 = {0.f, 0.f}; const f32x2 m2 = {m, m};
#pragma unroll
      for (int j = 0; j < 5; ++j)
#pragma unroll
          for (int r = 0; r < 16; r += 2) { const f32x2 d = (f32x2){p[j][r], p[j][r + 1]} - m2; f32x2 e; e[0] = __builtin_amdgcn_exp2f(d[0]); e[1] = __builtin_amdgcn_exp2f(d[1]); p[j][r] = e[0]; p[j][r + 1] = e[1]; l2 += e; }
      l = l2[0] + l2[1]; }
#else
#pragma unroll
    for (int j = 0; j < 5; ++j)
#pragma unroll
        for (int r = 0; r < 16; ++r) { p[j][r] = __builtin_amdgcn_exp2f(p[j][r] - m); l += p[j][r]; }
#endif
    { auto rr = __builtin_amdgcn_permlane32_swap(__float_as_uint(l), __float_as_uint(l), false, false); l = __uint_as_float(rr[0]) + __uint_as_float(rr[1]); }
    return l + __builtin_amdgcn_exp2f(sink2 - m);
}

__device__ __forceinline__ void attn_prompt_load(const Frame& F, const bf16_t* Z, int U, int bo, bf16x8 (&qr)[4]) {
    LAS unsigned char* lds = F.lds + bo;
    const int b = U >> 9, kvh = (U >> 7) & 3, qb = U & 127;
    const int lane = F.lane, wid = F.wave, r32 = lane & 31, hi = lane >> 5, g = wid >> 1, rh = wid & 1;
    const int pos0 = 64 * qb - 128; const size_t rowb = (size_t)b * SEQ;
#pragma unroll
    for (int tl = 0; tl < 3; ++tl) {
        int pk = pos0 + 64 * tl + lane; pk = pk < 0 ? 0 : pk;
        __builtin_amdgcn_global_load_lds((const unsigned*)(Z + (rowb + pk) * NIN + C_K + kvh * 64 + wid * 8), (LAS unsigned*)(lds + AT_K + tl * 8192 + wid * 1024), 16, 0, 0);
        int pv = pos0 + 64 * tl + 16 * (wid & 3) + (lane >> 2); pv = pv < 0 ? 0 : pv;
        __builtin_amdgcn_global_load_lds((const unsigned*)(Z + (rowb + pv) * NIN + C_V + kvh * 64 + (wid >> 2) * 32 + (lane & 3) * 8), (LAS unsigned*)(lds + AT_V + tl * 8192 + wid * 1024), 16, 0, 0);
    }
    const size_t qrow = rowb + 64 * qb + 32 * rh + r32;
#pragma unroll
    for (int d0 = 0; d0 < 4; ++d0) qr[d0] = *(const bf16x8*)(Z + qrow * NIN + C_Q + (kvh * 4 + g) * 64 + d0 * 16 + hi * 8);
}
__device__ __forceinline__ void attn_prompt_compute(const Frame& F, bf16_t* OS, float* owk, float* owv, const float* sinks_l, int U, int bo, const bf16x8 (&qr)[4]) {
    LAS unsigned char* lds = F.lds + bo;
    const int b = U >> 9, kvh = (U >> 7) & 3, qb = U & 127;
    const int lane = F.lane, wid = F.wave, r32 = lane & 31, hi = lane >> 5, g = wid >> 1, rh = wid & 1;
    const int pos0 = 64 * qb - 128; const size_t rowb = (size_t)b * SEQ;
    f32x16 p[5];
    const f32x16 Z0 = zero16();
    float ng_ = NEGBIG; asm volatile("" : "+v"(ng_));
#pragma unroll
    for (int j = 0; j < 5; ++j) {
        const int kbk = rh + j; LAS const unsigned char* kb = lds + AT_K + (kbk >> 1) * 8192 + hi * 1024 + ((kbk & 1) * 32 + r32) * 16;
        f32x16 a = Z0;
#pragma unroll
        for (int d0 = 0; d0 < 4; ++d0) a = mfma32(*(LAS const bf16x8*)(kb + d0 * 2048), qr[d0], a);
        p[j] = a;
    }
#pragma unroll
    for (int r = 0; r < 16; ++r) { const int cr = crow(r, hi); if (cr <= r32) p[0][r] = ng_; if (cr > r32) p[4][r] = ng_; }
    if (qb < 2) {
#pragma unroll
        for (int j = 0; j < 5; ++j)
#pragma unroll
            for (int r = 0; r < 16; ++r) if (pos0 + 32 * (rh + j) + crow(r, hi) < 0) p[j][r] = ng_;
    }
    const float l = softmax5(p, sinks_l[kvh * 4 + g] * LOG2E);
    f32x16 o0 = Z0, o1 = Z0;
    const int vlane = ((lane >> 4) & 1) * 32 + (lane & 3) * 8 + (4 * hi + ((lane & 15) >> 2)) * 64;
#pragma unroll
    for (int j = 0; j < 5; ++j) {
        const int kbk = rh + j;
#pragma unroll
        for (int s = 0; s < 2; ++s) {
            const bf16x8 pa = pack8(p[j][8 * s + 0], p[j][8 * s + 1], p[j][8 * s + 2], p[j][8 * s + 3], p[j][8 * s + 4], p[j][8 * s + 5], p[j][8 * s + 6], p[j][8 * s + 7]);
            LAS const unsigned char* vb = lds + AT_V + (kbk >> 1) * 8192 + (2 * (kbk & 1) + s) * 1024 + vlane;
            { const s16x4 lo = vtr(vb), hh = vtr(vb + 512); o0 = mfma32(pa, PK8(lo, hh), o0); }
            { const s16x4 lo = vtr(vb + 4096), hh = vtr(vb + 4096 + 512); o1 = mfma32(pa, PK8(lo, hh), o1); }
        }
    }
    LAS float* wsf = (LAS float*)(F.lds + AT_WS) + wid * 64;
    if (hi == 0) wsf[r32] = l;
    LDS_WAIT();
    LAS bf16_t* stg = (LAS bf16_t*)(F.lds + AT_OST) + wid * 2048;
#pragma unroll
    for (int r = 0; r < 16; ++r) { const int orow = crow(r, hi); const float rl = __builtin_amdgcn_rcpf(wsf[orow]);
        stg[orow * 64 + r32] = (bf16_t)(cvtpk(o0[r] * rl, 0.f) & 0xffffu); stg[orow * 64 + 32 + r32] = (bf16_t)(cvtpk(o1[r] * rl, 0.f) & 0xffffu); }
    LDS_WAIT();
    bf16_t* Ow = OS + (rowb + 64 * qb + 32 * rh) * KM + (kvh * 4 + g) * 64;
#pragma unroll
    for (int i = 0; i < 4; ++i) { const int row = i * 8 + (lane >> 3), ch = lane & 7; const u32x4 v = *(LAS const u32x4*)(stg + row * 64 + ch * 8); *(u32x4*)(Ow + (size_t)row * KM + ch * 8) = v; }
    if (qb >= 126) {
        const int row = F.tid & 63, c = F.tid >> 6, j = 64 * (qb - 126) + row;
        const u32x4 kk = *(LAS const u32x4*)(lds + AT_K + 2 * 8192 + c * 1024 + row * 16);
        const u32x4 vv = *(LAS const u32x4*)(lds + AT_V + 2 * 8192 + (c >> 2) * 4096 + (row >> 4) * 1024 + (row & 15) * 64 + (c & 3) * 16);
        float* dk = owk + ((size_t)(b * WIN + j)) * 256 + kvh * 64 + c * 8; float* dv = owv + ((size_t)(b * WIN + j)) * 256 + kvh * 64 + c * 8;
        *(f32x4*)dk = (f32x4){bflo(kk.x), bfhi(kk.x), bflo(kk.y), bfhi(kk.y)}; *(f32x4*)(dk + 4) = (f32x4){bflo(kk.z), bfhi(kk.z), bflo(kk.w), bfhi(kk.w)};
        *(f32x4*)dv = (f32x4){bflo(vv.x), bfhi(vv.x), bflo(vv.y), bfhi(vv.y)}; *(f32x4*)(dv + 4) = (f32x4){bflo(vv.z), bfhi(vv.z), bflo(vv.w), bfhi(vv.w)};
    }
}

constexpr int SA_K = 0, SA_V = 32768, SA_WS = 65536, SA_OST = 65536 + 2048;
__device__ __forceinline__ void sample_stage_kv(const Frame& F, const float* ck, const float* cv, float* owk, float* owv, int b, int hp) {
    LAS unsigned char* lds = F.lds;
    f32x4 kx[4][2], vx[4][2];
#pragma unroll
    for (int q = 0; q < 4; ++q) { const int idx = F.tid + 512 * q, key = idx >> 4, hl = (idx >> 3) & 1, c = idx & 7;
        const size_t off = ((size_t)(b * WIN + key) * 4 + 2 * hp + hl) * 64 + c * 8;
        kx[q][0] = *(const f32x4*)(ck + off); kx[q][1] = *(const f32x4*)(ck + off + 4); vx[q][0] = *(const f32x4*)(cv + off); vx[q][1] = *(const f32x4*)(cv + off + 4); }
#pragma unroll
    for (int q = 0; q < 4; ++q) { const int idx = F.tid + 512 * q, key = idx >> 4, hl = (idx >> 3) & 1, c = idx & 7;
        u32x4 wk, wv; wk.x = cvtpk(kx[q][0][0], kx[q][0][1]); wk.y = cvtpk(kx[q][0][2], kx[q][0][3]); wk.z = cvtpk(kx[q][1][0], kx[q][1][1]); wk.w = cvtpk(kx[q][1][2], kx[q][1][3]);
        wv.x = cvtpk(vx[q][0][0], vx[q][0][1]); wv.y = cvtpk(vx[q][0][2], vx[q][0][3]); wv.z = cvtpk(vx[q][1][0], vx[q][1][1]); wv.w = cvtpk(vx[q][1][2], vx[q][1][3]);
        *(LAS u32x4*)(lds + SA_K + hl * 16384 + (key >> 6) * 8192 + c * 1024 + (key & 63) * 16) = wk;
        *(LAS u32x4*)(lds + SA_V + hl * 16384 + (key >> 6) * 8192 + (c >> 2) * 4096 + ((key & 63) >> 4) * 1024 + (key & 15) * 64 + (c & 3) * 16) = wv;
        if (key >= 8) {
            const size_t oo = ((size_t)(b * WIN + key - 8) * 4 + 2 * hp + hl) * 64 + c * 8;
            *(f32x4*)(owk + oo) = kx[q][0]; *(f32x4*)(owk + oo + 4) = kx[q][1]; *(f32x4*)(owv + oo) = vx[q][0]; *(f32x4*)(owv + oo + 4) = vx[q][1]; } }
}
__device__ __forceinline__ void attn_sample_wave(const Frame& F, const bf16_t* Z, bf16_t* OS, float* owk, float* owv, const float* sinks_l, int b, int kvh, int hl) {
    LAS unsigned char* lds = F.lds;
    const int lane = F.lane, wid = F.wave, r32 = lane & 31, hi = lane >> 5, g = r32 >> 3, qi = r32 & 7;
    const size_t qrow = (size_t)MP + b * 8 + qi;
    bf16x8 qr[4];
#pragma unroll
    for (int d0 = 0; d0 < 4; ++d0) qr[d0] = *(const bf16x8*)(Z + qrow * NIN + C_Q + (kvh * 4 + g) * 64 + d0 * 16 + hi * 8);
    f32x16 p[5];
    float ng_ = NEGBIG; asm volatile("" : "+v"(ng_));
#pragma unroll
    for (int j = 0; j < 4; ++j) {
        LAS const unsigned char* kb = lds + SA_K + hl * 16384 + (j >> 1) * 8192 + hi * 1024 + ((j & 1) * 32 + r32) * 16;
        f32x16 a = zero16();
#pragma unroll
        for (int d0 = 0; d0 < 4; ++d0) a = mfma32(*(LAS const bf16x8*)(kb + d0 * 2048), qr[d0], a);
        p[j] = a;
    }
    { const size_t krow = (size_t)MP + b * 8 + (r32 < 8 ? r32 : 7); f32x16 a = zero16();
#pragma unroll
      for (int d0 = 0; d0 < 4; ++d0) a = mfma32(*(const bf16x8*)(Z + krow * NIN + C_K + kvh * 64 + d0 * 16 + hi * 8), qr[d0], a);
      p[4] = a; }
#pragma unroll
    for (int r = 0; r < 16; ++r) { const int cr = crow(r, hi); if (cr <= qi) p[0][r] = ng_; if (cr > qi) p[4][r] = ng_; }
    const float l = softmax5(p, sinks_l[kvh * 4 + g] * LOG2E);
    f32x16 o0 = zero16(), o1 = zero16();
    const int vlane = ((lane >> 4) & 1) * 32 + (lane & 3) * 8 + (4 * hi + ((lane & 15) >> 2)) * 64;
#pragma unroll
    for (int j = 0; j < 4; ++j)
#pragma unroll
        for (int s = 0; s < 2; ++s) {
            const bf16x8 pa = pack8(p[j][8 * s + 0], p[j][8 * s + 1], p[j][8 * s + 2], p[j][8 * s + 3], p[j][8 * s + 4], p[j][8 * s + 5], p[j][8 * s + 6], p[j][8 * s + 7]);
            LAS const unsigned char* vb = lds + SA_V + hl * 16384 + (j >> 1) * 8192 + (2 * (j & 1) + s) * 1024 + vlane;
            { const s16x4 lo = vtr(vb), hh = vtr(vb + 512); o0 = mfma32(pa, PK8(lo, hh), o0); }
            { const s16x4 lo = vtr(vb + 4096), hh = vtr(vb + 4096 + 512); o1 = mfma32(pa, PK8(lo, hh), o1); }
        }
    { const bf16x8 pa = pack8(p[4][0], p[4][1], p[4][2], p[4][3], p[4][4], p[4][5], p[4][6], p[4][7]);
      const bf16_t* vp = Z + ((size_t)MP + b * 8 + 4 * hi) * NIN + C_V + kvh * 64 + r32;
      u32x4 x = {0u, 0u, 0u, 0u}, y = {0u, 0u, 0u, 0u};
      x.x = (unsigned)vp[0] | ((unsigned)vp[NIN] << 16); x.y = (unsigned)vp[2 * NIN] | ((unsigned)vp[3 * NIN] << 16);
      y.x = (unsigned)vp[32] | ((unsigned)vp[NIN + 32] << 16); y.y = (unsigned)vp[2 * NIN + 32] | ((unsigned)vp[3 * NIN + 32] << 16);
      o0 = mfma32(pa, __builtin_bit_cast(bf16x8, x), o0); o1 = mfma32(pa, __builtin_bit_cast(bf16x8, y), o1); }
    LAS float* wsf = (LAS float*)(lds + SA_WS) + wid * 64;
    if (hi == 0) wsf[r32] = l;
    LDS_WAIT();
    LAS bf16_t* stg = (LAS bf16_t*)(lds + SA_OST) + wid * 2048;
#pragma unroll
    for (int r = 0; r < 16; ++r) { const int orow = crow(r, hi); const float rl = __builtin_amdgcn_rcpf(wsf[orow]);
        stg[orow * 64 + r32] = (bf16_t)(cvtpk(o0[r] * rl, 0.f) & 0xffffu); stg[orow * 64 + 32 + r32] = (bf16_t)(cvtpk(o1[r] * rl, 0.f) & 0xffffu); }
    LDS_WAIT();
#pragma unroll
    for (int i = 0; i < 4; ++i) { const int row = i * 8 + (lane >> 3), ch = lane & 7; const u32x4 v = *(LAS const u32x4*)(stg + row * 64 + ch * 8);
        *(u32x4*)(OS + ((size_t)MP + b * 8 + (row & 7)) * KM + (kvh * 4 + (row >> 3)) * 64 + ch * 8) = v; }
    { const int i = lane >> 3, c = (lane & 7) * 8; const bf16_t* zr = Z + ((size_t)MP + b * 8 + i) * NIN + kvh * 64 + c;
      const u32x4 kk = *(const u32x4*)(zr + C_K), vv = *(const u32x4*)(zr + C_V);
      float* dk = owk + ((size_t)(b * WIN + 120 + i)) * 256 + kvh * 64 + c; float* dv = owv + ((size_t)(b * WIN + 120 + i)) * 256 + kvh * 64 + c;
      *(f32x4*)dk = (f32x4){bflo(kk.x), bfhi(kk.x), bflo(kk.y), bfhi(kk.y)}; *(f32x4*)(dk + 4) = (f32x4){bflo(kk.z), bfhi(kk.z), bflo(kk.w), bfhi(kk.w)};
      *(f32x4*)dv = (f32x4){bflo(vv.x), bfhi(vv.x), bflo(vv.y), bfhi(vv.y)}; *(f32x4*)(dv + 4) = (f32x4){bflo(vv.z), bfhi(vv.z), bflo(vv.w), bfhi(vv.w)}; }
}

__device__ __forceinline__ void gmlp_prompt_unit(const Frame& F, const bf16_t* Z, bf16_t* OS, const float* gvst, const float* lng, const float* lnb, const bf16_t* wsb_l, const float* bs_l, int b, int ch, int g) {
    LAS unsigned char* lds = F.lds;
    const int tid = F.tid, lane = F.lane, wid = F.wave, r32 = lane & 31, hi = lane >> 5, tb = wid >> 1, chh = wid & 1;
    const size_t R0 = (size_t)b * SEQ + 128 * ch;
    LAS f32x2* st = (LAS f32x2*)(lds + GM_ST);
    f32x4 sp[6];
    if (tid < 128) { const float* pp = gvst + (R0 + tid) * 24;
#pragma unroll
        for (int k = 0; k < 6; ++k) sp[k] = *(const f32x4*)(pp + 4 * k); }
    const int c8 = (tid & 15) * 8;
    u32x4 xg[4];
#pragma unroll
    for (int it = 0; it < 4; ++it) xg[it] = *(const u32x4*)(Z + (R0 + (tid >> 4) + 32 * it) * NIN + C_GV + 128 * g + c8);
    const f32x4 g0 = *(const f32x4*)(lng + 128 * g + c8), g1 = *(const f32x4*)(lng + 128 * g + c8 + 4), b0 = *(const f32x4*)(lnb + 128 * g + c8), b1 = *(const f32x4*)(lnb + 128 * g + c8 + 4);
    const int nks = 2 * (tb + 1);
    bf16x8 wf[8];
    { const bf16_t* wrow = wsb_l + ((size_t)g * 128 + 32 * tb + r32) * 128 + 8 * hi;
#pragma unroll
      for (int ks = 0; ks < 8; ++ks) if (ks < nks) wf[ks] = *(const bf16x8*)(wrow + 16 * ks); }
    u32x4 gu[4];
#pragma unroll
    for (int i = 0; i < 4; ++i) gu[i] = *(const u32x4*)(Z + (R0 + 32 * tb + i * 8 + (lane >> 3)) * NIN + C_GU + 128 * g + 64 * chh + (lane & 7) * 8);
    float bsv[16];
#pragma unroll
    for (int r = 0; r < 16; ++r) bsv[r] = bs_l[g * 128 + 32 * tb + crow(r, hi)];
    if (tid < 128) { float s1 = 0.f, s2 = 0.f;
#pragma unroll
        for (int k = 0; k < 6; ++k) { s1 += sp[k][0] + sp[k][2]; s2 += sp[k][1] + sp[k][3]; }
        const float mean = s1 * (1.0f / GW), var = fmaxf(s2 * (1.0f / GW) - mean * mean, 0.f); st[tid] = (f32x2){mean, __builtin_amdgcn_rsqf(var + EPS)}; }
    __syncthreads();
#pragma unroll
    for (int it = 0; it < 4; ++it) {
        const int s = (tid >> 4) + 32 * it; const u32x4 x = xg[it];
        const f32x2 ms = st[s];
        const float v0 = (bflo(x.x) - ms[0]) * ms[1] * g0[0] + b0[0], v1 = (bfhi(x.x) - ms[0]) * ms[1] * g0[1] + b0[1], v2 = (bflo(x.y) - ms[0]) * ms[1] * g0[2] + b0[2], v3 = (bfhi(x.y) - ms[0]) * ms[1] * g0[3] + b0[3];
        const float v4 = (bflo(x.z) - ms[0]) * ms[1] * g1[0] + b1[0], v5 = (bfhi(x.z) - ms[0]) * ms[1] * g1[1] + b1[1], v6 = (bflo(x.w) - ms[0]) * ms[1] * g1[2] + b1[2], v7 = (bfhi(x.w) - ms[0]) * ms[1] * g1[3] + b1[3];
        u32x4 w; w.x = cvtpk(v0, v1); w.y = cvtpk(v2, v3); w.z = cvtpk(v4, v5); w.w = cvtpk(v6, v7);
        *(LAS u32x4*)(lds + GM_VN + ((c8 >> 5) * 8 + (s >> 4)) * 1024 + (s & 15) * 64 + (c8 & 31) * 2) = w;
    }
    __syncthreads();
    f32x16 a0 = zero16(), a1 = zero16();
    const int vlane = ((lane >> 4) & 1) * 32 + (lane & 3) * 8 + (8 * hi + ((lane & 15) >> 2)) * 64;
#pragma unroll
    for (int ks = 0; ks < 8; ++ks) if (ks < nks) {
        LAS const unsigned char* vb = lds + GM_VN + ((2 * chh) * 8 + ks) * 1024 + vlane;
        { const s16x4 lo = vtr(vb), hh = vtr(vb + 256); a0 = mfma32(wf[ks], PK8(lo, hh), a0); }
        { const s16x4 lo = vtr(vb + 8192), hh = vtr(vb + 8192 + 256); a1 = mfma32(wf[ks], PK8(lo, hh), a1); }
    }
    LAS bf16_t* stg = (LAS bf16_t*)(lds + GM_OST) + wid * 2048;
#pragma unroll
    for (int r = 0; r < 16; ++r) { const int orow = crow(r, hi);
        stg[orow * 64 + r32] = (bf16_t)(cvtpk(a0[r] + bsv[r], 0.f) & 0xffffu); stg[orow * 64 + 32 + r32] = (bf16_t)(cvtpk(a1[r] + bsv[r], 0.f) & 0xffffu); }
    LDS_WAIT();
#pragma unroll
    for (int i = 0; i < 4; ++i) { const int row = i * 8 + (lane >> 3), cc = (lane & 7) * 8; const u32x4 mx = *(LAS const u32x4*)(stg + row * 64 + cc);
        const size_t grow = R0 + 32 * tb + row; const u32x4 q = gu[i];
        u32x4 w; w.x = cvtpk(bflo(mx.x) * bflo(q.x), bfhi(mx.x) * bfhi(q.x)); w.y = cvtpk(bflo(mx.y) * bflo(q.y), bfhi(mx.y) * bfhi(q.y));
        w.z = cvtpk(bflo(mx.z) * bflo(q.z), bfhi(mx.z) * bfhi(q.z)); w.w = cvtpk(bflo(mx.w) * bflo(q.w), bfhi(mx.w) * bfhi(q.w));
        *(u32x4*)(OS + grow * KM + 1024 + 128 * g + 64 * chh + cc) = w; }
}

__device__ __forceinline__ void gmlp_sample_wave(const Frame& F, const bf16_t* Z, bf16_t* OS, const float* gvst, const float* lng, const float* lnb, const float* gws_l, const float* bs_l, float* ogv, int b, int c0) {
    const int lane = F.lane; const size_t R0 = (size_t)MP + b * 8;
    const int c = c0 + lane, g = c0 >> 7;
    unsigned short xv[8], xu[8];
#pragma unroll
    for (int i = 0; i < 8; ++i) { xv[i] = Z[(R0 + i) * NIN + C_GV + c]; xu[i] = Z[(R0 + i) * NIN + C_GU + c]; }
    float mean = 0.f, rstd = 0.f;
    { const float* pp = gvst + (R0 + (lane & 7)) * 24; float s1 = 0.f, s2 = 0.f;
#pragma unroll
      for (int k = 0; k < 6; ++k) { const f32x4 v = *(const f32x4*)(pp + 4 * k); s1 += v[0] + v[2]; s2 += v[1] + v[3]; }
      mean = s1 * (1.0f / GW); const float var = fmaxf(s2 * (1.0f / GW) - mean * mean, 0.f); rstd = __builtin_amdgcn_rsqf(var + EPS); }
    const float gg = lng[c], bb = lnb[c];
    float vn[8];
#pragma unroll
    for (int i = 0; i < 8; ++i) { const float mu = __uint_as_float(__builtin_amdgcn_readlane(__float_as_uint(mean), i)), rs = __uint_as_float(__builtin_amdgcn_readlane(__float_as_uint(rstd), i)); vn[i] = (bflo((unsigned)xv[i]) - mu) * rs * gg + bb; ogv[((size_t)b * 8 + i) * GW + c] = vn[i]; }
#pragma unroll
    for (int t = 0; t < 8; ++t) { float mx = bs_l[g * 128 + t];
#pragma unroll
        for (int s = 0; s <= t; ++s) mx += gws_l[(size_t)g * 16384 + t * 128 + s] * vn[s];
        OS[(R0 + t) * KM + 1024 + c] = (bf16_t)(cvtpk(bflo((unsigned)xu[t]) * mx, 0.f) & 0xffffu); }
}

__device__ __forceinline__ void p2_mixer(LAS unsigned char* lds_, const Ptrs& P, int l, int s_wave) {
    const Frame F = make_frame(lds_, s_wave);
    const bf16_t* Z = (const bf16_t*)(P.ws + WS_RA); bf16_t* OS = (bf16_t*)(P.ws + WS_RB); const float* gvst = (const float*)(P.ws + WS_GVST);
    const bf16_t* wsb_l = (const bf16_t*)(P.ws + WS_WSB) + (size_t)l * 6 * 16384;
    const float* sinks_l = P.sinks + l * 16; const float* lng = P.lng + l * GW; const float* lnb = P.lnb + l * GW; const float* bs_l = P.gbs + l * GW; const float* gws_l = P.gws + (size_t)l * 6 * 16384;
    float* owkp = P.out + O_WKP + (size_t)l * NB * WIN * 256; float* owvp = P.out + O_WVP + (size_t)l * NB * WIN * 256;
    float* owks = P.out + O_WKS + (size_t)l * SB * WIN * 256; float* owvs = P.out + O_WVS + (size_t)l * SB * WIN * 256;
    const float* ck = P.ck + (size_t)l * SB * WIN * 256; const float* cv = P.cv + (size_t)l * SB * WIN * 256; float* ogv = P.out + O_GVS + (size_t)l * SB * 8 * GW;
    constexpr int NU = 1024 + 768 + 256;
#ifndef MK_P2_REPS
#define MK_P2_REPS 1
#define MK_P2_CLASS 0
#endif
    for (int prep_ = 0; prep_ < MK_P2_REPS; ++prep_) {
    if (prep_ == 0 || (MK_P2_CLASS & 1)) {
        int U = F.vcu, bo = 0; bf16x8 qc[4], qn[4];
        __syncthreads();
#ifndef MK_P2X
#define MK_P2X 0
#endif
        constexpr int ALIM = (MK_P2X & 1) ? 2048 : 1024;
        if (U < ALIM) attn_prompt_load(F, Z, U & 1023, bo, qc);
        while (U < ALIM) {
            const int Un = U + F.G;
            VM_WAIT(); __syncthreads();
            if (Un < ALIM) attn_prompt_load(F, Z, Un & 1023, bo ^ AT_BUF, qn);
            attn_prompt_compute(F, OS, owkp, owvp, sinks_l, U & 1023, bo, qc);
#pragma unroll
            for (int d0 = 0; d0 < 4; ++d0) qc[d0] = qn[d0];
            U = Un; bo ^= AT_BUF;
        }
    }
    for (int U_ = F.vcu + ((1024 - F.vcu + F.G - 1) / F.G) * F.G; U_ < NU + ((MK_P2X & 2) ? 768 : (MK_P2X & 4) ? 256 : 0); U_ += F.G) {
        const int U = U_ < NU ? U_ : ((MK_P2X & 2) ? U_ - 1024 : U_ - 256);
        if (prep_ > 0) { const int cls = U < 1792 ? 2 : 4; if (!(cls & MK_P2_CLASS)) continue; }
        __syncthreads();
        if (false) {}
        else if (U < 1792) { const int V = U - 1024; gmlp_prompt_unit(F, Z, OS, gvst, lng, lnb, wsb_l, bs_l, V / 384, (V / 6) % 64, V % 6); }
        else { const int V = U - 1792, b = V >> 1, hp = V & 1;
            sample_stage_kv(F, ck, cv, owks, owvs, b, hp);
            LDS_WAIT(); __syncthreads();
            if (F.wave < 2) attn_sample_wave(F, Z, OS, owks, owvs, sinks_l, b, 2 * hp + F.wave, F.wave);
            else gmlp_sample_wave(F, Z, OS, gvst, lng, lnb, gws_l, bs_l, ogv, b, 384 * hp + 64 * (F.wave - 2)); }
    }
    }
}

__device__ __forceinline__ void ld8(const bf16_t* p, float (&v)[8]) { const u32x4 x = *(const u32x4*)p; v[0] = bflo(x.x); v[1] = bfhi(x.x); v[2] = bflo(x.y); v[3] = bfhi(x.y); v[4] = bflo(x.z); v[5] = bfhi(x.z); v[6] = bflo(x.w); v[7] = bfhi(x.w); }
__device__ __forceinline__ void ld8f(const float* p, float (&v)[8]) { const f32x4 a = *(const f32x4*)p, b = *(const f32x4*)(p + 4); v[0] = a[0]; v[1] = a[1]; v[2] = a[2]; v[3] = a[3]; v[4] = b[0]; v[5] = b[1]; v[6] = b[2]; v[7] = b[3]; }
__device__ __forceinline__ void st8f(float* p, const float (&v)[8]) { *(f32x4*)p = (f32x4){v[0], v[1], v[2], v[3]}; *(f32x4*)(p + 4) = (f32x4){v[4], v[5], v[6], v[7]}; }
__device__ __forceinline__ void st8f_nt(float* p, const float (&v)[8]) { __builtin_nontemporal_store((f32x4){v[0], v[1], v[2], v[3]}, (f32x4*)p); __builtin_nontemporal_store((f32x4){v[4], v[5], v[6], v[7]}, (f32x4*)(p + 4)); }
__device__ __forceinline__ void cv8(const u32x4 x, float (&v)[8]) { v[0] = bflo(x.x); v[1] = bfhi(x.x); v[2] = bflo(x.y); v[3] = bfhi(x.y); v[4] = bflo(x.z); v[5] = bfhi(x.z); v[6] = bflo(x.w); v[7] = bfhi(x.w); }
__device__ __forceinline__ u32x4 pk8f(const float* p) { const f32x4 a = *(const f32x4*)p, b = *(const f32x4*)(p + 4); u32x4 w; w.x = cvtpk(a[0], a[1]); w.y = cvtpk(a[2], a[3]); w.z = cvtpk(b[0], b[1]); w.w = cvtpk(b[2], b[3]); return w; }
__device__ __forceinline__ void p7_pre(LAS unsigned char* lds_, const Ptrs& P, int l, int pm_lo, int pm_hi, int s_wave) {
    const Frame F = make_frame(lds_, s_wave);
    const bf16_t* Z2 = (const bf16_t*)(P.ws + WS_RA); bf16_t* G = (bf16_t*)(P.ws + WS_RB); const float* HT = (const float*)(P.ws + WS_RA);
    const float* cw = P.cw + (size_t)l * 3 * NUP; const float* cb = P.cb + (size_t)l * NUP; const float* sc = P.sc + (size_t)l * SB * 2 * NUP;
    float* ocs = P.out + O_CVS + (size_t)l * SB * 2 * NUP;
    if (F.tid < 352) {
    const int c = F.tid * 8;
    float wa[3][8], wb[3][8], ba[8], bb[8];
#pragma unroll
    for (int j = 0; j < 3; ++j) { ld8f(cw + j * NUP + c, wa[j]); ld8f(cw + j * NUP + DFF + c, wb[j]); }
    ld8f(cb + c, ba); ld8f(cb + DFF + c, bb);
    for (int pm = pm_lo; pm < pm_hi; ++pm)
    for (int part = 0; part < 3; ++part) {
        if (part < 2) { const int U = 2 * pm + part;
            const int r0 = MP + U * 8;
            u32x4 ra[10], rb[10];
#pragma unroll
            for (int i = 2; i < 10; ++i) { ra[i] = *(const u32x4*)(Z2 + (size_t)(r0 + i - 2) * NUP + c); rb[i] = *(const u32x4*)(Z2 + (size_t)(r0 + i - 2) * NUP + DFF + c); }
            { const float* s0 = sc + (size_t)U * 2 * NUP; ra[0] = pk8f(s0 + c); ra[1] = pk8f(s0 + NUP + c); rb[0] = pk8f(s0 + DFF + c); rb[1] = pk8f(s0 + NUP + DFF + c); }
#pragma unroll
            for (int i = 2; i < 10; ++i) {
                float a2[8], a1[8], a0[8], b2[8], b1[8], b0[8], o[8];
                cv8(ra[i - 2], a2); cv8(ra[i - 1], a1); cv8(ra[i], a0); cv8(rb[i - 2], b2); cv8(rb[i - 1], b1); cv8(rb[i], b0);
#pragma unroll
                for (int e = 0; e < 8; ++e) { const float ca = ba[e] + wa[0][e] * a2[e] + wa[1][e] * a1[e] + wa[2][e] * a0[e], cbv = bb[e] + wb[0][e] * b2[e] + wb[1][e] * b1[e] + wb[2][e] * b0[e]; o[e] = gelu_t(ca) * cbv; }
                u32x4 w; w.x = cvtpk(o[0], o[1]); w.y = cvtpk(o[2], o[3]); w.z = cvtpk(o[4], o[5]); w.w = cvtpk(o[6], o[7]);
                *(u32x4*)(G + (size_t)(r0 + i - 2) * DFF + c) = w;
            }
            float* d = ocs + (size_t)U * 2 * NUP;
#pragma unroll
            for (int j = 0; j < 2; ++j) { float va[8], vb[8]; cv8(ra[8 + j], va); cv8(rb[8 + j], vb); st8f(d + j * NUP + c, va); st8f(d + j * NUP + DFF + c, vb); }
        } else if ((pm & 31) != 0) {
            float t0a[8], t1a[8], h0a[8], h1a[8], t0b[8], t1b[8], h0b[8], h1b[8];
            const float* tp = HT + ((size_t)(pm - 1) * 4 + 2) * NUP; const float* hp = HT + (size_t)pm * 4 * NUP;
            ld8f(tp + c, t0a); ld8f(tp + NUP + c, t1a); ld8f(hp + c, h0a); ld8f(hp + NUP + c, h1a);
            ld8f(tp + DFF + c, t0b); ld8f(tp + NUP + DFF + c, t1b); ld8f(hp + DFF + c, h0b); ld8f(hp + NUP + DFF + c, h1b);
            float o0[8], o1[8];
#pragma unroll
            for (int e = 0; e < 8; ++e) {
                const float ca0 = ba[e] + wa[0][e] * t0a[e] + wa[1][e] * t1a[e] + wa[2][e] * h0a[e], cb0 = bb[e] + wb[0][e] * t0b[e] + wb[1][e] * t1b[e] + wb[2][e] * h0b[e];
                const float ca1 = ba[e] + wa[0][e] * t1a[e] + wa[1][e] * h0a[e] + wa[2][e] * h1a[e], cb1 = bb[e] + wb[0][e] * t1b[e] + wb[1][e] * h0b[e] + wb[2][e] * h1b[e];
                o0[e] = gelu_t(ca0) * cb0; o1[e] = gelu_t(ca1) * cb1; }
            u32x4 w; w.x = cvtpk(o0[0], o0[1]); w.y = cvtpk(o0[2], o0[3]); w.z = cvtpk(o0[4], o0[5]); w.w = cvtpk(o0[6], o0[7]);
            *(u32x4*)(G + (size_t)(pm * 256) * DFF + c) = w;
            w.x = cvtpk(o1[0], o1[1]); w.y = cvtpk(o1[2], o1[3]); w.z = cvtpk(o1[4], o1[5]); w.w = cvtpk(o1[6], o1[7]);
            *(u32x4*)(G + (size_t)(pm * 256 + 1) * DFF + c) = w;
        }
    }
}
}

__device__ __forceinline__ void p_final(LAS unsigned char* lds_, const Ptrs& P, int s_wave) {
    const Frame F = make_frame(lds_, s_wave);
    float* Y = P.out + O_Y; const bf16_t* XB = (const bf16_t*)(P.ws + WS_XB); const float* xsq = (const float*)(P.ws + WS_XSQ);
    const int gw = F.vcu * 8 + F.wave, NGW = F.G * 8;
    float gn[2][8];
#pragma unroll
    for (int j = 0; j < 2; ++j) ld8f(P.nfin + 8 * F.lane + 512 * j, gn[j]);
    for (int m = gw; m < M; m += NGW) {
        float s = 0.f;
        { const f32x4 a = *(const f32x4*)(xsq + (size_t)m * 16 + 4 * (F.lane & 3)); s = (a[0] + a[1]) + (a[2] + a[3]); s = xadd<1>(s); s = xadd<2>(s); }
        const float rs = __builtin_amdgcn_rsqf(s * (1.0f / DM) + EPS);
#pragma unroll
        for (int j = 0; j < 2; ++j) { float v[8]; ld8(XB + (size_t)m * DM + 8 * F.lane + 512 * j, v);
#pragma unroll
            for (int e = 0; e < 8; ++e) v[e] = v[e] * rs * gn[j][e];
            st8f_nt(Y + (size_t)m * DM + 8 * F.lane + 512 * j, v); }
    }
}

struct SFrag { bf16x8 a[4], b[4]; };
__device__ __forceinline__ void small_ld(SFrag& f, const bf16_t* ap, const bf16_t* bp, size_t lda16, size_t ldb16) {
#pragma unroll
    for (int i = 0; i < 4; ++i) { f.a[i] = *(const bf16x8*)(ap + i * lda16); f.b[i] = *(const bf16x8*)(bp + i * ldb16); }
}
__device__ __forceinline__ void small_mma(f32x4 (&acc)[4][4], const SFrag& f) {
#pragma unroll
    for (int i = 0; i < 4; ++i)
#pragma unroll
        for (int j = 0; j < 4; ++j) acc[i][j] = __builtin_amdgcn_mfma_f32_16x16x32_bf16(f.a[i], f.b[j], acc[i][j], 0, 0, 0);
}
__device__ __forceinline__ void small_kslice(f32x4 (&acc)[4][4], const bf16_t* A, int lda, const bf16_t* Bt, int ldb, int k0, int nks, int lane) {
    const bf16_t* ap = A + (size_t)(lane & 15) * lda + k0 + 8 * (lane >> 4); const bf16_t* bp = Bt + (size_t)(lane & 15) * ldb + k0 + 8 * (lane >> 4);
    const size_t lda16 = (size_t)16 * lda, ldb16 = (size_t)16 * ldb;
    for (int s = 0; s < nks; s += 4) {
        SFrag f0, f1, f2, f3;
        small_ld(f0, ap + 32 * s, bp + 32 * s, lda16, ldb16);
        if (s + 1 < nks) small_ld(f1, ap + 32 * (s + 1), bp + 32 * (s + 1), lda16, ldb16);
        if (s + 2 < nks) small_ld(f2, ap + 32 * (s + 2), bp + 32 * (s + 2), lda16, ldb16);
        if (s + 3 < nks) small_ld(f3, ap + 32 * (s + 3), bp + 32 * (s + 3), lda16, ldb16);
        __builtin_amdgcn_sched_barrier(0);
        small_mma(acc, f0);
        if (s + 1 < nks) small_mma(acc, f1);
        if (s + 2 < nks) small_mma(acc, f2);
        if (s + 3 < nks) small_mma(acc, f3);
    }
}
__device__ __forceinline__ void small_zero(f32x4 (&acc)[4][4]) { float z = 0.f; asm volatile("" : "+v"(z));
#pragma unroll
    for (int i = 0; i < 4; ++i)
#pragma unroll
        for (int j = 0; j < 4; ++j) acc[i][j] = (f32x4){z, z, z, z}; }
__device__ __forceinline__ void small_reduce(LAS unsigned char* ring, const f32x4 (&acc)[4][4], const Frame& F, float (&out)[8]) {
    LAS float* slab = (LAS float*)(ring + F.wave * 16384);
    const int rq = 4 * (F.lane >> 4), cl = F.lane & 15;
#pragma unroll
    for (int i = 0; i < 4; ++i)
#pragma unroll
        for (int j = 0; j < 4; ++j)
#pragma unroll
            for (int r = 0; r < 4; ++r) slab[(16 * i + rq + r) * 64 + 16 * j + cl] = acc[i][j][r];
    LDS_WAIT(); __syncthreads();
    const int row = F.tid >> 3, c8 = (F.tid & 7) * 8;
#pragma unroll
    for (int e = 0; e < 8; ++e) out[e] = 0.f;
#pragma unroll
    for (int w = 0; w < 8; ++w) { const f32x4 x = *(LAS const f32x4*)(ring + w * 16384 + (row * 64 + c8) * 4), y = *(LAS const f32x4*)(ring + w * 16384 + (row * 64 + c8) * 4 + 16);
        out[0] += x[0]; out[1] += x[1]; out[2] += x[2]; out[3] += x[3]; out[4] += y[0]; out[5] += y[1]; out[6] += y[2]; out[7] += y[3]; }
    LDS_WAIT(); __syncthreads();
}
__device__ __forceinline__ void small_resid(LAS unsigned char* lds_, const bf16_t* A, int K, const bf16_t* Bt, bf16_t* XB, float* xsq, int s_wave) {
    const Frame F = make_frame(lds_, s_wave);
    for (int t = F.vcu; t < 256; t += F.G) {
        const int rb = 4 * (t >> 6) + ((t >> 3) & 3), cb = 8 * ((t >> 5) & 1) + (t & 7);
        f32x4 acc[4][4]; small_zero(acc);
        small_kslice(acc, A + (size_t)(MP + 64 * rb) * K, K, Bt + (size_t)(64 * cb) * K, K, F.wave * (K / 8), K / 256, F.lane);
        float o[8]; small_reduce(lds_ + RING_OFF, acc, F, o);
        const int row = MP + 64 * rb + (F.tid >> 3), c8 = 64 * cb + (F.tid & 7) * 8;
        float xo[8]; ld8(XB + (size_t)row * DM + c8, xo);
        u32x4 w; float ss = 0.f;
        { const unsigned r0 = cvtpk(xo[0] + o[0], xo[1] + o[1]), r1 = cvtpk(xo[2] + o[2], xo[3] + o[3]), r2 = cvtpk(xo[4] + o[4], xo[5] + o[5]), r3 = cvtpk(xo[6] + o[6], xo[7] + o[7]);
          w.x = r0; w.y = r1; w.z = r2; w.w = r3;
          ss = (bflo(r0) * bflo(r0) + bfhi(r0) * bfhi(r0)) + (bflo(r1) * bflo(r1) + bfhi(r1) * bfhi(r1)) + (bflo(r2) * bflo(r2) + bfhi(r2) * bfhi(r2)) + (bflo(r3) * bflo(r3) + bfhi(r3) * bfhi(r3)); }
        *(u32x4*)(XB + (size_t)row * DM + c8) = w;
        ss = xadd<1>(ss); ss = xadd<2>(ss); ss = xadd<4>(ss);
        if ((F.tid & 7) == 0) xsq[(size_t)row * 16 + cb] = ss;
    }
}
__device__ __forceinline__ void small_merge(LAS unsigned char* lds_, const bf16_t* OS, const bf16_t* WMl, const bf16_t* Z, bf16_t* MG, int s_wave) {
    const Frame F = make_frame(lds_, s_wave);
    for (int t = F.vcu; t < 256; t += F.G) {
        const int rb = 4 * (t >> 6) + ((t >> 3) & 3), cb = 8 * ((t >> 5) & 1) + (t & 7);
        const bf16_t* A = OS + (size_t)(MP + 64 * rb) * KM; const bf16_t* Bt = WMl + (size_t)(64 * cb) * KM;
        float o[8], s[8];
        { f32x4 acc[4][4]; small_zero(acc); small_kslice(acc, A, KM, Bt, KM, F.wave * 128, 4, F.lane); small_reduce(lds_ + RING_OFF, acc, F, o); }
        { f32x4 acc[4][4]; small_zero(acc); small_kslice(acc, A, KM, Bt, KM, 1024 + F.wave * 96, 3, F.lane); small_reduce(lds_ + RING_OFF, acc, F, s); }
        const int row = MP + 64 * rb + (F.tid >> 3), c8 = 64 * cb + (F.tid & 7) * 8;
        float ga[8], gb[8]; { const int gc = C_GA + 256 * (c8 >> 7) + (c8 & 127); ld8(Z + (size_t)row * NIN + gc, ga); ld8(Z + (size_t)row * NIN + gc + 128, gb); }
        u32x4 w; w.x = cvtpk(gb[0] * (ga[0] * o[0] + s[0]), gb[1] * (ga[1] * o[1] + s[1])); w.y = cvtpk(gb[2] * (ga[2] * o[2] + s[2]), gb[3] * (ga[3] * o[3] + s[3]));
        w.z = cvtpk(gb[4] * (ga[4] * o[4] + s[4]), gb[5] * (ga[5] * o[5] + s[5])); w.w = cvtpk(gb[6] * (ga[6] * o[6] + s[6]), gb[7] * (ga[7] * o[7] + s[7]));
        *(u32x4*)(MG + (size_t)row * DM + c8) = w;
    }
}

struct Args { const float* in[21]; float* out; unsigned char* ws; int ph_lo, ph_hi; };
static_assert(offsetof(Args, out) == 21 * 8 && offsetof(Args, ws) == 22 * 8, "Args layout");
__global__ void __launch_bounds__(512, 2) mk_fwd(Args args) {
    extern __shared__ __attribute__((aligned(16))) unsigned char lds_raw[];
    LAS unsigned char* const lds = (LAS unsigned char*)lds_raw; const int G = gridDim.x;
    volatile LAS unsigned* MISC = (volatile LAS unsigned*)(lds + MISC_OFF);
    const int s_wave = __builtin_amdgcn_readfirstlane((int)threadIdx.x >> 6);
    for (int u = tid_from_wave(s_wave); u < (LDS_BYTES - LDSCTL_OFF) / 4; u += 512) ((LAS unsigned*)(lds + LDSCTL_OFF))[u] = 0u;
    __syncthreads();
    const int lo = args.ph_lo, hi = args.ph_hi;
    XcdBarrier bar; bar.bar = (unsigned*)(args.ws + WS_CTL) + 4096; bar.x = 0; bar.st = nullptr;
    if (hi - lo > 1) bar = xcd_barrier_post((unsigned*)(args.ws + WS_CTL) + 4096, MISC + 8, tid_from_wave(s_wave) == 0);
    LAS unsigned char* ring = lds + RING_OFF; LAS unsigned char* red = lds + RED_OFF;
    for (int ph = lo; ph < hi; ++ph) {
        int z_ = 0; asm volatile("" : "+s"(z_));
        Ptrs P; P.xp = args.in[0 + z_]; P.xs = args.in[1 + z_]; P.ck = args.in[2 + z_]; P.cv = args.in[3 + z_]; P.sc = args.in[4 + z_]; P.nmix = args.in[5 + z_]; P.w_in = args.in[6 + z_]; P.sinks = args.in[7 + z_];
        P.lng = args.in[8 + z_]; P.lnb = args.in[9 + z_]; P.gws = args.in[10 + z_]; P.gbs = args.in[11 + z_]; P.wpa = args.in[12 + z_]; P.wpb = args.in[13 + z_]; P.wout = args.in[14 + z_]; P.nffn = args.in[15 + z_];
        P.wup = args.in[16 + z_]; P.cw = args.in[17 + z_]; P.cb = args.in[18 + z_]; P.wdn = args.in[19 + z_]; P.nfin = args.in[20 + z_]; P.out = (float*)args.in[21 + z_]; P.ws = (unsigned char*)args.in[22 + z_];
        bf16_t* XB = (bf16_t*)(P.ws + WS_XB); float* xsq = (float*)(P.ws + WS_XSQ);
#if defined(MK_REP_K)
      const int nrep_ = ((ph == 0 && MK_REP_K == 100) || (ph > 0 && ph < NPH - 1 && (ph - 1) % 6 == MK_REP_K)) ? MK_REP_N : 1;
      for (int rep_ = 0; rep_ < nrep_; ++rep_) {
        if (rep_ > 0) xcd_barrier(bar, tid_from_wave(s_wave) == 0);
#endif
#if defined(MK_REP_K)
        bf16_t* XBo = rep_ > 0 ? (bf16_t*)(P.ws + ((size_t)460 << 20)) : XB; float* xsqo = rep_ > 0 ? (float*)(P.ws + ((size_t)500 << 20)) : xsq;
#else
        bf16_t* XBo = XB; float* xsqo = xsq;
#endif
        if (ph == 0) p0_prologue(lds, P, s_wave);
        else if (ph == NPH - 1) p_final(lds, P, s_wave);
        else {
            const int l = (ph - 1) / 6, k = (ph - 1) % 6;
            if (k == 0) { const int NGm = G - NWORKERS;
                if ((int)blockIdx.x < NGm) { pg8::Gemm g{XB, (const bf16_t*)(P.ws + WS_WIN) + (size_t)l * NIN * DM, M, NIN, DM}; pg8::StaticOrder S; S.init(M, NIN, NGm, (int)blockIdx.x);
                    pg8::EpiAct E{(bf16_t*)(P.ws + WS_RA), NIN, xsq, (float*)(P.ws + WS_GVST), 1}; pg8::gemm_phase(ring, red, g, S, E, s_wave); }
#if defined(MK_REP_K) && defined(MK_WORK_ONCE)
                else if (rep_ == 0) p1_workers(lds, P, l, (int)blockIdx.x - NGm, NWORKERS, s_wave); }
#else
                else p1_workers(lds, P, l, (int)blockIdx.x - NGm, NWORKERS, s_wave); }
#endif
            else if (k == 1) p2_mixer(lds, P, l, s_wave);
            else if (k == 2) { pg8::Gemm g{(const bf16_t*)(P.ws + WS_RB), (const bf16_t*)(P.ws + WS_WM) + (size_t)l * DM * KM, MP, DM, KM}; pg8::StaticOrder S; S.init(MP, DM, G, (int)blockIdx.x);
                pg8::EpiMerge E{(const bf16_t*)(P.ws + WS_RA), (bf16_t*)(P.ws + WS_MG)};
                if (G == 256) { pg8::Unit u; S.next(0, u); pg8::gemm_phase_x(ring, red, g, u, E, s_wave); }
                else { pg8::gemm_phase(ring, red, g, S, E, s_wave);
                    small_merge(lds, (const bf16_t*)(P.ws + WS_RB), (const bf16_t*)(P.ws + WS_WM) + (size_t)l * DM * KM, (const bf16_t*)(P.ws + WS_RA), (bf16_t*)(P.ws + WS_MG), s_wave); } }
            else if (k == 3) { pg8::Gemm g{(const bf16_t*)(P.ws + WS_MG), (const bf16_t*)(P.ws + WS_WOUT) + (size_t)l * DM * DM, MP, DM, DM}; pg8::StaticOrder S; S.init(MP, DM, G, (int)blockIdx.x);
                pg8::EpiResid E{XBo, xsqo};
                if (G == 256) { pg8::Unit u; S.next(0, u); pg8::gemm_phase_x(ring, red, g, u, E, s_wave); }
                else { pg8::gemm_phase(ring, red, g, S, E, s_wave); small_resid(lds, (const bf16_t*)(P.ws + WS_MG), DM, (const bf16_t*)(P.ws + WS_WOUT) + (size_t)l * DM * DM, XBo, xsqo, s_wave); } }
            else if (k == 4) { pg8::Gemm g{XB, (const bf16_t*)(P.ws + WS_WUP) + (size_t)l * NUP * DM, M, NUP, DM}; pg8::StaticOrder S; S.init(M, NUP, G, (int)blockIdx.x);
                pg8::EpiUp E{P.ws, P.cw + (size_t)l * 3 * NUP, P.cb + (size_t)l * NUP, P.out + O_CVP + (size_t)l * NB * 2 * NUP};
                pg8::gemm_phase(ring, red, g, S, E, s_wave); }
            else { if (G == 256) { pg8::StaticOrder S0; S0.init(MP, DM, G, (int)blockIdx.x); pg8::Unit u0; S0.next(0, u0); p7_pre(lds, P, l, u0.pm, u0.pm + 1, s_wave); } else p7_pre(lds, P, l, 0, MP / 256, s_wave);
                VM_WAIT(); __syncthreads();
                pg8::Gemm g{(const bf16_t*)(P.ws + WS_RB), (const bf16_t*)(P.ws + WS_WDN) + (size_t)l * DM * DFF, MP, DM, DFF}; pg8::StaticOrder S; S.init(MP, DM, G, (int)blockIdx.x);
                pg8::EpiResid E{XBo, xsqo};
                if (G == 256) { pg8::Unit u; S.next(0, u); pg8::gemm_phase_x(ring, red, g, u, E, s_wave); }
                else { pg8::gemm_phase(ring, red, g, S, E, s_wave); small_resid(lds, (const bf16_t*)(P.ws + WS_RB), DFF, (const bf16_t*)(P.ws + WS_WDN) + (size_t)l * DM * DFF, XBo, xsqo, s_wave); } }
        }
#if defined(MK_REP_K)
      }
#endif
        if (ph + 1 < hi) xcd_barrier(bar, tid_from_wave(s_wave) == 0);
#if defined(MK_BAR_TWICE)
        for (int bb_ = 1; bb_ < MK_BAR_TWICE; ++bb_) if (ph + 1 < hi) xcd_barrier(bar, tid_from_wave(s_wave) == 0);
#endif
    }
}

extern "C" void kernel_launch(void* const* d_in, const int* in_sizes, int n_in, void* d_out, int out_size, void* d_ws, size_t ws_size, hipStream_t stream) {
    static int grid = 0;
    if (grid == 0) {
        if (n_in != 21 || out_size != (int)O_END || ws_size < WS_END) { fprintf(stderr, "kernel_launch: unexpected shapes: n_in %d out %d ws %zu (need %zu)\n", n_in, out_size, ws_size, (size_t)WS_END); grid = -1; return; }
        int dev = 0, cus = 0, per_cu = 0;
        if (hipGetDevice(&dev) != hipSuccess || hipDeviceGetAttribute(&cus, hipDeviceAttributeMultiprocessorCount, dev) != hipSuccess) { grid = -1; return; }
        if (hipFuncSetAttribute((const void*)mk_fwd, hipFuncAttributeMaxDynamicSharedMemorySize, LDS_BYTES) != hipSuccess) { fprintf(stderr, "kernel_launch: hipFuncSetAttribute failed\n"); grid = -1; return; }
        if (hipOccupancyMaxActiveBlocksPerMultiprocessor(&per_cu, (const void*)mk_fwd, 512, LDS_BYTES) != hipSuccess || per_cu < 1) { fprintf(stderr, "kernel_launch: occupancy query says %d blocks/CU\n", per_cu); per_cu = 1; }
        (void)hipGetLastError();
        grid = cus;
    }
    if (grid < 0) return;
    (void)hipMemsetAsync((char*)d_ws + WS_CTL, 0, CTL_ZERO_BYTES, stream);
    Args a{};
    for (int i = 0; i < 21; ++i) a.in[i] = (const float*)d_in[i];
    a.out = (float*)d_out; a.ws = (unsigned char*)d_ws;
#if MK_ONE_LAUNCH
    a.ph_lo = 0; a.ph_hi = NPH;
    void* kargs[] = {&a};
    hipError_t e = hipLaunchCooperativeKernel((const void*)mk_fwd, dim3(grid), dim3(512), kargs, LDS_BYTES, stream);
    if (e != hipSuccess) fprintf(stderr, "kernel_launch: cooperative launch failed: %s\n", hipGetErrorString(e));
#else
    for (int ph = 0; ph < NPH; ++ph) { a.ph_lo = ph; a.ph_hi = ph + 1; hipLaunchKernelGGL(mk_fwd, dim3(grid), dim3(512), LDS_BYTES, stream, a); }
#endif
}
```

```cpp
#include <hip/hip_runtime.h>
#include <cstdio>
#include <cstdint>
#include <cstddef>

#ifndef MK_ONE_LAUNCH
#define MK_ONE_LAUNCH 1
#endif

#define LAS __attribute__((address_space(3)))
#define GAS __attribute__((address_space(1)))
typedef unsigned short bf16_t;
typedef short bf16x8 __attribute__((ext_vector_type(8)));
typedef short s16x4 __attribute__((ext_vector_type(4)));
typedef float f32x2 __attribute__((ext_vector_type(2)));
typedef float f32x4 __attribute__((ext_vector_type(4)));
typedef float f32x16 __attribute__((ext_vector_type(16)));
typedef unsigned u32x2 __attribute__((ext_vector_type(2)));
typedef unsigned u32x4 __attribute__((ext_vector_type(4)));
typedef __bf16 bf16x2_t __attribute__((ext_vector_type(2)));

constexpr int DM = 1024, NB = 2, SEQ = 8192, DEPTH = 4, SB = 128, ST = 8, WIN = 128;
constexpr int MP = NB * SEQ, MS = SB * ST, M = MP + MS;
constexpr int NIN = 5120, C_Q = 0, C_K = 1024, C_V = 1280, C_GU = 1536, C_GV = 2304, C_GA = 3072, C_GB = 4096;
constexpr int KM = 1792, NUP = 5632, DFF = 2816, GW = 768;
constexpr float EPS = 1e-5f, LOG2E = 1.4426950408889634f, C2 = 0.125f * 1.4426950408889634f, NEGBIG = -1e30f;
#ifndef MK_NWORKERS
#define MK_NWORKERS 24
#endif
constexpr int NPH = 26, NWORKERS = MK_NWORKERS;

constexpr size_t O_Y = 0, O_WKP = 17825792, O_WVP = 18087936, O_CVP = 18350080, O_WKS = 18440192, O_WVS = 35217408, O_CVS = 51994624, O_GVS = 57761792, O_END = 60907520;

constexpr size_t MiB = 1u << 20;
constexpr size_t WS_CTL = 0, CTL_ZERO_BYTES = 64 * 1024, WS_XSQ = 1 * MiB  , WS_GVST = 2 * MiB + 512 * 1024, WS_WSB = 5 * MiB, WS_WIN = 8 * MiB, WS_WM = 48 * MiB, WS_WOUT = 62 * MiB,
                 WS_WUP = 70 * MiB, WS_WDN = 114 * MiB, WS_XB = 136 * MiB, WS_RA = 170 * MiB, WS_RB = 357 * MiB, WS_MG = WS_RB + 60 * MiB, WS_END = 451 * MiB;
static_assert((size_t)M * NUP * 2 <= WS_RB - WS_RA && (size_t)M * DFF * 2 <= WS_END - WS_RB && (size_t)M * KM * 2 <= 60 * MiB && WS_MG + (size_t)M * DM * 2 <= WS_END, "ws map");

constexpr int RING_OFF = 0, RING_BYTES = 131072, RED_OFF = RING_BYTES, RED_BYTES = 20480, LDSCTL_OFF = RED_OFF + RED_BYTES, MISC_OFF = LDSCTL_OFF + 320, LDS_BYTES = 155648;

__device__ __forceinline__ unsigned cvtpk(float lo, float hi) { f32x2 v = {lo, hi}; bf16x2_t b = __builtin_convertvector(v, bf16x2_t); return __builtin_bit_cast(unsigned, b); }
__device__ __forceinline__ float bflo(unsigned u) { return __uint_as_float(u << 16); }
__device__ __forceinline__ float bfhi(unsigned u) { return __uint_as_float(u & 0xffff0000u); }
__device__ __forceinline__ float gelu_t(float x) { const float t = x * (-2.302208198f + -0.1029432398f * x * x); return x * __builtin_amdgcn_rcpf(1.0f + __builtin_amdgcn_exp2f(t)); }
__device__ __forceinline__ float sigm(float x) { return __builtin_amdgcn_rcpf(1.0f + __builtin_amdgcn_exp2f(-LOG2E * x)); }
__device__ __forceinline__ int crow(int r, int hi) { return (r & 3) + 8 * (r >> 2) + 4 * hi; }
template <int MASK> __device__ __forceinline__ float xadd(float v) {
    if constexpr (MASK == 32) { auto rr = __builtin_amdgcn_permlane32_swap(__float_as_uint(v), __float_as_uint(v), false, false); return __uint_as_float(rr[0]) + __uint_as_float(rr[1]); }
    else return v + __int_as_float(__builtin_amdgcn_ds_swizzle(__float_as_int(v), (MASK << 10) | 0x1f));
}
__device__ __forceinline__ int tid_from_wave(int s_wave) { int lane; asm volatile("v_mbcnt_lo_u32_b32 %0, -1, 0\n\tv_mbcnt_hi_u32_b32 %0, -1, %0" : "=v"(lane)); return s_wave * 64 + lane; }

#ifndef MK_WGM
#define MK_WGM 4
#endif
namespace pg8 {
#define PG8_LAS __attribute__((address_space(3)))
constexpr int BM = 256, BK = 64, HALF = 128, HTB = HALF * BK * 2  , STAGE_BYTES = 8 * HTB, NXCD = 8, WGM = MK_WGM;
__host__ __device__ __forceinline__ int lds_byte(int r, int c) { const int st = (r >> 4) * 2 + (c >> 5), rr = r & 15, cc = c & 31, ob = rr * 64 + cc * 2; return st * 1024 + (ob ^ (((ob >> 9) & 1) << 5)); }
__host__ __device__ __forceinline__ void stage_rc(int b, int& R, int& C) { const int st = b / 1024, sb = b % 1024, swz = sb ^ (((sb >> 9) & 1) << 5); R = (st >> 1) * 16 + swz / 64; C = (st & 1) * 32 + (swz % 64) / 2; }
__host__ __device__ __forceinline__ int perm32(int rho) { const int n = rho >> 4, i = rho & 15; return 8 * (i >> 2) + 4 * n + (i & 3); }

struct Unit { int pm, pn; };
struct Gemm { const bf16_t* A; const bf16_t* Bt; int M, N, K; };
struct StaticOrder {
    int nM, nN, nwg, G, c;
    __host__ __device__ void init(int M_, int N_, int G_, int c_) { nM = M_ / BM; nN = N_ / BM; nwg = nM * nN; G = G_; c = c_; }
    __host__ __device__ bool next(int i, Unit& u) const {
        const long L = (long)i * G + c; if (L >= nwg) return false;
        int wgid = (int)L; { const int q = nwg / NXCD, r = nwg % NXCD, xcd = wgid % NXCD, off = wgid / NXCD; wgid = (xcd < r ? xcd * (q + 1) : r * (q + 1) + (xcd - r) * q) + off; }
        const int nig = WGM * nN, gid = wgid / nig, fm = gid * WGM, gsz = (nM - fm) < WGM ? (nM - fm) : WGM;
        u.pm = fm + ((wgid % nig) % gsz); u.pn = (wgid % nig) / gsz; return true;
    }
};


struct RsPf { f32x4 a, b; };
__device__ __forceinline__ void rs_issue(RsPf& p, const float* xsq, int pm, int tid) { const float* q = xsq + (size_t)(pm * BM + (tid >> 1)) * 16 + 8 * (tid & 1); p.a = *(const f32x4*)q; p.b = *(const f32x4*)(q + 4); }
__device__ __forceinline__ void rs_write(const RsPf& p, PG8_LAS float* R, int tid) {
    float s = ((p.a[0] + p.a[1]) + (p.a[2] + p.a[3])) + ((p.b[0] + p.b[1]) + (p.b[2] + p.b[3])); s = xadd<1>(s);
    if ((tid & 1) == 0) R[tid >> 1] = __builtin_amdgcn_rsqf(s * (1.0f / DM) + EPS);
}
struct EpiAct {
    static constexpr bool PERM = true, IDEMP = true; static constexpr int MID_T = -1;
    bf16_t* O; int ldc; const float* xsq; float* gvst; int mode;
    __device__ __forceinline__ void mid(f32x4 (&)[2][2][4][2], const Unit&, int, int, int, int) const {}
    template <int KIND> __device__ __forceinline__ void body(const f32x4 (&acc)[2][2][4][2], const Unit& u, int wr, int wc, int fr, int fq, const PG8_LAS float* R) const {
        const int row0 = u.pm * BM + wr * 64 + fr, col0 = u.pn * BM + wc * 32 + 8 * fq;
#pragma unroll
        for (int ai = 0; ai < 2; ++ai)
#pragma unroll
            for (int m = 0; m < 4; ++m) {
                const int row = row0 + ai * HALF + m * 16;
                float rs = R[ai * HALF + wr * 64 + m * 16 + fr];
                if (KIND == 0) rs *= C2;
                float s1 = 0.f, s2 = 0.f;
                bf16_t* rowp = O + (size_t)row * ldc + col0;
                float v[2][8];
#pragma unroll
                for (int bj = 0; bj < 2; ++bj)
#pragma unroll
                    for (int e = 0; e < 8; ++e) { float x = acc[ai][bj][m][e >> 2][e & 3] * rs;
                        if (KIND == 2 || KIND == 3) x = gelu_t(x);
                        if (KIND == 4) x = fminf(1.0f + __builtin_amdgcn_exp2f(-LOG2E * x), 1e30f);
                        v[bj][e] = x; }
                if (KIND == 4) {
#pragma unroll
                    for (int e = 0; e < 8; ++e) { const float ta = v[0][e], tb = v[1][e]; v[0][e] = tb * __builtin_amdgcn_rcpf(ta); v[1][e] = __builtin_amdgcn_rcpf(tb); } }
#pragma unroll
                for (int bj = 0; bj < 2; ++bj) {
                    u32x4 w; w.x = cvtpk(v[bj][0], v[bj][1]); w.y = cvtpk(v[bj][2], v[bj][3]); w.z = cvtpk(v[bj][4], v[bj][5]); w.w = cvtpk(v[bj][6], v[bj][7]);
                    if (KIND == 3) {
#pragma unroll
                        for (int e = 0; e < 4; ++e) { const unsigned q = e == 0 ? w.x : e == 1 ? w.y : e == 2 ? w.z : w.w; const float a = bflo(q), b = bfhi(q); s1 += a + b; s2 += a * a + b * b; } }
                    *(u32x4*)(rowp + bj * HALF) = w;
                }
                if (KIND == 3) {
                    s1 = xadd<16>(s1); s1 = xadd<32>(s1); s2 = xadd<16>(s2); s2 = xadd<32>(s2);
                    if (fq == 0) *(f32x2*)(gvst + (size_t)row * 24 + ((u.pn - 9) * 4 + wc) * 2) = (f32x2){s1, s2};
                }
            }
    }
    static constexpr bool USES_R = true;
    __device__ __forceinline__ void prep(const Unit& u, PG8_LAS unsigned char* red, int tid) const { RsPf p; rs_issue(p, xsq, u.pm, tid); rs_write(p, (PG8_LAS float*)red, tid); }
    __device__ __forceinline__ void run(f32x4 (&acc)[2][2][4][2], const Unit& u, int wr, int wc, int fr, int fq, PG8_LAS unsigned char* red, int tid, const Unit* nxt, int par) const {
        asm volatile("" : "+v"(fr), "+v"(fq), "+v"(tid));
        const PG8_LAS float* R = (const PG8_LAS float*)red + par * 256;
        RsPf pf; rs_issue(pf, xsq, nxt ? nxt->pm : u.pm, tid);
        run2(acc, u, wr, wc, fr, fq, R);
        rs_write(pf, (PG8_LAS float*)red + (par ^ 1) * 256, tid);
    }
    __device__ __forceinline__ void run2(f32x4 (&acc)[2][2][4][2], const Unit& u, int wr, int wc, int fr, int fq, const PG8_LAS float* R) const {
        if (mode == 0) { body<1>(acc, u, wr, wc, fr, fq, R); return; }
        const int pn = u.pn;
        if (pn < 4) body<0>(acc, u, wr, wc, fr, fq, R);
        else if (pn < 6) body<1>(acc, u, wr, wc, fr, fq, R);
        else if (pn < 9) body<2>(acc, u, wr, wc, fr, fq, R);
        else if (pn < 12) body<3>(acc, u, wr, wc, fr, fq, R);
        else body<4>(acc, u, wr, wc, fr, fq, R);
    }
};

#ifndef MK_WT_SINGLE
#define MK_WT_SINGLE 0
#endif
__device__ __forceinline__ void st16wt(void* p, u32x4 v) {
#if MK_WT_SINGLE
    asm volatile("global_store_dwordx4 %0, %1, off sc1\n\ts_nop 1" :: "v"(p), "v"(v) : "memory");
#else
    *(u32x4*)p = v;
#endif
}
struct EpiMerge {
    static constexpr bool PERM = true, IDEMP = false; static constexpr int MID_T = 16;
    const bf16_t* Z; bf16_t* O;
    template <int WHICH> __device__ __forceinline__ void scale(f32x4 (&acc)[2][2][4][2], const Unit& u, int wr, int wc, int fr, int fq) const {
        asm volatile("" : "+v"(fr), "+v"(fq));
        const int row0 = u.pm * BM + wr * 64 + fr, gc0 = C_GA + 512 * u.pn + WHICH * 128 + wc * 32 + 8 * fq;
        u32x4 gt[2][4][2];
#pragma unroll
        for (int ai = 0; ai < 2; ++ai)
#pragma unroll
            for (int m = 0; m < 4; ++m) { const bf16_t* zr = Z + (size_t)(row0 + ai * HALF + m * 16) * NIN + gc0;
#pragma unroll
                for (int bj = 0; bj < 2; ++bj) gt[ai][m][bj] = *(const u32x4*)(zr + bj * 256); }
        __builtin_amdgcn_sched_barrier(0);
#pragma unroll
        for (int ai = 0; ai < 2; ++ai)
#pragma unroll
            for (int m = 0; m < 4; ++m)
#pragma unroll
                for (int bj = 0; bj < 2; ++bj) { const u32x4 a = gt[ai][m][bj];
#pragma unroll
                    for (int e = 0; e < 4; ++e) { const unsigned qa = e == 0 ? a.x : e == 1 ? a.y : e == 2 ? a.z : a.w;
                        acc[ai][bj][m][e >> 1][(e & 1) * 2] *= bflo(qa); acc[ai][bj][m][e >> 1][(e & 1) * 2 + 1] *= bfhi(qa); } }
    }
    __device__ __forceinline__ void mid(f32x4 (&acc)[2][2][4][2], const Unit& u, int wr, int wc, int fr, int fq) const { scale<0>(acc, u, wr, wc, fr, fq); }
    template <int WHICH> __device__ __forceinline__ void scalex(f32x4 (&accx)[2], const Unit& u, int wr, int wc, int fr, int fq) const {
        asm volatile("" : "+v"(fr), "+v"(fq));
        const u32x4 a = *(const u32x4*)(Z + (size_t)(MP + 16 * u.pm + fr) * NIN + C_GA + 512 * u.pn + 256 * wr + WHICH * 128 + wc * 32 + 8 * fq);
#pragma unroll
        for (int e = 0; e < 4; ++e) { const unsigned qa = e == 0 ? a.x : e == 1 ? a.y : e == 2 ? a.z : a.w; accx[e >> 1][(e & 1) * 2] *= bflo(qa); accx[e >> 1][(e & 1) * 2 + 1] *= bfhi(qa); }
    }
    __device__ __forceinline__ void midx(f32x4 (&accx)[2], const Unit& u, int wr, int wc, int fr, int fq) const { scalex<0>(accx, u, wr, wc, fr, fq); }
    __device__ __forceinline__ void runx(f32x4 (&accx)[2], const Unit& u, int wr, int wc, int fr, int fq, PG8_LAS unsigned char*, int) const {
        scalex<1>(accx, u, wr, wc, fr, fq);
        asm volatile("" : "+v"(fr), "+v"(fq));
        u32x4 w; w.x = cvtpk(accx[0][0], accx[0][1]); w.y = cvtpk(accx[0][2], accx[0][3]); w.z = cvtpk(accx[1][0], accx[1][1]); w.w = cvtpk(accx[1][2], accx[1][3]);
        st16wt(O + (size_t)(MP + 16 * u.pm + fr) * DM + u.pn * BM + 128 * wr + wc * 32 + 8 * fq, w);
    }
    static constexpr bool USES_R = false;
    __device__ __forceinline__ void prep(const Unit&, PG8_LAS unsigned char*, int) const {}
    __device__ __forceinline__ void run(f32x4 (&acc)[2][2][4][2], const Unit& u, int wr, int wc, int fr, int fq, PG8_LAS unsigned char*, int, const Unit*, int) const {
        scale<1>(acc, u, wr, wc, fr, fq);
        asm volatile("" : "+v"(fr), "+v"(fq));
        const int row0 = u.pm * BM + wr * 64 + fr, col0 = u.pn * BM + wc * 32 + 8 * fq;
#pragma unroll
        for (int ai = 0; ai < 2; ++ai)
#pragma unroll
            for (int m = 0; m < 4; ++m) {
                const int row = row0 + ai * HALF + m * 16;
#pragma unroll
                for (int bj = 0; bj < 2; ++bj) {
                    u32x4 w; w.x = cvtpk(acc[ai][bj][m][0][0], acc[ai][bj][m][0][1]); w.y = cvtpk(acc[ai][bj][m][0][2], acc[ai][bj][m][0][3]);
                    w.z = cvtpk(acc[ai][bj][m][1][0], acc[ai][bj][m][1][1]); w.w = cvtpk(acc[ai][bj][m][1][2], acc[ai][bj][m][1][3]);
                    st16wt(O + (size_t)row * DM + col0 + bj * HALF, w);
                }
            }
    }
};

struct EpiResid {
    static constexpr bool PERM = true, IDEMP = false; static constexpr int MID_T = -1;
    bf16_t* XB; float* xsq;
    __device__ __forceinline__ void mid(f32x4 (&)[2][2][4][2], const Unit&, int, int, int, int) const {}
    __device__ __forceinline__ void midx(f32x4 (&)[2], const Unit&, int, int, int, int) const {}
    __device__ __forceinline__ void runx(f32x4 (&accx)[2], const Unit& u, int wr, int wc, int fr, int fq, PG8_LAS unsigned char* red, int tid) const {
        asm volatile("" : "+v"(fr), "+v"(fq), "+v"(tid));
        const int row = MP + 16 * u.pm + fr; bf16_t* xr = XB + (size_t)row * DM + u.pn * BM + 128 * wr + wc * 32 + 8 * fq;
        const u32x4 o = *(const u32x4*)xr; u32x4 w; float ss = 0.f;
#pragma unroll
        for (int e = 0; e < 4; ++e) { const unsigned q = e == 0 ? o.x : e == 1 ? o.y : e == 2 ? o.z : o.w;
            const unsigned r = cvtpk(bflo(q) + accx[e >> 1][(e & 1) * 2], bfhi(q) + accx[e >> 1][(e & 1) * 2 + 1]);
            const float a = bflo(r), b = bfhi(r); ss += a * a + b * b;
            if (e == 0) w.x = r; else if (e == 1) w.y = r; else if (e == 2) w.z = r; else w.w = r; }
        st16wt(xr, w);
        ss = xadd<16>(ss); ss = xadd<32>(ss);
        PG8_LAS float* RX = (PG8_LAS float*)(red + 4096);
        if (fq == 0) RX[(wr * 4 + wc) * 16 + fr] = ss;
        asm volatile("s_waitcnt lgkmcnt(0)" ::: "memory"); __builtin_amdgcn_s_barrier(); asm volatile("" ::: "memory");
        if (tid < 16) { float s = 0.f;
#pragma unroll
            for (int w8 = 0; w8 < 8; ++w8) s += RX[w8 * 16 + tid];
            xsq[(size_t)(MP + 16 * u.pm + tid) * 16 + u.pn] = s; }
    }
    static constexpr bool USES_R = false;
    __device__ __forceinline__ void prep(const Unit&, PG8_LAS unsigned char*, int) const {}
    __device__ __forceinline__ void run(f32x4 (&acc)[2][2][4][2], const Unit& u, int wr, int wc, int fr, int fq, PG8_LAS unsigned char*, int, const Unit*, int) const {
        asm volatile("" : "+v"(fr), "+v"(fq));
        const int row0 = u.pm * BM + wr * 64 + fr, col0 = u.pn * BM + wc * 32 + 8 * fq;
        u32x4 xo[2][4][2];
#pragma unroll
        for (int ai = 0; ai < 2; ++ai)
#pragma unroll
            for (int m = 0; m < 4; ++m)
#pragma unroll
                for (int bj = 0; bj < 2; ++bj) xo[ai][m][bj] = *(const u32x4*)(XB + (size_t)(row0 + ai * HALF + m * 16) * DM + col0 + bj * HALF);
        __builtin_amdgcn_sched_barrier(0);
#pragma unroll
        for (int ai = 0; ai < 2; ++ai)
#pragma unroll
            for (int m = 0; m < 4; ++m) {
                const int row = row0 + ai * HALF + m * 16;
                bf16_t* xr = XB + (size_t)row * DM + col0;
                float ss = 0.f;
#pragma unroll
                for (int bj = 0; bj < 2; ++bj) {
                    const u32x4 o = xo[ai][m][bj];
                    u32x4 w;
#pragma unroll
                    for (int e = 0; e < 4; ++e) { const unsigned q = e == 0 ? o.x : e == 1 ? o.y : e == 2 ? o.z : o.w;
                        const unsigned r = cvtpk(bflo(q) + acc[ai][bj][m][e >> 1][(e & 1) * 2], bfhi(q) + acc[ai][bj][m][e >> 1][(e & 1) * 2 + 1]);
                        const float a = bflo(r), b = bfhi(r); ss += a * a + b * b;
                        if (e == 0) w.x = r; else if (e == 1) w.y = r; else if (e == 2) w.z = r; else w.w = r; }
                    st16wt(xr + bj * HALF, w);
                }
                ss = xadd<16>(ss); ss = xadd<32>(ss);
                if (fq == 0) xsq[(size_t)row * 16 + u.pn * 4 + wc] = ss;
            }
    }
};

template <int CTRL> __device__ __forceinline__ unsigned dppu(unsigned old, unsigned src) { return (unsigned)__builtin_amdgcn_update_dpp((int)old, (int)src, CTRL, 0xf, 0xf, false); }
template <int CTRL> __device__ __forceinline__ float dppf(float old, float src) { return __int_as_float(__builtin_amdgcn_update_dpp(__float_as_int(old), __float_as_int(src), CTRL, 0xf, 0xf, false)); }
#ifndef MK_UP_SB
#define MK_UP_SB 1
#endif
#ifndef MK_DOT2
#define MK_DOT2 0
#endif
typedef __attribute__((ext_vector_type(2))) __bf16 bf16v2_t;
__device__ __forceinline__ float dot2bf(unsigned a, unsigned b, float c) { return __builtin_amdgcn_fdot2_f32_bf16(__builtin_bit_cast(bf16v2_t, a), __builtin_bit_cast(bf16v2_t, b), c, false); }
#ifndef MK_UP_T21
#define MK_UP_T21 0
#endif
struct EpiUp {
    static constexpr bool PERM = !MK_UP_T21, IDEMP = true; static constexpr int MID_T = -1;
    unsigned char* ws; const float* cw; const float* cb; float* ocp;
    __device__ __forceinline__ void mid(f32x4 (&)[2][2][4][2], const Unit&, int, int, int, int) const {}
    static constexpr bool USES_R = true;
    __device__ __forceinline__ void stage_cw(int pn, PG8_LAS unsigned char* red, int tid, int par) const {
        if (tid < 256) { const int tp = __builtin_amdgcn_readfirstlane(tid >> 6), hb = (tid >> 5) & 1, c4 = (tid & 31) * 4; const float* srcw = (tp < 3 ? cw + tp * NUP : cb) + hb * DFF + 128 * pn + c4;
            __builtin_amdgcn_global_load_lds((const unsigned*)srcw, (PG8_LAS unsigned*)((PG8_LAS float*)(red + 12288) + par * 1024 + tp * 256), 16, 0, 0); }
    }
    __device__ __forceinline__ void prep(const Unit& u, PG8_LAS unsigned char* red, int tid) const { RsPf p; rs_issue(p, (const float*)(ws + WS_XSQ), u.pm, tid); stage_cw(u.pn, red, tid, 0); rs_write(p, (PG8_LAS float*)red, tid); }
    __device__ __forceinline__ void run(f32x4 (&acc)[2][2][4][2], const Unit& u, int wr, int wc, int fr, int fq, PG8_LAS unsigned char* red, int tid, const Unit* nxt, int par) const {
        asm volatile("" : "+v"(fr), "+v"(fq), "+v"(tid));
        const PG8_LAS float* R = (const PG8_LAS float*)red + par * 256;
        RsPf pf; rs_issue(pf, (const float*)(ws + WS_XSQ), nxt ? nxt->pm : u.pm, tid);
        run2(acc, u, wr, wc, fr, fq, red, R, tid, pf, true, (PG8_LAS float*)red + (par ^ 1) * 256, par);
        if (nxt) { int t2 = tid; asm volatile("" : "+v"(t2)); stage_cw(nxt->pn, red, t2, par ^ 1); }
    }
    __device__ __forceinline__ void run2(f32x4 (&acc)[2][2][4][2], const Unit& u, int wr, int wc, int fr, int fq, PG8_LAS unsigned char* red, const PG8_LAS float* R, int tid, const RsPf& pf, bool has_pf, PG8_LAS float* Rn, int par) const {
        bf16_t* const G = (bf16_t*)(ws + WS_RB); bf16_t* const Z2 = (bf16_t*)(ws + WS_RA); float* const HT = (float*)(ws + WS_RA);
        const int row0 = u.pm * BM + wr * 64 + fr, jcb = 128 * u.pn + 32 * wc;
#define UP_CO(n) (MK_UP_T21 ? 16 * (n) + 4 * fq : 8 * fq + 4 * (n))
        if (u.pm >= MP / BM) {
#pragma unroll
            for (int ai = 0; ai < 2; ++ai)
#pragma unroll
                for (int m = 0; m < 4; ++m) { const int row = row0 + ai * HALF + m * 16; const float rs = R[ai * HALF + wr * 64 + m * 16 + fr];
#pragma unroll
                    for (int bj = 0; bj < 2; ++bj) { u32x4 w; w.x = cvtpk(acc[ai][bj][m][0][0] * rs, acc[ai][bj][m][0][1] * rs); w.y = cvtpk(acc[ai][bj][m][0][2] * rs, acc[ai][bj][m][0][3] * rs);
                        w.z = cvtpk(acc[ai][bj][m][1][0] * rs, acc[ai][bj][m][1][1] * rs); w.w = cvtpk(acc[ai][bj][m][1][2] * rs, acc[ai][bj][m][1][3] * rs);
#if MK_UP_T21
                        *(u32x2*)(Z2 + (size_t)row * NUP + bj * DFF + jcb + UP_CO(0)) = (u32x2){w.x, w.y}; *(u32x2*)(Z2 + (size_t)row * NUP + bj * DFF + jcb + UP_CO(1)) = (u32x2){w.z, w.w}; } }
#else
                        *(u32x4*)(Z2 + (size_t)row * NUP + bj * DFF + jcb + UP_CO(0)) = w; } }
#endif
            if (has_pf) rs_write(pf, Rn, tid);
            return;
        }
        const float rs3[2] = {R[wr * 64 + 48 + fr], R[HALF + wr * 64 + 48 + fr]}; const float rs00 = R[wr * 64 + fr];
        PG8_LAS float* H = (PG8_LAS float*)(red + 4096);
        const PG8_LAS float* CW = (const PG8_LAS float*)(red + 12288) + par * 1024;
        if (fr >= 14) {
#pragma unroll
            for (int ai = 0; ai < 2; ++ai)
#pragma unroll
                for (int bj = 0; bj < 2; ++bj)
#pragma unroll
                    for (int n = 0; n < 2; ++n) *(PG8_LAS f32x4*)(H + ((2 * ai + wr) * 2 + (fr - 14)) * 256 + bj * HALF + 32 * wc + UP_CO(n)) = acc[ai][bj][3][n] * rs3[ai];
        }
        if (has_pf) rs_write(pf, Rn, tid);
        asm volatile("s_waitcnt lgkmcnt(0)" ::: "memory"); __builtin_amdgcn_s_barrier(); asm volatile("" ::: "memory");
        if (fr >= 14 && wr == 1) {
            float* t = HT + ((size_t)u.pm * 4 + 2 + (fr - 14)) * NUP + jcb;
#pragma unroll
            for (int bj = 0; bj < 2; ++bj)
#pragma unroll
                for (int n = 0; n < 2; ++n) *(f32x4*)(t + bj * DFF + UP_CO(n)) = acc[1][bj][3][n] * rs3[1];
            if ((u.pm & 31) == 31) { float* o = ocp + ((size_t)(u.pm >> 5) * 2 + (fr - 14)) * NUP + jcb;
#pragma unroll
                for (int bj = 0; bj < 2; ++bj)
#pragma unroll
                    for (int n = 0; n < 2; ++n) *(f32x4*)(o + bj * DFF + UP_CO(n)) = acc[1][bj][3][n] * rs3[1]; }
        }
        if (fr < 2 && wr == 0) { float* t = HT + ((size_t)u.pm * 4 + fr) * NUP + jcb;
#pragma unroll
            for (int bj = 0; bj < 2; ++bj)
#pragma unroll
                for (int n = 0; n < 2; ++n) *(f32x4*)(t + bj * DFF + UP_CO(n)) = acc[0][bj][0][n] * rs00; }
        u32x2 zp[2][2][4][2];
#pragma unroll
        for (int ai = 0; ai < 2; ++ai)
#pragma unroll
            for (int m = 0; m < 4; ++m) { const float rs = R[ai * HALF + wr * 64 + m * 16 + fr];
#pragma unroll
                for (int bj = 0; bj < 2; ++bj)
#pragma unroll
                    for (int n = 0; n < 2; ++n) { zp[ai][bj][m][n].x = cvtpk(acc[ai][bj][m][n][0] * rs, acc[ai][bj][m][n][1] * rs); zp[ai][bj][m][n].y = cvtpk(acc[ai][bj][m][n][2] * rs, acc[ai][bj][m][n][3] * rs); } }
#if defined(MK_UP_MAIN_REPS)
        for (int mr_ = 0; mr_ < MK_UP_MAIN_REPS; ++mr_)
#endif
#pragma unroll
        for (int n = 0; n < 2; ++n) {
            f32x4 wa[3], wb[3], ba, bb;
#pragma unroll
            for (int j = 0; j < 3; ++j) { wa[j] = *(const PG8_LAS f32x4*)(CW + (j * 2 + 0) * 128 + 32 * wc + UP_CO(n)); wb[j] = *(const PG8_LAS f32x4*)(CW + (j * 2 + 1) * 128 + 32 * wc + UP_CO(n)); }
            ba = *(const PG8_LAS f32x4*)(CW + 6 * 128 + 32 * wc + UP_CO(n)); bb = *(const PG8_LAS f32x4*)(CW + 7 * 128 + 32 * wc + UP_CO(n));
#if MK_DOT2
            unsigned wap[3][4], wbp[3][4];
#pragma unroll
            for (int j = 0; j < 3; ++j)
#pragma unroll
                for (int e = 0; e < 4; ++e) { wap[j][e] = (e & 1) ? cvtpk(0.f, wa[j][e]) : cvtpk(wa[j][e], 0.f); wbp[j][e] = (e & 1) ? cvtpk(0.f, wb[j][e]) : cvtpk(wb[j][e], 0.f); }
#endif
#pragma unroll
            for (int ai = 0; ai < 2; ++ai) {
                const int cid = 2 * ai + wr;
                u32x2 wkeep = {0u, 0u};
                u32x2 h1a = {0u, 0u}, h2a = h1a, h1b = h1a, h2b = h1a;
                if (cid > 0 && fr < 2) { const PG8_LAS float* hb = H + (cid - 1) * 512 + 32 * wc + UP_CO(n);
                    const f32x4 x2a = *(const PG8_LAS f32x4*)(hb), x1a = *(const PG8_LAS f32x4*)(hb + 256), x2b = *(const PG8_LAS f32x4*)(hb + HALF), x1b = *(const PG8_LAS f32x4*)(hb + 256 + HALF);
                    h2a.x = cvtpk(x2a[0], x2a[1]); h2a.y = cvtpk(x2a[2], x2a[3]); h1a.x = cvtpk(x1a[0], x1a[1]); h1a.y = cvtpk(x1a[2], x1a[3]);
                    h2b.x = cvtpk(x2b[0], x2b[1]); h2b.y = cvtpk(x2b[2], x2b[3]); h1b.x = cvtpk(x1b[0], x1b[1]); h1b.y = cvtpk(x1b[2], x1b[3]); }
#pragma unroll
                for (int m = 0; m < 4; ++m) {
                    float g4[4];
#pragma unroll
                    for (int hx = 0; hx < 2; ++hx) {
                        const unsigned za = hx ? zp[ai][0][m][n].y : zp[ai][0][m][n].x, zb = hx ? zp[ai][1][m][n].y : zp[ai][1][m][n].x;
                        unsigned o1a, o2a, o1b, o2b;
                        if (m == 0) { const unsigned q1a = hx ? h1a.y : h1a.x, q2a = hx ? h2a.y : h2a.x, q1b = hx ? h1b.y : h1b.x, q2b = hx ? h2b.y : h2b.x; o1a = q1a; o1b = q1b; o2a = fr == 0 ? q2a : q1a; o2b = fr == 0 ? q2b : q1b; }
                        else { const unsigned pa = hx ? zp[ai][0][m - 1][n].y : zp[ai][0][m - 1][n].x, pb = hx ? zp[ai][1][m - 1][n].y : zp[ai][1][m - 1][n].x;
                            o1a = dppu<0x121>(pa, pa); o2a = dppu<0x122>(pa, pa); o1b = dppu<0x121>(pb, pb); o2b = dppu<0x122>(pb, pb); }
                        const unsigned p1a = dppu<0x111>(o1a, za), p2a = dppu<0x112>(o2a, za), p1b = dppu<0x111>(o1b, zb), p2b = dppu<0x112>(o2b, zb);
                        const int e0 = 2 * hx, e1 = 2 * hx + 1;
#if MK_DOT2
                        const float ca0 = dot2bf(za, wap[2][e0], dot2bf(p1a, wap[1][e0], dot2bf(p2a, wap[0][e0], ba[e0]))), cb0 = dot2bf(zb, wbp[2][e0], dot2bf(p1b, wbp[1][e0], dot2bf(p2b, wbp[0][e0], bb[e0])));
                        const float ca1 = dot2bf(za, wap[2][e1], dot2bf(p1a, wap[1][e1], dot2bf(p2a, wap[0][e1], ba[e1]))), cb1 = dot2bf(zb, wbp[2][e1], dot2bf(p1b, wbp[1][e1], dot2bf(p2b, wbp[0][e1], bb[e1])));
#else
                        const float ca0 = ba[e0] + wa[0][e0] * bflo(p2a) + wa[1][e0] * bflo(p1a) + wa[2][e0] * bflo(za), cb0 = bb[e0] + wb[0][e0] * bflo(p2b) + wb[1][e0] * bflo(p1b) + wb[2][e0] * bflo(zb);
                        const float ca1 = ba[e1] + wa[0][e1] * bfhi(p2a) + wa[1][e1] * bfhi(p1a) + wa[2][e1] * bfhi(za), cb1 = bb[e1] + wb[0][e1] * bfhi(p2b) + wb[1][e1] * bfhi(p1b) + wb[2][e1] * bfhi(zb);
#endif
                        g4[e0] = gelu_t(ca0) * cb0; g4[e1] = gelu_t(ca1) * cb1;
                    }
                    u32x2 w2; w2.x = cvtpk(g4[0], g4[1]); w2.y = cvtpk(g4[2], g4[3]);
#if MK_UP_T21
                    if ((m & 1) == 0) wkeep = w2;
                    else { auto sx = __builtin_amdgcn_permlane16_swap(wkeep.x, w2.x, false, false); auto sy = __builtin_amdgcn_permlane16_swap(wkeep.y, w2.y, false, false);
                        const bool odd = (fq & 1) != 0;
                        u32x4 w4; w4.x = sx[0]; w4.y = sy[0]; w4.z = sx[1]; w4.w = sy[1];
                        const int rowb = row0 + ai * HALF + (odd ? m : m - 1) * 16, colb = jcb + 16 * n + 4 * (fq & 2);
                        const bool deferred = (cid == 0) && (m == 1) && !odd && (fr < 2) && ((u.pm & 31) != 0);
                        if (!deferred) *(u32x4*)(G + (size_t)rowb * DFF + colb) = w4; }
#else
                    { const bool deferred = (cid == 0) && (m == 0) && (fr < 2) && ((u.pm & 31) != 0);
                        if (!deferred) *(u32x2*)(G + (size_t)(row0 + ai * HALF + m * 16) * DFF + jcb + UP_CO(n)) = w2; }
#endif
#if MK_UP_SB == 1
                    __builtin_amdgcn_sched_barrier(0);
#elif MK_UP_SB == 2
                    if (m & 1) __builtin_amdgcn_sched_barrier(0);
#endif
                }
            }
        }
    }
};

#ifndef MK_FRESH_SKIP
#define MK_FRESH_SKIP 1
#endif
template <class Epi, class Sched>
__device__ __forceinline__ void gemm_phase(PG8_LAS unsigned char* lds, PG8_LAS unsigned char* red, const Gemm g, const Sched& S, const Epi& E, int s_wave) {
    int tid_ = tid_from_wave(s_wave); asm volatile("" : "+v"(tid_));
    const int tid = tid_, wid = __builtin_amdgcn_readfirstlane(tid >> 6), lane = tid & 63, wr = wid >> 2, wc = wid & 3, fr = lane & 15, fq = lane >> 4;
    const int K = g.K, nt = K / BK;
    unsigned voffA[2], voffB[2];
#pragma unroll
    for (int i = 0; i < 2; ++i) { int R, C; stage_rc(tid * 16 + i * 8192, R, C); const int Rb = Epi::PERM ? ((R & ~31) + perm32(R & 31)) : R;
        voffA[i] = (unsigned)(R * K + C) * 2u; voffB[i] = (unsigned)(Rb * K + C) * 2u; }
    const size_t kstep = (size_t)(BK * 2);
    const size_t hstep = (size_t)HALF * K * 2;
    const size_t tstep = 2 * hstep;
    const unsigned ldsw = (unsigned)wid * 1024u;
    const int aoff = lds_byte(wr * 64 + fr, fq * 8), boff = lds_byte(wc * 32 + fr, fq * 8);
#define PG8_SA(b, h) (((b) * 2 + (h)) * HTB)
#define PG8_SB(b, h) ((4 + (b) * 2 + (h)) * HTB)
#define PG8_STAGE(bufoff, gbase, voff) do { _Pragma("unroll") for (int _i = 0; _i < 2; ++_i) \
        __builtin_amdgcn_global_load_lds((const unsigned*)((const char*)(gbase) + (voff)[_i]), (PG8_LAS unsigned*)(lds + (bufoff) + ldsw + _i * 8192), 16, 0, 0); } while (0)
#define PG8_LDA(dst, b, h) do { _Pragma("unroll") for (int m = 0; m < 4; ++m) _Pragma("unroll") for (int k = 0; k < 2; ++k) dst[m][k] = *(const PG8_LAS bf16x8*)(lds + PG8_SA(b, h) + aoff + m * 2048 + k * 1024); } while (0)
#define PG8_LDB(dst, b, h) do { _Pragma("unroll") for (int n = 0; n < 2; ++n) _Pragma("unroll") for (int k = 0; k < 2; ++k) dst[n][k] = *(const PG8_LAS bf16x8*)(lds + PG8_SB(b, h) + boff + n * 2048 + k * 1024); } while (0)
#define PG8_MMA(ai, bj, At, Bt) do { __builtin_amdgcn_s_setprio(1); _Pragma("unroll") for (int m = 0; m < 4; ++m) _Pragma("unroll") for (int n = 0; n < 2; ++n) _Pragma("unroll") for (int k = 0; k < 2; ++k) \
        acc[ai][bj][m][n] = __builtin_amdgcn_mfma_f32_16x16x32_bf16(Bt[n][k], At[m][k], acc[ai][bj][m][n], 0, 0, 0); __builtin_amdgcn_s_setprio(0); } while (0)
#define PG8_WAIT_V(n) asm volatile("s_waitcnt vmcnt(" #n ")" ::: "memory")
#define PG8_WAIT_V8_UNLESS(f) asm volatile("s_cmp_lg_u32 %0, 0\n\ts_cbranch_scc1 .Lsk%=\n\ts_waitcnt vmcnt(8)\n.Lsk%=:" :: "s"(f) : "scc", "memory")
#define PG8_WAIT_L(n) asm volatile("s_waitcnt lgkmcnt(" #n ")" ::: "memory")
#define PG8_BAR __builtin_amdgcn_s_barrier()
#define PG8_SCHED __builtin_amdgcn_sched_barrier(0)
#if defined(MK_DUP_KLOOP)
#define PG8_NEXT(i, u) (Epi::IDEMP ? S.next((i) >> 1, u) : S.next((i), u))
#define PG8_SKIP_EPI(i) (Epi::IDEMP && (((i) & 1) == 0))
#else
#define PG8_NEXT(i, u) S.next((i), u)
#define PG8_SKIP_EPI(i) false
#endif
    Unit cur, nxt; int ui = 0;
    if (!PG8_NEXT(0, cur)) return;
    if constexpr (Epi::USES_R) E.prep(cur, red, tid);
    f32x4 acc[2][2][4][2];
#pragma unroll
    for (int a = 0; a < 2; ++a)
#pragma unroll
        for (int b = 0; b < 2; ++b)
#pragma unroll
            for (int m = 0; m < 4; ++m)
#pragma unroll
                for (int n = 0; n < 2; ++n) acc[a][b][m][n] = (f32x4){0.f, 0.f, 0.f, 0.f};
    bf16x8 At[4][2], B0[2][2], B1[2][2];
    const char* cA = (const char*)g.A + (size_t)cur.pm * tstep; const char* cB = (const char*)g.Bt + (size_t)cur.pn * tstep;
    PG8_STAGE(PG8_SB(0, 0), cB, voffB); PG8_STAGE(PG8_SB(0, 1), cB + hstep, voffB); PG8_STAGE(PG8_SA(0, 0), cA, voffA); PG8_STAGE(PG8_SA(0, 1), cA + hstep, voffA);
    if (wr == 1) PG8_BAR;
    PG8_WAIT_V(2); PG8_BAR;
    PG8_STAGE(PG8_SB(1, 0), cB + kstep, voffB); PG8_STAGE(PG8_SA(1, 0), cA + kstep, voffA); PG8_STAGE(PG8_SB(1, 1), cB + hstep + kstep, voffB);
    PG8_WAIT_V(6); PG8_BAR;
    for (;;) {
        const bool has_next = PG8_NEXT(ui + 1, nxt);
        const char* nA = has_next ? (const char*)g.A + (size_t)nxt.pm * tstep : cA; const char* nB = has_next ? (const char*)g.Bt + (size_t)nxt.pn * tstep : cB;
        for (int t = 0; t < nt; t += 2) {
            const bool last = (t == nt - 2);
            const char* a1 = cA + (size_t)(t + 1) * kstep;
            const char* a2 = last ? nA : cA + (size_t)(t + 2) * kstep; const char* b2 = last ? nB : cB + (size_t)(t + 2) * kstep;
            const char* a3 = a2 + kstep; const char* b3 = b2 + kstep;
            if constexpr (Epi::MID_T >= 0) { if (t == Epi::MID_T) E.mid(acc, cur, wr, wc, fr, fq); }
            const int fresh_ = __builtin_amdgcn_readfirstlane((MK_FRESH_SKIP && ui != 0 && t == 0) ? 1 : 0);
            PG8_LDB(B0, 0, 0); PG8_LDB(B1, 0, 1); PG8_SCHED; PG8_LDA(At, 0, 0); PG8_STAGE(PG8_SA(1, 1), a1 + hstep, voffA);
            PG8_WAIT_V8_UNLESS(fresh_); PG8_WAIT_L(0); PG8_BAR; PG8_MMA(0, 0, At, B0); PG8_MMA(0, 1, At, B1); PG8_BAR; PG8_SCHED;
            PG8_LDA(At, 0, 1); PG8_STAGE(PG8_SB(0, 0), b2, voffB); PG8_STAGE(PG8_SB(0, 1), b2 + hstep, voffB); PG8_STAGE(PG8_SA(0, 0), a2, voffA);
            PG8_WAIT_V8_UNLESS(fresh_); PG8_WAIT_L(0); PG8_BAR; PG8_MMA(1, 0, At, B0); PG8_MMA(1, 1, At, B1); PG8_BAR; PG8_SCHED;
            PG8_LDB(B0, 1, 0); PG8_LDB(B1, 1, 1); PG8_SCHED; PG8_LDA(At, 1, 0); PG8_STAGE(PG8_SA(0, 1), a2 + hstep, voffA);
            PG8_WAIT_V(8); PG8_WAIT_L(0); PG8_BAR; PG8_MMA(0, 0, At, B0); PG8_MMA(0, 1, At, B1); PG8_BAR; PG8_SCHED;
            PG8_LDA(At, 1, 1); PG8_STAGE(PG8_SB(1, 0), b3, voffB); PG8_STAGE(PG8_SB(1, 1), b3 + hstep, voffB); PG8_STAGE(PG8_SA(1, 0), a3, voffA);
            PG8_WAIT_V(8); PG8_WAIT_L(0); PG8_BAR; PG8_MMA(1, 0, At, B0); PG8_MMA(1, 1, At, B1); PG8_BAR; PG8_SCHED;
        }
        if (wr == 0) PG8_BAR;
#if MK_FRESH_SKIP
        PG8_WAIT_V(0);
#endif
        if (!PG8_SKIP_EPI(ui)) E.run(acc, cur, wr, wc, fr, fq, red, tid, has_next ? &nxt : nullptr, ui & 1);
#if defined(MK_EPI_TWICE)
        if constexpr (Epi::MID_T < 0 && Epi::IDEMP) { for (int er_ = 1; er_ < MK_EPI_TWICE; ++er_) { asm volatile("s_waitcnt lgkmcnt(0)" ::: "memory"); __builtin_amdgcn_s_barrier(); E.run(acc, cur, wr, wc, fr, fq, red, tid, has_next ? &nxt : nullptr, ui & 1); } }
#endif
        if (!has_next) break;
#pragma unroll
        for (int a = 0; a < 2; ++a)
#pragma unroll
            for (int b = 0; b < 2; ++b)
#pragma unroll
                for (int m = 0; m < 4; ++m)
#pragma unroll
                    for (int n = 0; n < 2; ++n) acc[a][b][m][n] = (f32x4){0.f, 0.f, 0.f, 0.f};
        cur = nxt; cA = nA; cB = nB; ++ui;
        if (wr == 1) PG8_BAR;
    }
    PG8_WAIT_V(0);
    PG8_BAR;
#undef PG8_SA
#undef PG8_SB
#undef PG8_STAGE
#undef PG8_LDA
#undef PG8_LDB
#undef PG8_MMA
#undef PG8_WAIT_V
#undef PG8_WAIT_V8_UNLESS
#undef PG8_WAIT_L
#undef PG8_BAR
#undef PG8_SCHED
}
template <class Epi>
__device__ __forceinline__ void gemm_phase_x(PG8_LAS unsigned char* lds, PG8_LAS unsigned char* red, const Gemm g, const Unit cur, const Epi& E, int s_wave) {
    int tid_ = tid_from_wave(s_wave); asm volatile("" : "+v"(tid_));
    const int tid = tid_, wid = __builtin_amdgcn_readfirstlane(tid >> 6), lane = tid & 63, wr = wid >> 2, wc = wid & 3, fr = lane & 15, fq = lane >> 4;
    const int K = g.K, nt = K / BK;
    unsigned voffA[2], voffB[2], voffX;
#pragma unroll
    for (int i = 0; i < 2; ++i) { int R, C; stage_rc(tid * 16 + i * 8192, R, C); const int Rb = Epi::PERM ? ((R & ~31) + perm32(R & 31)) : R;
        voffA[i] = (unsigned)(R * K + C) * 2u; voffB[i] = (unsigned)(Rb * K + C) * 2u; }
    { int R, C; stage_rc(tid * 4, R, C); voffX = (unsigned)(R * K + C) * 2u; }
    const size_t kstep = (size_t)(BK * 2);
    const size_t hstep = (size_t)HALF * K * 2;
    const size_t tstep = 2 * hstep;
    const unsigned ldsw = (unsigned)wid * 1024u;
    const int aoff = lds_byte(wr * 64 + fr, fq * 8), boff = lds_byte(wc * 32 + fr, fq * 8), xoff = lds_byte(fr, fq * 8);
    constexpr int XA_OFF = RING_BYTES + 4096;
#define PGX_SA(b, h) (((b) * 2 + (h)) * HTB)
#define PGX_SB(b, h) ((4 + (b) * 2 + (h)) * HTB)
#define PGX_STAGE(bufoff, gbase, voff) do { _Pragma("unroll") for (int _i = 0; _i < 2; ++_i) \
        __builtin_amdgcn_global_load_lds((const unsigned*)((const char*)(gbase) + (voff)[_i]), (PG8_LAS unsigned*)(lds + (bufoff) + ldsw + _i * 8192), 16, 0, 0); } while (0)
#define PGX_STAGEX(b, gbase) __builtin_amdgcn_global_load_lds((const unsigned*)((const char*)(gbase) + voffX), (PG8_LAS unsigned*)(lds + XA_OFF + (b) * 2048 + wid * 256), 4, 0, 0)
#define PGX_LDA(dst, b, h) do { _Pragma("unroll") for (int m = 0; m < 4; ++m) _Pragma("unroll") for (int k = 0; k < 2; ++k) dst[m][k] = *(const PG8_LAS bf16x8*)(lds + PGX_SA(b, h) + aoff + m * 2048 + k * 1024); } while (0)
#define PGX_LDB(dst, b, h) do { _Pragma("unroll") for (int n = 0; n < 2; ++n) _Pragma("unroll") for (int k = 0; k < 2; ++k) dst[n][k] = *(const PG8_LAS bf16x8*)(lds + PGX_SB(b, h) + boff + n * 2048 + k * 1024); } while (0)
#define PGX_LDX(dst, b) do { _Pragma("unroll") for (int k = 0; k < 2; ++k) dst[k] = *(const PG8_LAS bf16x8*)(lds + XA_OFF + (b) * 2048 + xoff + k * 1024); } while (0)
#define PGX_MMA(ai, bj, At, Bt) do { __builtin_amdgcn_s_setprio(1); _Pragma("unroll") for (int m = 0; m < 4; ++m) _Pragma("unroll") for (int n = 0; n < 2; ++n) _Pragma("unroll") for (int k = 0; k < 2; ++k) \
        acc[ai][bj][m][n] = __builtin_amdgcn_mfma_f32_16x16x32_bf16(Bt[n][k], At[m][k], acc[ai][bj][m][n], 0, 0, 0); __builtin_amdgcn_s_setprio(0); } while (0)
#define PGX_MMAX(Bt) do { _Pragma("unroll") for (int n = 0; n < 2; ++n) _Pragma("unroll") for (int k = 0; k < 2; ++k) accx[n] = __builtin_amdgcn_mfma_f32_16x16x32_bf16(Bt[n][k], Xt[k], accx[n], 0, 0, 0); } while (0)
#define PGX_WAIT_V(n) asm volatile("s_waitcnt vmcnt(" #n ")" ::: "memory")
#define PGX_WAIT_L(n) asm volatile("s_waitcnt lgkmcnt(" #n ")" ::: "memory")
#define PGX_BAR __builtin_amdgcn_s_barrier()
#define PGX_SCHED __builtin_amdgcn_sched_barrier(0)
    f32x4 acc[2][2][4][2], accx[2];
    bf16x8 At[4][2], B0[2][2], B1[2][2], Xt[2];
    const char* cA = (const char*)g.A + (size_t)cur.pm * tstep; const char* cB = (const char*)g.Bt + (size_t)cur.pn * tstep;
    const char* cX = (const char*)g.A + (size_t)(MP + 16 * cur.pm) * K * 2;
#pragma unroll
    for (int a = 0; a < 2; ++a)
#pragma unroll
        for (int b = 0; b < 2; ++b)
#pragma unroll
            for (int m = 0; m < 4; ++m)
#pragma unroll
                for (int n = 0; n < 2; ++n) acc[a][b][m][n] = (f32x4){0.f, 0.f, 0.f, 0.f};
    accx[0] = (f32x4){0.f, 0.f, 0.f, 0.f}; accx[1] = (f32x4){0.f, 0.f, 0.f, 0.f};
#ifndef MK_PRETOUCH
#define MK_PRETOUCH 0
#endif
#if MK_PRETOUCH > 0
    { const int ia = cur.pn * 512 + tid, ib = (cur.pm & 3) * 512 + tid;
      const char* pa = cA + (size_t)(ia & 255) * K * 2 + (size_t)(2 + (ia >> 8)) * kstep; const char* pb = cB + (size_t)(ib & 255) * K * 2 + (size_t)(2 + (ib >> 8)) * kstep;
      __builtin_amdgcn_global_load_lds((const unsigned*)pa, (PG8_LAS unsigned*)(lds + PGX_SB(1, 1) + wid * 256), 4, 0, 0);
      __builtin_amdgcn_global_load_lds((const unsigned*)pb, (PG8_LAS unsigned*)(lds + PGX_SB(1, 1) + 2048 + wid * 256), 4, 0, 0); }
#endif
    PGX_STAGEX(0, cX); PGX_STAGE(PGX_SB(0, 0), cB, voffB); PGX_STAGE(PGX_SB(0, 1), cB + hstep, voffB); PGX_STAGE(PGX_SA(0, 0), cA, voffA); PGX_STAGE(PGX_SA(0, 1), cA + hstep, voffA);
    if (wr == 1) PGX_BAR;
    PGX_WAIT_V(2); PGX_BAR;
    PGX_STAGEX(1, cX + kstep); PGX_STAGE(PGX_SB(1, 0), cB + kstep, voffB); PGX_STAGE(PGX_SA(1, 0), cA + kstep, voffA); PGX_STAGE(PGX_SB(1, 1), cB + hstep + kstep, voffB);
    PGX_WAIT_V(7); PGX_BAR;
#if defined(MK_X_KREPS)
    for (int t_ = 0; t_ < nt * 2; t_ += 2) { const int t = t_ >= nt ? t_ - nt : t_;
        if (t == 0 && t_ > 0) { float z0_ = 0.f; asm volatile("" : "+v"(z0_));
#pragma unroll
            for (int a = 0; a < 2; ++a)
#pragma unroll
                for (int b = 0; b < 2; ++b)
#pragma unroll
                    for (int m = 0; m < 4; ++m)
#pragma unroll
                        for (int n = 0; n < 2; ++n) acc[a][b][m][n] *= z0_;
            accx[0] *= z0_; accx[1] *= z0_; }
#else
    for (int t = 0; t < nt; t += 2) {
#endif
        const bool last = (t == nt - 2);
        const char* a1 = cA + (size_t)(t + 1) * kstep;
        const char* a2 = last ? cA : cA + (size_t)(t + 2) * kstep; const char* b2 = last ? cB : cB + (size_t)(t + 2) * kstep; const char* x2 = last ? cX : cX + (size_t)(t + 2) * kstep;
        const char* a3 = a2 + kstep; const char* b3 = b2 + kstep; const char* x3 = x2 + kstep;
        if constexpr (Epi::MID_T >= 0) { if (t == Epi::MID_T) { E.mid(acc, cur, wr, wc, fr, fq); E.midx(accx, cur, wr, wc, fr, fq); } }
        PGX_LDB(B0, 0, 0); PGX_LDB(B1, 0, 1); PGX_SCHED; PGX_LDA(At, 0, 0); PGX_LDX(Xt, 0); PGX_STAGE(PGX_SA(1, 1), a1 + hstep, voffA);
        PGX_WAIT_V(9); PGX_WAIT_L(0); PGX_BAR; PGX_MMA(0, 0, At, B0); PGX_MMA(0, 1, At, B1); if (wr == 0) PGX_MMAX(B0); else PGX_MMAX(B1); PGX_BAR; PGX_SCHED;
        PGX_LDA(At, 0, 1); PGX_STAGEX(0, x2); PGX_STAGE(PGX_SB(0, 0), b2, voffB); PGX_STAGE(PGX_SB(0, 1), b2 + hstep, voffB); PGX_STAGE(PGX_SA(0, 0), a2, voffA);
        PGX_WAIT_V(9); PGX_WAIT_L(0); PGX_BAR; PGX_MMA(1, 0, At, B0); PGX_MMA(1, 1, At, B1); PGX_BAR; PGX_SCHED;
        PGX_LDB(B0, 1, 0); PGX_LDB(B1, 1, 1); PGX_SCHED; PGX_LDA(At, 1, 0); PGX_LDX(Xt, 1); PGX_STAGE(PGX_SA(0, 1), a2 + hstep, voffA);
        PGX_WAIT_V(9); PGX_WAIT_L(0); PGX_BAR; PGX_MMA(0, 0, At, B0); PGX_MMA(0, 1, At, B1); if (wr == 0) PGX_MMAX(B0); else PGX_MMAX(B1); PGX_BAR; PGX_SCHED;
        PGX_LDA(At, 1, 1); PGX_STAGEX(1, x3); PGX_STAGE(PGX_SB(1, 0), b3, voffB); PGX_STAGE(PGX_SB(1, 1), b3 + hstep, voffB); PGX_STAGE(PGX_SA(1, 0), a3, voffA);
        PGX_WAIT_V(9); PGX_WAIT_L(0); PGX_BAR; PGX_MMA(1, 0, At, B0); PGX_MMA(1, 1, At, B1); PGX_BAR; PGX_SCHED;
    }
    if (wr == 0) PGX_BAR;
    PGX_WAIT_V(0); PGX_BAR;
    E.run(acc, cur, wr, wc, fr, fq, red, tid, nullptr, 0);
    E.runx(accx, cur, wr, wc, fr, fq, red, tid);
    PGX_BAR;
#undef PGX_SA
#undef PGX_SB
#undef PGX_STAGE
#undef PGX_STAGEX
#undef PGX_LDA
#undef PGX_LDB
#undef PGX_LDX
#undef PGX_MMA
#undef PGX_MMAX
#undef PGX_WAIT_V
#undef PGX_WAIT_L
#undef PGX_BAR
#undef PGX_SCHED
}
}

typedef GAS unsigned gu32;
#define RLX_AGENT __ATOMIC_RELAXED, __HIP_MEMORY_SCOPE_AGENT
#define LDS_WAIT() asm volatile("s_waitcnt lgkmcnt(0)" ::: "memory")
#define VM_WAIT() asm volatile("s_waitcnt vmcnt(0)" ::: "memory")

#define XB_TMO      128
#define XB_XCNT(j)  (256  + 64 * (j))
#define XB_XSUB(j)  (1280 + 64 * (j))
#define XB_XGEN(j)  (2304 + 64 * (j))
#define XB_TOP      3328
#define XB_TOPGEN   3392
#define XCD_BAR_WORDS 3456
#define XB_SPIN_CAP (1u << 18)
__device__ __forceinline__ unsigned xb_ld(unsigned* p)              { return __hip_atomic_load(p, __ATOMIC_RELAXED, __HIP_MEMORY_SCOPE_AGENT); }
__device__ __forceinline__ unsigned xb_add(unsigned* p, unsigned v) { return __hip_atomic_fetch_add(p, v, __ATOMIC_RELAXED, __HIP_MEMORY_SCOPE_AGENT); }
__device__ __forceinline__ unsigned xb_xcc_id() { return (unsigned)__builtin_amdgcn_s_getreg((3 << 11) | 20) & 0xFu; }
#define XB_SPIN(cond, bar) do { unsigned _sp = 0; while (cond) { __builtin_amdgcn_s_sleep(1); \
    if ((++_sp & 255u) == 0u) { if (xb_ld(&(bar)[XB_TMO])) break; if (_sp > XB_SPIN_CAP) { atomicAdd(&(bar)[XB_TMO], 1u); break; } } } } while (0)
struct XcdBarrier { unsigned* bar; unsigned x; volatile LAS unsigned* st; };
__device__ __forceinline__ XcdBarrier xcd_barrier_post(unsigned* bar, volatile LAS unsigned* st, bool leader) {
    XcdBarrier b; b.bar = bar; b.x = xb_xcc_id(); b.st = st;
    if (leader) (void)xb_add(&bar[XB_XCNT(b.x)], 1u);
    return b;
}
__device__ __forceinline__ void xcd_barrier_complete(unsigned* bar, unsigned x, unsigned& nloc, unsigned& nx) {
    const unsigned G = gridDim.x * gridDim.y * gridDim.z;
    unsigned sum, cnt, mine, sp = 0u;
    for (;;) {
        sum = 0u; cnt = 0u; mine = 0u;
#pragma unroll
        for (unsigned j = 0; j < 16; ++j) { const unsigned c = xb_ld(&bar[XB_XCNT(j)]); sum += c; cnt += (c > 0u) ? 1u : 0u; mine = (j == x) ? c : mine; }
        if (sum == G) break;
        __builtin_amdgcn_s_sleep(1);
        if ((++sp & 255u) == 0u) { if (xb_ld(&bar[XB_TMO])) break; if (sp > XB_SPIN_CAP) { atomicAdd(&bar[XB_TMO], 1u); break; } }
    }
    nloc = mine > 0u ? mine : 1u; nx = cnt > 0u ? cnt : 1u;
}
__device__ __forceinline__ void xcd_barrier(const XcdBarrier& b, bool leader) {
    asm volatile("s_waitcnt vmcnt(0)" ::: "memory");
    __syncthreads();
    if (leader) {
        unsigned* bar = b.bar;
        __builtin_amdgcn_s_waitcnt(0);
        unsigned nloc = b.st[0], nx = b.st[1];
        if (nloc == 0u) { xcd_barrier_complete(bar, b.x, nloc, nx); b.st[0] = nloc; b.st[1] = nx; }
        const unsigned old = xb_add(&bar[XB_XSUB(b.x)], 1u);
        const unsigned gen = old / nloc;
        if (old + 1u == (gen + 1u) * nloc) {
            __builtin_amdgcn_fence(__ATOMIC_RELEASE, "agent");
            asm volatile("s_waitcnt vmcnt(0)" ::: "memory");
            const unsigned og = xb_add(&bar[XB_TOP], 1u);
            const unsigned tg = og / nx;
            if (og + 1u == (tg + 1u) * nx) xb_add(&bar[XB_TOPGEN], 1u);
            else XB_SPIN(xb_ld(&bar[XB_TOPGEN]) == tg, bar);
            __builtin_amdgcn_fence(__ATOMIC_ACQUIRE, "agent");
            xb_add(&bar[XB_XGEN(b.x)], 1u);
            asm volatile("s_waitcnt vmcnt(0)" ::: "memory");
        } else {
            XB_SPIN(xb_ld(&bar[XB_XGEN(b.x)]) == gen, bar);
            __builtin_amdgcn_fence(__ATOMIC_ACQUIRE, "agent");
            asm volatile("s_waitcnt vmcnt(0)" ::: "memory");
        }
    }
    __syncthreads();
}

struct Frame { LAS unsigned char* lds; int tid, lane, wave, vcu, G; };
__device__ __forceinline__ Frame make_frame(LAS unsigned char* lds, int s_wave) {
    Frame F; F.lds = lds; int t = tid_from_wave(s_wave); asm volatile("" : "+v"(t)); F.tid = t; F.lane = t & 63; F.wave = __builtin_amdgcn_readfirstlane(t >> 6);
    F.G = gridDim.x; { const int bx = blockIdx.x; F.vcu = (F.G % 8 == 0) ? (bx % 8) * (F.G / 8) + bx / 8 : bx; }
    return F;
}

__device__ __forceinline__ float wave_sum(float v) {
    v = xadd<1>(v); v = xadd<2>(v); v = xadd<4>(v); v = xadd<8>(v); v = xadd<16>(v); v = xadd<32>(v);
    return v;
}

struct Ptrs {
    const float *xp, *xs, *ck, *cv, *sc, *nmix, *w_in, *sinks, *lng, *lnb, *gws, *gbs, *wpa, *wpb, *wout, *nffn, *wup, *cw, *cb, *wdn, *nfin;
    float* out; unsigned char* ws;
};

struct TItem { const float* W; bf16_t* WT; const float* gain; int N, ldt, col_off, k0, n0, n0d; };
__device__ __forceinline__ void titem_decode(const Ptrs& P, int it, TItem& t) {
    constexpr int I_IN = 16 * 160, I_PA = 16 * 32, I_PB = 12 * 32, I_OUT = 16 * 32, I_UP = 16 * 176, I_DN = 44 * 32, I_L = I_IN + I_PA + I_PB + I_OUT + I_UP + I_DN;
    const int l = it / I_L; int r = it % I_L; int remap = 0;
    if (r < I_IN) { t.W = P.w_in + (size_t)l * DM * NIN; t.N = NIN; t.WT = (bf16_t*)(P.ws + WS_WIN) + (size_t)l * NIN * DM; t.ldt = DM; t.col_off = 0; t.gain = P.nmix + l * DM; remap = 1; }
    else if ((r -= I_IN) < I_PA) { t.W = P.wpa + (size_t)l * DM * DM; t.N = DM; t.WT = (bf16_t*)(P.ws + WS_WM) + (size_t)l * DM * KM; t.ldt = KM; t.col_off = 0; t.gain = nullptr; }
    else if ((r -= I_PA) < I_PB) { t.W = P.wpb + (size_t)l * GW * DM; t.N = DM; t.WT = (bf16_t*)(P.ws + WS_WM) + (size_t)l * DM * KM; t.ldt = KM; t.col_off = 1024; t.gain = nullptr; }
    else if ((r -= I_PB) < I_OUT) { t.W = P.wout + (size_t)l * DM * DM; t.N = DM; t.WT = (bf16_t*)(P.ws + WS_WOUT) + (size_t)l * DM * DM; t.ldt = DM; t.col_off = 0; t.gain = nullptr; }
    else if ((r -= I_OUT) < I_UP) { t.W = P.wup + (size_t)l * DM * NUP; t.N = NUP; t.WT = (bf16_t*)(P.ws + WS_WUP) + (size_t)l * NUP * DM; t.ldt = DM; t.col_off = 0; t.gain = P.nffn + l * DM; remap = 2; }
    else { r -= I_UP; t.W = P.wdn + (size_t)l * DFF * DM; t.N = DM; t.WT = (bf16_t*)(P.ws + WS_WDN) + (size_t)l * DM * DFF; t.ldt = DFF; t.col_off = 0; t.gain = nullptr; }
    const int nblk = t.N / 32, kb = r / nblk, nb = r % nblk; t.k0 = 64 * kb; t.n0 = 32 * nb; t.n0d = t.n0;
    if (remap == 1 && t.n0 >= C_GA) { const int h = t.n0 >= C_GB, a = t.n0 - (h ? C_GB : C_GA); t.n0d = C_GA + 256 * (a >> 7) + 128 * h + (a & 127); }
    if (remap == 2) { const int h = t.n0 >= DFF, a = t.n0 - (h ? DFF : 0); t.n0d = 256 * (a >> 7) + 128 * h + (a & 127); }
}
__device__ __forceinline__ void titem_load(const TItem& t, f32x4 (&v)[8], int lane) {
    const float* p = t.W + (size_t)(t.k0 + (lane >> 3)) * t.N + t.n0 + (lane & 7) * 4;
#pragma unroll
#ifndef MK_WT_NT
#define MK_WT_NT 2
#endif
#if MK_WT_NT >= 1
    for (int i = 0; i < 8; ++i) v[i] = __builtin_nontemporal_load((const f32x4*)(p + (size_t)(8 * i) * t.N));
#else
    for (int i = 0; i < 8; ++i) v[i] = *(const f32x4*)(p + (size_t)(8 * i) * t.N);
#endif
}
__device__ __forceinline__ void titem_finish(const TItem& t, const f32x4 (&v)[8], LAS float* scr, int lane) {
#pragma unroll
    for (int i = 0; i < 8; ++i) { const int kk = 8 * i + (lane >> 3); const float gsc = t.gain ? t.gain[t.k0 + kk] : 1.0f; LAS float* s = scr + kk * 33 + (lane & 7) * 4;
        s[0] = v[i][0] * gsc; s[1] = v[i][1] * gsc; s[2] = v[i][2] * gsc; s[3] = v[i][3] * gsc; }
    LDS_WAIT(); asm volatile("" ::: "memory");
    const int c = lane & 7;
#pragma unroll
    for (int j = 0; j < 4; ++j) { const int n = (lane >> 3) + 8 * j; const LAS float* s = scr + (8 * c) * 33 + n;
        u32x4 o; o.x = cvtpk(s[0 * 33], s[1 * 33]); o.y = cvtpk(s[2 * 33], s[3 * 33]); o.z = cvtpk(s[4 * 33], s[5 * 33]); o.w = cvtpk(s[6 * 33], s[7 * 33]);
#if MK_WT_NT >= 2
        __builtin_nontemporal_store(o, (GAS u32x4*)(t.WT + (size_t)(t.n0d + n) * t.ldt + t.col_off + t.k0 + 8 * c)); }
#else
        *(GAS u32x4*)(t.WT + (size_t)(t.n0d + n) * t.ldt + t.col_off + t.k0 + 8 * c) = o; }
#endif
    LDS_WAIT(); asm volatile("" ::: "memory");
}
__device__ __forceinline__ void job_weights(const Ptrs& P, int l, LAS float* scr, int gw, int NGW, int lane) {
    constexpr int I_L = 8192; const int beg = l * I_L, end = beg + I_L;
    int it = beg + gw; TItem ta, tb; f32x4 va[8], vb[8];
#if defined(MK_W_NOPF)
    if (NGW < 2048) { for (; it < end; it += NGW) { titem_decode(P, it, ta); titem_load(ta, va, lane); titem_finish(ta, va, scr, lane); } return; }
#endif
    if (it < end) { titem_decode(P, it, ta); titem_load(ta, va, lane); }
    while (it < end) {
        const int it1 = it + NGW; if (it1 < end) { titem_decode(P, it1, tb); titem_load(tb, vb, lane); }
        titem_finish(ta, va, scr, lane);
        if (it1 >= end) break;
        const int it2 = it1 + NGW; if (it2 < end) { titem_decode(P, it2, ta); titem_load(ta, va, lane); }
        titem_finish(tb, vb, scr, lane);
        it = it2;
    }
}
__device__ __forceinline__ void job_cache_copy(const Ptrs& P, int l, int gt, int NT) {
    constexpr int PER = 7680, TOT = 2 * SB * PER;
    const float* ckl = P.ck + (size_t)l * SB * 32768; const float* cvl = P.cv + (size_t)l * SB * 32768; float* okl = P.out + O_WKS + (size_t)l * SB * 32768; float* ovl = P.out + O_WVS + (size_t)l * SB * 32768;
    for (int e0 = gt; e0 < TOT; e0 += 8 * NT) {
        f32x4 v[8];
#pragma unroll
        for (int q = 0; q < 8; ++q) { const int e = e0 + q * NT; if (e < TOT) { const int which = e >= SB * PER, r = which ? e - SB * PER : e, b = r / PER, o = r % PER; v[q] = *(const f32x4*)((which ? cvl : ckl) + (size_t)b * 32768 + 2048 + (size_t)o * 4); } }
#pragma unroll
        for (int q = 0; q < 8; ++q) { const int e = e0 + q * NT; if (e < TOT) { const int which = e >= SB * PER, r = which ? e - SB * PER : e, b = r / PER, o = r % PER; *(f32x4*)((which ? ovl : okl) + (size_t)b * 32768 + (size_t)o * 4) = v[q]; } }
    }
}

__device__ __forceinline__ void p0_prologue(LAS unsigned char* lds_, const Ptrs& P, int s_wave) {
    const Frame F = make_frame(lds_, s_wave);
    LAS float* scr = (LAS float*)(F.lds + RING_OFF + F.wave * 16384);
    const int gw = F.vcu * 8 + F.wave, NGW = F.G * 8;
    job_weights(P, 0, scr, gw, NGW, F.lane);
    { bf16_t* WSB = (bf16_t*)(P.ws + WS_WSB); const int gt = gw * 64 + F.lane, NT = NGW * 64;
      for (int e = gt; e < DEPTH * 6 * 128 * 64; e += NT) { const int s = (e & 63) * 2, t = (e >> 6) & 127; const f32x2 w = *(const f32x2*)(P.gws + (size_t)e * 2);
          *(unsigned*)(WSB + (size_t)e * 2) = cvtpk(s <= t ? w[0] : 0.f, s + 1 <= t ? w[1] : 0.f); } }
    { bf16_t* XB = (bf16_t*)(P.ws + WS_XB); float* xsq = (float*)(P.ws + WS_XSQ);
      for (int m0 = gw; m0 < M; m0 += 2 * NGW) {
          f32x4 v[2][4];
#pragma unroll
          for (int q = 0; q < 2; ++q) { const int m = m0 + q * NGW; if (m < M) { const float* src = m < MP ? P.xp + (size_t)m * DM : P.xs + (size_t)(m - MP) * DM;
#pragma unroll
              for (int j = 0; j < 4; ++j) v[q][j] = __builtin_nontemporal_load((const f32x4*)(src + 4 * F.lane + 256 * j)); } }
#pragma unroll
          for (int q = 0; q < 2; ++q) { const int m = m0 + q * NGW; if (m < M) { float s = 0.f;
#pragma unroll
              for (int j = 0; j < 4; ++j) { u32x2 w; w.x = cvtpk(v[q][j][0], v[q][j][1]); w.y = cvtpk(v[q][j][2], v[q][j][3]); *(u32x2*)(XB + (size_t)m * DM + 4 * F.lane + 256 * j) = w;
                  const float a = bflo(w.x), b = bfhi(w.x), c = bflo(w.y), d = bfhi(w.y); s += (a * a + b * b) + (c * c + d * d); }
              s = wave_sum(s);
              if (F.lane < 4) *(f32x4*)(xsq + (size_t)m * 16 + 4 * F.lane) = (f32x4){F.lane == 0 ? s : 0.f, 0.f, 0.f, 0.f}; } }
      } }
}
__device__ __forceinline__ void p1_workers(LAS unsigned char* lds_, const Ptrs& P, int l, int widx, int nworkers, int s_wave) {
    const Frame F = make_frame(lds_, s_wave);
    LAS float* scr = (LAS float*)(F.lds + RING_OFF + F.wave * 16384);
    if (l + 1 < DEPTH) job_weights(P, l + 1, scr, widx * 8 + F.wave, nworkers * 8, F.lane);
}

constexpr int AT_K = 0, AT_V = 24576, AT_BUF = 49152, AT_WS = 2 * AT_BUF, AT_OST = AT_WS + 2048;
constexpr int GM_VN = 0, GM_ST = 32768, GM_OST = 34816;
__device__ __forceinline__ f32x16 zero16() { float z = 0.f; asm volatile("" : "+v"(z)); f32x16 r;
#pragma unroll
    for (int i = 0; i < 16; ++i) r[i] = z;
    return r; }
__device__ __forceinline__ f32x16 mfma32(bf16x8 a, bf16x8 b, f32x16 c) { return __builtin_amdgcn_mfma_f32_32x32x16_bf16(a, b, c, 0, 0, 0); }
typedef short v4i16_t __attribute__((ext_vector_type(4)));
__device__ __forceinline__ s16x4 vtr(LAS const unsigned char* p) { return __builtin_bit_cast(s16x4, __builtin_amdgcn_ds_read_tr16_b64_v4i16((LAS v4i16_t*)p)); }
#define PK8(lo, hi) (bf16x8){lo[0], lo[1], lo[2], lo[3], hi[0], hi[1], hi[2], hi[3]}
__device__ __forceinline__ bf16x8 pack8(float a0, float a1, float a2, float a3, float a4, float a5, float a6, float a7) {
    u32x4 w; w.x = cvtpk(a0, a1); w.y = cvtpk(a2, a3); w.z = cvtpk(a4, a5); w.w = cvtpk(a6, a7); return __builtin_bit_cast(bf16x8, w); }

#ifndef MK_SM_PK
#define MK_SM_PK 1
#endif
__device__ __forceinline__ float softmax5(f32x16 (&p)[5], float sink2) {
    float m = sink2;
#pragma unroll
    for (int j = 0; j < 5; ++j)
#pragma unroll
        for (int r = 0; r < 16; ++r) m = fmaxf(m, p[j][r]);
    { auto rr = __builtin_amdgcn_permlane32_swap(__float_as_uint(m), __float_as_uint(m), false, false); m = fmaxf(__uint_as_float(rr[0]), __uint_as_float(rr[1])); }
    float l = 0.f;
#if MK_SM_PK
    { f32x2 l2 = {0.f, 0.f}; const f32x2 m2 = {m, m};
#pragma unroll
      for (int j = 0; j < 5; ++j)
#pragma unroll
          for (int r = 0; r < 16; r += 2) { const f32x2 d = (f32x2){p[j][r], p[j][r + 1]} - m2; f32x2 e; e[0] = __builtin_amdgcn_exp2f(d[0]); e[1] = __builtin_amdgcn_exp2f(d[1]); p[j][r] = e[0]; p[j][r + 1] = e[1]; l2 += e; }
      l = l2[0] + l2[1]; }
#else
#pragma unroll
    for (int j = 0; j < 5; ++j)
#pragma unroll
        for (int r = 0; r < 16; ++r) { p[j][r] = __builtin_amdgcn_exp2f(p[j][r] - m); l += p[j][r]; }
#endif
    { auto rr = __builtin_amdgcn_permlane32_swap(__float_as_uint(l), __float_as_uint(l), false, false); l = __uint_as_float(rr[0]) + __uint_as_float(rr[1]); }
    return l + __builtin_amdgcn_exp2f(sink2 - m);
}

__device__ __forceinline__ void attn_prompt_load(const Frame& F, const bf16_t* Z, int U, int bo, bf16x8 (&qr)[4]) {
    LAS unsigned char* lds = F.lds + bo;
    const int b = U >> 9, kvh = (U >> 7) & 3, qb = U & 127;
    const int lane = F.lane, wid = F.wave, r32 = lane & 31, hi = lane >> 5, g = wid >> 1, rh = wid & 1;
    const int pos0 = 64 * qb - 128; const size_t rowb = (size_t)b * SEQ;
#pragma unroll
    for (int tl = 0; tl < 3; ++tl) {
        int pk = pos0 + 64 * tl + lane; pk = pk < 0 ? 0 : pk;
        __builtin_amdgcn_global_load_lds((const unsigned*)(Z + (rowb + pk) * NIN + C_K + kvh * 64 + wid * 8), (LAS unsigned*)(lds + AT_K + tl * 8192 + wid * 1024), 16, 0, 0);
        int pv = pos0 + 64 * tl + 16 * (wid & 3) + (lane >> 2); pv = pv < 0 ? 0 : pv;
        __builtin_amdgcn_global_load_lds((const unsigned*)(Z + (rowb + pv) * NIN + C_V + kvh * 64 + (wid >> 2) * 32 + (lane & 3) * 8), (LAS unsigned*)(lds + AT_V + tl * 8192 + wid * 1024), 16, 0, 0);
    }
    const size_t qrow = rowb + 64 * qb + 32 * rh + r32;
#pragma unroll
    for (int d0 = 0; d0 < 4; ++d0) qr[d0] = *(const bf16x8*)(Z + qrow * NIN + C_Q + (kvh * 4 + g) * 64 + d0 * 16 + hi * 8);
}
__device__ __forceinline__ void attn_prompt_compute(const Frame& F, bf16_t* OS, float* owk, float* owv, const float* sinks_l, int U, int bo, const bf16x8 (&qr)[4]) {
    LAS unsigned char* lds = F.lds + bo;
    const int b = U >> 9, kvh = (U >> 7) & 3, qb = U & 127;
    const int lane = F.lane, wid = F.wave, r32 = lane & 31, hi = lane >> 5, g = wid >> 1, rh = wid & 1;
    const int pos0 = 64 * qb - 128; const size_t rowb = (size_t)b * SEQ;
    f32x16 p[5];
    const f32x16 Z0 = zero16();
    float ng_ = NEGBIG; asm volatile("" : "+v"(ng_));
#pragma unroll
    for (int j = 0; j < 5; ++j) {
        const int kbk = rh + j; LAS const unsigned char* kb = lds + AT_K + (kbk >> 1) * 8192 + hi * 1024 + ((kbk & 1) * 32 + r32) * 16;
        f32x16 a = Z0;
#pragma unroll
        for (int d0 = 0; d0 < 4; ++d0) a = mfma32(*(LAS const bf16x8*)(kb + d0 * 2048), qr[d0], a);
        p[j] = a;
    }
#pragma unroll
    for (int r = 0; r < 16; ++r) { const int cr = crow(r, hi); if (cr <= r32) p[0][r] = ng_; if (cr > r32) p[4][r] = ng_; }
    if (qb < 2) {
#pragma unroll
        for (int j = 0; j < 5; ++j)
#pragma unroll
            for (int r = 0; r < 16; ++r) if (pos0 + 32 * (rh + j) + crow(r, hi) < 0) p[j][r] = ng_;
    }
    const float l = softmax5(p, sinks_l[kvh * 4 + g] * LOG2E);
    f32x16 o0 = Z0, o1 = Z0;
    const int vlane = ((lane >> 4) & 1) * 32 + (lane & 3) * 8 + (4 * hi + ((lane & 15) >> 2)) * 64;
#pragma unroll
    for (int j = 0; j < 5; ++j) {
        const int kbk = rh + j;
#pragma unroll
        for (int s = 0; s < 2; ++s) {
            const bf16x8 pa = pack8(p[j][8 * s + 0], p[j][8 * s + 1], p[j][8 * s + 2], p[j][8 * s + 3], p[j][8 * s + 4], p[j][8 * s + 5], p[j][8 * s + 6], p[j][8 * s + 7]);
            LAS const unsigned char* vb = lds + AT_V + (kbk >> 1) * 8192 + (2 * (kbk & 1) + s) * 1024 + vlane;
            { const s16x4 lo = vtr(vb), hh = vtr(vb + 512); o0 = mfma32(pa, PK8(lo, hh), o0); }
            { const s16x4 lo = vtr(vb + 4096), hh = vtr(vb + 4096 + 512); o1 = mfma32(pa, PK8(lo, hh), o1); }
        }
    }
    LAS float* wsf = (LAS float*)(F.lds + AT_WS) + wid * 64;
    if (hi == 0) wsf[r32] = l;
    LDS_WAIT();
    LAS bf16_t* stg = (LAS bf16_t*)(F.lds + AT_OST) + wid * 2048;
#pragma unroll
    for (int r = 0; r < 16; ++r) { const int orow = crow(r, hi); const float rl = __builtin_amdgcn_rcpf(wsf[orow]);
        stg[orow * 64 + r32] = (bf16_t)(cvtpk(o0[r] * rl, 0.f) & 0xffffu); stg[orow * 64 + 32 + r32] = (bf16_t)(cvtpk(o1[r] * rl, 0.f) & 0xffffu); }
    LDS_WAIT();
    bf16_t* Ow = OS + (rowb + 64 * qb + 32 * rh) * KM + (kvh * 4 + g) * 64;
#pragma unroll
    for (int i = 0; i < 4; ++i) { const int row = i * 8 + (lane >> 3), ch = lane & 7; const u32x4 v = *(LAS const u32x4*)(stg + row * 64 + ch * 8); *(u32x4*)(Ow + (size_t)row * KM + ch * 8) = v; }
    if (qb >= 126) {
        const int row = F.tid & 63, c = F.tid >> 6, j = 64 * (qb - 126) + row;
        const u32x4 kk = *(LAS const u32x4*)(lds + AT_K + 2 * 8192 + c * 1024 + row * 16);
        const u32x4 vv = *(LAS const u32x4*)(lds + AT_V + 2 * 8192 + (c >> 2) * 4096 + (row >> 4) * 1024 + (row & 15) * 64 + (c & 3) * 16);
        float* dk = owk + ((size_t)(b * WIN + j)) * 256 + kvh * 64 + c * 8; float* dv = owv + ((size_t)(b * WIN + j)) * 256 + kvh * 64 + c * 8;
        *(f32x4*)dk = (f32x4){bflo(kk.x), bfhi(kk.x), bflo(kk.y), bfhi(kk.y)}; *(f32x4*)(dk + 4) = (f32x4){bflo(kk.z), bfhi(kk.z), bflo(kk.w), bfhi(kk.w)};
        *(f32x4*)dv = (f32x4){bflo(vv.x), bfhi(vv.x), bflo(vv.y), bfhi(vv.y)}; *(f32x4*)(dv + 4) = (f32x4){bflo(vv.z), bfhi(vv.z), bflo(vv.w), bfhi(vv.w)};
    }
}

constexpr int SA_K = 0, SA_V = 32768, SA_WS = 65536, SA_OST = 65536 + 2048;
__device__ __forceinline__ void sample_stage_kv(const Frame& F, const float* ck, const float* cv, float* owk, float* owv, int b, int hp) {
    LAS unsigned char* lds = F.lds;
    f32x4 kx[4][2], vx[4][2];
#pragma unroll
    for (int q = 0; q < 4; ++q) { const int idx = F.tid + 512 * q, key = idx >> 4, hl = (idx >> 3) & 1, c = idx & 7;
        const size_t off = ((size_t)(b * WIN + key) * 4 + 2 * hp + hl) * 64 + c * 8;
        kx[q][0] = *(const f32x4*)(ck + off); kx[q][1] = *(const f32x4*)(ck + off + 4); vx[q][0] = *(const f32x4*)(cv + off); vx[q][1] = *(const f32x4*)(cv + off + 4); }
#pragma unroll
    for (int q = 0; q < 4; ++q) { const int idx = F.tid + 512 * q, key = idx >> 4, hl = (idx >> 3) & 1, c = idx & 7;
        u32x4 wk, wv; wk.x = cvtpk(kx[q][0][0], kx[q][0][1]); wk.y = cvtpk(kx[q][0][2], kx[q][0][3]); wk.z = cvtpk(kx[q][1][0], kx[q][1][1]); wk.w = cvtpk(kx[q][1][2], kx[q][1][3]);
        wv.x = cvtpk(vx[q][0][0], vx[q][0][1]); wv.y = cvtpk(vx[q][0][2], vx[q][0][3]); wv.z = cvtpk(vx[q][1][0], vx[q][1][1]); wv.w = cvtpk(vx[q][1][2], vx[q][1][3]);
        *(LAS u32x4*)(lds + SA_K + hl * 16384 + (key >> 6) * 8192 + c * 1024 + (key & 63) * 16) = wk;
        *(LAS u32x4*)(lds + SA_V + hl * 16384 + (key >> 6) * 8192 + (c >> 2) * 4096 + ((key & 63) >> 4) * 1024 + (key & 15) * 64 + (c & 3) * 16) = wv;
        if (key >= 8) {
            const size_t oo = ((size_t)(b * WIN + key - 8) * 4 + 2 * hp + hl) * 64 + c * 8;
            *(f32x4*)(owk + oo) = kx[q][0]; *(f32x4*)(owk + oo + 4) = kx[q][1]; *(f32x4*)(owv + oo) = vx[q][0]; *(f32x4*)(owv + oo + 4) = vx[q][1]; } }
}
__device__ __forceinline__ void attn_sample_wave(const Frame& F, const bf16_t* Z, bf16_t* OS, float* owk, float* owv, const float* sinks_l, int b, int kvh, int hl) {
    LAS unsigned char* lds = F.lds;
    const int lane = F.lane, wid = F.wave, r32 = lane & 31, hi = lane >> 5, g = r32 >> 3, qi = r32 & 7;
    const size_t qrow = (size_t)MP + b * 8 + qi;
    bf16x8 qr[4];
#pragma unroll
    for (int d0 = 0; d0 < 4; ++d0) qr[d0] = *(const bf16x8*)(Z + qrow * NIN + C_Q + (kvh * 4 + g) * 64 + d0 * 16 + hi * 8);
    f32x16 p[5];
    float ng_ = NEGBIG; asm volatile("" : "+v"(ng_));
#pragma unroll
    for (int j = 0; j < 4; ++j) {
        LAS const unsigned char* kb = lds + SA_K + hl * 16384 + (j >> 1) * 8192 + hi * 1024 + ((j & 1) * 32 + r32) * 16;
        f32x16 a = zero16();
#pragma unroll
        for (int d0 = 0; d0 < 4; ++d0) a = mfma32(*(LAS const bf16x8*)(kb + d0 * 2048), qr[d0], a);
        p[j] = a;
    }
    { const size_t krow = (size_t)MP + b * 8 + (r32 < 8 ? r32 : 7); f32x16 a = zero16();
#pragma unroll
      for (int d0 = 0; d0 < 4; ++d0) a = mfma32(*(const bf16x8*)(Z + krow * NIN + C_K + kvh * 64 + d0 * 16 + hi * 8), qr[d0], a);
      p[4] = a; }
#pragma unroll
    for (int r = 0; r < 16; ++r) { const int cr = crow(r, hi); if (cr <= qi) p[0][r] = ng_; if (cr > qi) p[4][r] = ng_; }
    const float l = softmax5(p, sinks_l[kvh * 4 + g] * LOG2E);
    f32x16 o0 = zero16(), o1 = zero16();
    const int vlane = ((lane >> 4) & 1) * 32 + (lane & 3) * 8 + (4 * hi + ((lane & 15) >> 2)) * 64;
#pragma unroll
    for (int j = 0; j < 4; ++j)
#pragma unroll
        for (int s = 0; s < 2; ++s) {
            const bf16x8 pa = pack8(p[j][8 * s + 0], p[j][8 * s + 1], p[j][8 * s + 2], p[j][8 * s + 3], p[j][8 * s + 4], p[j][8 * s + 5], p[j][8 * s + 6], p[j][8 * s + 7]);
            LAS const unsigned char* vb = lds + SA_V + hl * 16384 + (j >> 1) * 8192 + (2 * (j & 1) + s) * 1024 + vlane;
            { const s16x4 lo = vtr(vb), hh = vtr(vb + 512); o0 = mfma32(pa, PK8(lo, hh), o0); }
            { const s16x4 lo = vtr(vb + 4096), hh = vtr(vb + 4096 + 512); o1 = mfma32(pa, PK8(lo, hh), o1); }
        }
    { const bf16x8 pa = pack8(p[4][0], p[4][1], p[4][2], p[4][3], p[4][4], p[4][5], p[4][6], p[4][7]);
      const bf16_t* vp = Z + ((size_t)MP + b * 8 + 4 * hi) * NIN + C_V + kvh * 64 + r32;
      u32x4 x = {0u, 0u, 0u, 0u}, y = {0u, 0u, 0u, 0u};
      x.x = (unsigned)vp[0] | ((unsigned)vp[NIN] << 16); x.y = (unsigned)vp[2 * NIN] | ((unsigned)vp[3 * NIN] << 16);
      y.x = (unsigned)vp[32] | ((unsigned)vp[NIN + 32] << 16); y.y = (unsigned)vp[2 * NIN + 32] | ((unsigned)vp[3 * NIN + 32] << 16);
      o0 = mfma32(pa, __builtin_bit_cast(bf16x8, x), o0); o1 = mfma32(pa, __builtin_bit_cast(bf16x8, y), o1); }
    LAS float* wsf = (LAS float*)(lds + SA_WS) + wid * 64;
    if (hi == 0) wsf[r32] = l;
    LDS_WAIT();
    LAS bf16_t* stg = (LAS bf16_t*)(lds + SA_OST) + wid * 2048;
#pragma unroll
    for (int r = 0; r < 16; ++r) { const int orow = crow(r, hi); const float rl = __builtin_amdgcn_rcpf(wsf[orow]);
        stg[orow * 64 + r32] = (bf16_t)(cvtpk(o0[r] * rl, 0.f) & 0xffffu); stg[orow * 64 + 32 + r32] = (bf16_t)(cvtpk(o1[r] * rl, 0.f) & 0xffffu); }
    LDS_WAIT();
#pragma unroll
    for (int i = 0; i < 4; ++i) { const int row = i * 8 + (lane >> 3), ch = lane & 7; const u32x4 v = *(LAS const u32x4*)(stg + row * 64 + ch * 8);
        *(u32x4*)(OS + ((size_t)MP + b * 8 + (row & 7)) * KM + (kvh * 4 + (row >> 3)) * 64 + ch * 8) = v; }
    { const int i = lane >> 3, c = (lane & 7) * 8; const bf16_t* zr = Z + ((size_t)MP + b * 8 + i) * NIN + kvh * 64 + c;
      const u32x4 kk = *(const u32x4*)(zr + C_K), vv = *(const u32x4*)(zr + C_V);
      float* dk = owk + ((size_t)(b * WIN + 120 + i)) * 256 + kvh * 64 + c; float* dv = owv + ((size_t)(b * WIN + 120 + i)) * 256 + kvh * 64 + c;
      *(f32x4*)dk = (f32x4){bflo(kk.x), bfhi(kk.x), bflo(kk.y), bfhi(kk.y)}; *(f32x4*)(dk + 4) = (f32x4){bflo(kk.z), bfhi(kk.z), bflo(kk.w), bfhi(kk.w)};
      *(f32x4*)dv = (f32x4){bflo(vv.x), bfhi(vv.x), bflo(vv.y), bfhi(vv.y)}; *(f32x4*)(dv + 4) = (f32x4){bflo(vv.z), bfhi(vv.z), bflo(vv.w), bfhi(vv.w)}; }
}

__device__ __forceinline__ void gmlp_prompt_unit(const Frame& F, const bf16_t* Z, bf16_t* OS, const float* gvst, const float* lng, const float* lnb, const bf16_t* wsb_l, const float* bs_l, int b, int ch, int g) {
    LAS unsigned char* lds = F.lds;
    const int tid = F.tid, lane = F.lane, wid = F.wave, r32 = lane & 31, hi = lane >> 5, tb = wid >> 1, chh = wid & 1;
    const size_t R0 = (size_t)b * SEQ + 128 * ch;
    LAS f32x2* st = (LAS f32x2*)(lds + GM_ST);
    f32x4 sp[6];
    if (tid < 128) { const float* pp = gvst + (R0 + tid) * 24;
#pragma unroll
        for (int k = 0; k < 6; ++k) sp[k] = *(const f32x4*)(pp + 4 * k); }
    const int c8 = (tid & 15) * 8;
    u32x4 xg[4];
#pragma unroll
    for (int it = 0; it < 4; ++it) xg[it] = *(const u32x4*)(Z + (R0 + (tid >> 4) + 32 * it) * NIN + C_GV + 128 * g + c8);
    const f32x4 g0 = *(const f32x4*)(lng + 128 * g + c8), g1 = *(const f32x4*)(lng + 128 * g + c8 + 4), b0 = *(const f32x4*)(lnb + 128 * g + c8), b1 = *(const f32x4*)(lnb + 128 * g + c8 + 4);
    const int nks = 2 * (tb + 1);
    bf16x8 wf[8];
    { const bf16_t* wrow = wsb_l + ((size_t)g * 128 + 32 * tb + r32) * 128 + 8 * hi;
#pragma unroll
      for (int ks = 0; ks < 8; ++ks) if (ks < nks) wf[ks] = *(const bf16x8*)(wrow + 16 * ks); }
    u32x4 gu[4];
#pragma unroll
    for (int i = 0; i < 4; ++i) gu[i] = *(const u32x4*)(Z + (R0 + 32 * tb + i * 8 + (lane >> 3)) * NIN + C_GU + 128 * g + 64 * chh + (lane & 7) * 8);
    float bsv[16];
#pragma unroll
    for (int r = 0; r < 16; ++r) bsv[r] = bs_l[g * 128 + 32 * tb + crow(r, hi)];
    if (tid < 128) { float s1 = 0.f, s2 = 0.f;
#pragma unroll
        for (int k = 0; k < 6; ++k) { s1 += sp[k][0] + sp[k][2]; s2 += sp[k][1] + sp[k][3]; }
        const float mean = s1 * (1.0f / GW), var = fmaxf(s2 * (1.0f / GW) - mean * mean, 0.f); st[tid] = (f32x2){mean, __builtin_amdgcn_rsqf(var + EPS)}; }
    __syncthreads();
#pragma unroll
    for (int it = 0; it < 4; ++it) {
        const int s = (tid >> 4) + 32 * it; const u32x4 x = xg[it];
        const f32x2 ms = st[s];
        const float v0 = (bflo(x.x) - ms[0]) * ms[1] * g0[0] + b0[0], v1 = (bfhi(x.x) - ms[0]) * ms[1] * g0[1] + b0[1], v2 = (bflo(x.y) - ms[0]) * ms[1] * g0[2] + b0[2], v3 = (bfhi(x.y) - ms[0]) * ms[1] * g0[3] + b0[3];
        const float v4 = (bflo(x.z) - ms[0]) * ms[1] * g1[0] + b1[0], v5 = (bfhi(x.z) - ms[0]) * ms[1] * g1[1] + b1[1], v6 = (bflo(x.w) - ms[0]) * ms[1] * g1[2] + b1[2], v7 = (bfhi(x.w) - ms[0]) * ms[1] * g1[3] + b1[3];
        u32x4 w; w.x = cvtpk(v0, v1); w.y = cvtpk(v2, v3); w.z = cvtpk(v4, v5); w.w = cvtpk(v6, v7);
        *(LAS u32x4*)(lds + GM_VN + ((c8 >> 5) * 8 + (s >> 4)) * 1024 + (s & 15) * 64 + (c8 & 31) * 2) = w;
    }
    __syncthreads();
    f32x16 a0 = zero16(), a1 = zero16();
    const int vlane = ((lane >> 4) & 1) * 32 + (lane & 3) * 8 + (8 * hi + ((lane & 15) >> 2)) * 64;
#pragma unroll
    for (int ks = 0; ks < 8; ++ks) if (ks < nks) {
        LAS const unsigned char* vb = lds + GM_VN + ((2 * chh) * 8 + ks) * 1024 + vlane;
        { const s16x4 lo = vtr(vb), hh = vtr(vb + 256); a0 = mfma32(wf[ks], PK8(lo, hh), a0); }
        { const s16x4 lo = vtr(vb + 8192), hh = vtr(vb + 8192 + 256); a1 = mfma32(wf[ks], PK8(lo, hh), a1); }
    }
    LAS bf16_t* stg = (LAS bf16_t*)(lds + GM_OST) + wid * 2048;
#pragma unroll
    for (int r = 0; r < 16; ++r) { const int orow = crow(r, hi);
        stg[orow * 64 + r32] = (bf16_t)(cvtpk(a0[r] + bsv[r], 0.f) & 0xffffu); stg[orow * 64 + 32 + r32] = (bf16_t)(cvtpk(a1[r] + bsv[r], 0.f) & 0xffffu); }
    LDS_WAIT();
#pragma unroll
    for (int i = 0; i < 4; ++i) { const int row = i * 8 + (lane >> 3), cc = (lane & 7) * 8; const u32x4 mx = *(LAS const u32x4*)(stg + row * 64 + cc);
        const size_t grow = R0 + 32 * tb + row; const u32x4 q = gu[i];
        u32x4 w; w.x = cvtpk(bflo(mx.x) * bflo(q.x), bfhi(mx.x) * bfhi(q.x)); w.y = cvtpk(bflo(mx.y) * bflo(q.y), bfhi(mx.y) * bfhi(q.y));
        w.z = cvtpk(bflo(mx.z) * bflo(q.z), bfhi(mx.z) * bfhi(q.z)); w.w = cvtpk(bflo(mx.w) * bflo(q.w), bfhi(mx.w) * bfhi(q.w));
        *(u32x4*)(OS + grow * KM + 1024 + 128 * g + 64 * chh + cc) = w; }
}

__device__ __forceinline__ void gmlp_sample_wave(const Frame& F, const bf16_t* Z, bf16_t* OS, const float* gvst, const float* lng, const float* lnb, const float* gws_l, const float* bs_l, float* ogv, int b, int c0) {
    const int lane = F.lane; const size_t R0 = (size_t)MP + b * 8;
    const int c = c0 + lane, g = c0 >> 7;
    unsigned short xv[8], xu[8];
#pragma unroll
    for (int i = 0; i < 8; ++i) { xv[i] = Z[(R0 + i) * NIN + C_GV + c]; xu[i] = Z[(R0 + i) * NIN + C_GU + c]; }
    float mean = 0.f, rstd = 0.f;
    { const float* pp = gvst + (R0 + (lane & 7)) * 24; float s1 = 0.f, s2 = 0.f;
#pragma unroll
      for (int k = 0; k < 6; ++k) { const f32x4 v = *(const f32x4*)(pp + 4 * k); s1 += v[0] + v[2]; s2 += v[1] + v[3]; }
      mean = s1 * (1.0f / GW); const float var = fmaxf(s2 * (1.0f / GW) - mean * mean, 0.f); rstd = __builtin_amdgcn_rsqf(var + EPS); }
    const float gg = lng[c], bb = lnb[c];
    float vn[8];
#pragma unroll
    for (int i = 0; i < 8; ++i) { const float mu = __uint_as_float(__builtin_amdgcn_readlane(__float_as_uint(mean), i)), rs = __uint_as_float(__builtin_amdgcn_readlane(__float_as_uint(rstd), i)); vn[i] = (bflo((unsigned)xv[i]) - mu) * rs * gg + bb; ogv[((size_t)b * 8 + i) * GW + c] = vn[i]; }
#pragma unroll
    for (int t = 0; t < 8; ++t) { float mx = bs_l[g * 128 + t];
#pragma unroll
        for (int s = 0; s <= t; ++s) mx += gws_l[(size_t)g * 16384 + t * 128 + s] * vn[s];
        OS[(R0 + t) * KM + 1024 + c] = (bf16_t)(cvtpk(bflo((unsigned)xu[t]) * mx, 0.f) & 0xffffu); }
}

__device__ __forceinline__ void p2_mixer(LAS unsigned char* lds_, const Ptrs& P, int l, int s_wave) {
    const Frame F = make_frame(lds_, s_wave);
    const bf16_t* Z = (const bf16_t*)(P.ws + WS_RA); bf16_t* OS = (bf16_t*)(P.ws + WS_RB); const float* gvst = (const float*)(P.ws + WS_GVST);
    const bf16_t* wsb_l = (const bf16_t*)(P.ws + WS_WSB) + (size_t)l * 6 * 16384;
    const float* sinks_l = P.sinks + l * 16; const float* lng = P.lng + l * GW; const float* lnb = P.lnb + l * GW; const float* bs_l = P.gbs + l * GW; const float* gws_l = P.gws + (size_t)l * 6 * 16384;
    float* owkp = P.out + O_WKP + (size_t)l * NB * WIN * 256; float* owvp = P.out + O_WVP + (size_t)l * NB * WIN * 256;
    float* owks = P.out + O_WKS + (size_t)l * SB * WIN * 256; float* owvs = P.out + O_WVS + (size_t)l * SB * WIN * 256;
    const float* ck = P.ck + (size_t)l * SB * WIN * 256; const float* cv = P.cv + (size_t)l * SB * WIN * 256; float* ogv = P.out + O_GVS + (size_t)l * SB * 8 * GW;
    constexpr int NU = 1024 + 768 + 256;
#ifndef MK_P2_REPS
#define MK_P2_REPS 1
#define MK_P2_CLASS 0
#endif
    for (int prep_ = 0; prep_ < MK_P2_REPS; ++prep_) {
    if (prep_ == 0 || (MK_P2_CLASS & 1)) {
        int U = F.vcu, bo = 0; bf16x8 qc[4], qn[4];
        __syncthreads();
#ifndef MK_P2X
#define MK_P2X 0
#endif
        constexpr int ALIM = (MK_P2X & 1) ? 2048 : 1024;
        if (U < ALIM) attn_prompt_load(F, Z, U & 1023, bo, qc);
        while (U < ALIM) {
            const int Un = U + F.G;
            VM_WAIT(); __syncthreads();
            if (Un < ALIM) attn_prompt_load(F, Z, Un & 1023, bo ^ AT_BUF, qn);
            attn_prompt_compute(F, OS, owkp, owvp, sinks_l, U & 1023, bo, qc);
#pragma unroll
            for (int d0 = 0; d0 < 4; ++d0) qc[d0] = qn[d0];
            U = Un; bo ^= AT_BUF;
        }
    }
    for (int U_ = F.vcu + ((1024 - F.vcu + F.G - 1) / F.G) * F.G; U_ < NU + ((MK_P2X & 2) ? 768 : (MK_P2X & 4) ? 256 : 0); U_ += F.G) {
        const int U = U_ < NU ? U_ : ((MK_P2X & 2) ? U_ - 1024 : U_ - 256);
        if (prep_ > 0) { const int cls = U < 1792 ? 2 : 4; if (!(cls & MK_P2_CLASS)) continue; }
        __syncthreads();
        if (false) {}
        else if (U < 1792) { const int V = U - 1024; gmlp_prompt_unit(F, Z, OS, gvst, lng, lnb, wsb_l, bs_l, V / 384, (V / 6) % 64, V % 6); }
        else { const int V = U - 1792, b = V >> 1, hp = V & 1;
            sample_stage_kv(F, ck, cv, owks, owvs, b, hp);
            LDS_WAIT(); __syncthreads();
            if (F.wave < 2) attn_sample_wave(F, Z, OS, owks, owvs, sinks_l, b, 2 * hp + F.wave, F.wave);
            else gmlp_sample_wave(F, Z, OS, gvst, lng, lnb, gws_l, bs_l, ogv, b, 384 * hp + 64 * (F.wave - 2)); }
    }
    }
}

__device__ __forceinline__ void ld8(const bf16_t* p, float (&v)[8]) { const u32x4 x = *(const u32x4*)p; v[0] = bflo(x.x); v[1] = bfhi(x.x); v[2] = bflo(x.y); v[3] = bfhi(x.y); v[4] = bflo(x.z); v[5] = bfhi(x.z); v[6] = bflo(x.w); v[7] = bfhi(x.w); }
__device__ __forceinline__ void ld8f(const float* p, float (&v)[8]) { const f32x4 a = *(const f32x4*)p, b = *(const f32x4*)(p + 4); v[0] = a[0]; v[1] = a[1]; v[2] = a[2]; v[3] = a[3]; v[4] = b[0]; v[5] = b[1]; v[6] = b[2]; v[7] = b[3]; }
__device__ __forceinline__ void st8f(float* p, const float (&v)[8]) { *(f32x4*)p = (f32x4){v[0], v[1], v[2], v[3]}; *(f32x4*)(p + 4) = (f32x4){v[4], v[5], v[6], v[7]}; }
__device__ __forceinline__ void st8f_nt(float* p, const float (&v)[8]) { __builtin_nontemporal_store((f32x4){v[0], v[1], v[2], v[3]}, (f32x4*)p); __builtin_nontemporal_store((f32x4){v[4], v[5], v[6], v[7]}, (f32x4*)(p + 4)); }
__device__ __forceinline__ void cv8(const u32x4 x, float (&v)[8]) { v[0] = bflo(x.x); v[1] = bfhi(x.x); v[2] = bflo(x.y); v[3] = bfhi(x.y); v[4] = bflo(x.z); v[5] = bfhi(x.z); v[6] = bflo(x.w); v[7] = bfhi(x.w); }
__device__ __forceinline__ u32x4 pk8f(const float* p) { const f32x4 a = *(const f32x4*)p, b = *(const f32x4*)(p + 4); u32x4 w; w.x = cvtpk(a[0], a[1]); w.y = cvtpk(a[2], a[3]); w.z = cvtpk(b[0], b[1]); w.w = cvtpk(b[2], b[3]); return w; }
__device__ __forceinline__ void p7_pre(LAS unsigned char* lds_, const Ptrs& P, int l, int pm_lo, int pm_hi, int s_wave) {
    const Frame F = make_frame(lds_, s_wave);
    const bf16_t* Z2 = (const bf16_t*)(P.ws + WS_RA); bf16_t* G = (bf16_t*)(P.ws + WS_RB); const float* HT = (const float*)(P.ws + WS_RA);
    const float* cw = P.cw + (size_t)l * 3 * NUP; const float* cb = P.cb + (size_t)l * NUP; const float* sc = P.sc + (size_t)l * SB * 2 * NUP;
    float* ocs = P.out + O_CVS + (size_t)l * SB * 2 * NUP;
    if (F.tid < 352) {
    const int c = F.tid * 8;
    float wa[3][8], wb[3][8], ba[8], bb[8];
#pragma unroll
    for (int j = 0; j < 3; ++j) { ld8f(cw + j * NUP + c, wa[j]); ld8f(cw + j * NUP + DFF + c, wb[j]); }
    ld8f(cb + c, ba); ld8f(cb + DFF + c, bb);
    for (int pm = pm_lo; pm < pm_hi; ++pm)
    for (int part = 0; part < 3; ++part) {
        if (part < 2) { const int U = 2 * pm + part;
            const int r0 = MP + U * 8;
            u32x4 ra[10], rb[10];
#pragma unroll
            for (int i = 2; i < 10; ++i) { ra[i] = *(const u32x4*)(Z2 + (size_t)(r0 + i - 2) * NUP + c); rb[i] = *(const u32x4*)(Z2 + (size_t)(r0 + i - 2) * NUP + DFF + c); }
            { const float* s0 = sc + (size_t)U * 2 * NUP; ra[0] = pk8f(s0 + c); ra[1] = pk8f(s0 + NUP + c); rb[0] = pk8f(s0 + DFF + c); rb[1] = pk8f(s0 + NUP + DFF + c); }
#pragma unroll
            for (int i = 2; i < 10; ++i) {
                float a2[8], a1[8], a0[8], b2[8], b1[8], b0[8], o[8];
                cv8(ra[i - 2], a2); cv8(ra[i - 1], a1); cv8(ra[i], a0); cv8(rb[i - 2], b2); cv8(rb[i - 1], b1); cv8(rb[i], b0);
#pragma unroll
                for (int e = 0; e < 8; ++e) { const float ca = ba[e] + wa[0][e] * a2[e] + wa[1][e] * a1[e] + wa[2][e] * a0[e], cbv = bb[e] + wb[0][e] * b2[e] + wb[1][e] * b1[e] + wb[2][e] * b0[e]; o[e] = gelu_t(ca) * cbv; }
                u32x4 w; w.x = cvtpk(o[0], o[1]); w.y = cvtpk(o[2], o[3]); w.z = cvtpk(o[4], o[5]); w.w = cvtpk(o[6], o[7]);
                *(u32x4*)(G + (size_t)(r0 + i - 2) * DFF + c) = w;
            }
            float* d = ocs + (size_t)U * 2 * NUP;
#pragma unroll
            for (int j = 0; j < 2; ++j) { float va[8], vb[8]; cv8(ra[8 + j], va); cv8(rb[8 + j], vb); st8f(d + j * NUP + c, va); st8f(d + j * NUP + DFF + c, vb); }
        } else if ((pm & 31) != 0) {
            float t0a[8], t1a[8], h0a[8], h1a[8], t0b[8], t1b[8], h0b[8], h1b[8];
            const float* tp = HT + ((size_t)(pm - 1) * 4 + 2) * NUP; const float* hp = HT + (size_t)pm * 4 * NUP;
            ld8f(tp + c, t0a); ld8f(tp + NUP + c, t1a); ld8f(hp + c, h0a); ld8f(hp + NUP + c, h1a);
            ld8f(tp + DFF + c, t0b); ld8f(tp + NUP + DFF + c, t1b); ld8f(hp + DFF + c, h0b); ld8f(hp + NUP + DFF + c, h1b);
            float o0[8], o1[8];
#pragma unroll
            for (int e = 0; e < 8; ++e) {
                const float ca0 = ba[e] + wa[0][e] * t0a[e] + wa[1][e] * t1a[e] + wa[2][e] * h0a[e], cb0 = bb[e] + wb[0][e] * t0b[e] + wb[1][e] * t1b[e] + wb[2][e] * h0b[e];
                const float ca1 = ba[e] + wa[0][e] * t1a[e] + wa[1][e] * h0a[e] + wa[2][e] * h1a[e], cb1 = bb[e] + wb[0][e] * t1b[e] + wb[1][e] * h0b[e] + wb[2][e] * h1b[e];
                o0[e] = gelu_t(ca0) * cb0; o1[e] = gelu_t(ca1) * cb1; }
            u32x4 w; w.x = cvtpk(o0[0], o0[1]); w.y = cvtpk(o0[2], o0[3]); w.z = cvtpk(o0[4], o0[5]); w.w = cvtpk(o0[6], o0[7]);
            *(u32x4*)(G + (size_t)(pm * 256) * DFF + c) = w;
            w.x = cvtpk(o1[0], o1[1]); w.y = cvtpk(o1[2], o1[3]); w.z = cvtpk(o1[4], o1[5]); w.w = cvtpk(o1[6], o1[7]);
            *(u32x4*)(G + (size_t)(pm * 256 + 1) * DFF + c) = w;
        }
    }
}
}

__device__ __forceinline__ void p_final(LAS unsigned char* lds_, const Ptrs& P, int s_wave) {
    const Frame F = make_frame(lds_, s_wave);
    float* Y = P.out + O_Y; const bf16_t* XB = (const bf16_t*)(P.ws + WS_XB); const float* xsq = (const float*)(P.ws + WS_XSQ);
    const int gw = F.vcu * 8 + F.wave, NGW = F.G * 8;
    float gn[2][8];
#pragma unroll
    for (int j = 0; j < 2; ++j) ld8f(P.nfin + 8 * F.lane + 512 * j, gn[j]);
    for (int m = gw; m < M; m += NGW) {
        float s = 0.f;
        { const f32x4 a = *(const f32x4*)(xsq + (size_t)m * 16 + 4 * (F.lane & 3)); s = (a[0] + a[1]) + (a[2] + a[3]); s = xadd<1>(s); s = xadd<2>(s); }
        const float rs = __builtin_amdgcn_rsqf(s * (1.0f / DM) + EPS);
#pragma unroll
        for (int j = 0; j < 2; ++j) { float v[8]; ld8(XB + (size_t)m * DM + 8 * F.lane + 512 * j, v);
#pragma unroll
            for (int e = 0; e < 8; ++e) v[e] = v[e] * rs * gn[j][e];
            st8f_nt(Y + (size_t)m * DM + 8 * F.lane + 512 * j, v); }
    }
}

struct SFrag { bf16x8 a[4], b[4]; };
__device__ __forceinline__ void small_ld(SFrag& f, const bf16_t* ap, const bf16_t* bp, size_t lda16, size_t ldb16) {
#pragma unroll
    for (int i = 0; i < 4; ++i) { f.a[i] = *(const bf16x8*)(ap + i * lda16); f.b[i] = *(const bf16x8*)(bp + i * ldb16); }
}
__device__ __forceinline__ void small_mma(f32x4 (&acc)[4][4], const SFrag& f) {
#pragma unroll
    for (int i = 0; i < 4; ++i)
#pragma unroll
        for (int j = 0; j < 4; ++j) acc[i][j] = __builtin_amdgcn_mfma_f32_16x16x32_bf16(f.a[i], f.b[j], acc[i][j], 0, 0, 0);
}
__device__ __forceinline__ void small_kslice(f32x4 (&acc)[4][4], const bf16_t* A, int lda, const bf16_t* Bt, int ldb, int k0, int nks, int lane) {
    const bf16_t* ap = A + (size_t)(lane & 15) * lda + k0 + 8 * (lane >> 4); const bf16_t* bp = Bt + (size_t)(lane & 15) * ldb + k0 + 8 * (lane >> 4);
    const size_t lda16 = (size_t)16 * lda, ldb16 = (size_t)16 * ldb;
    for (int s = 0; s < nks; s += 4) {
        SFrag f0, f1, f2, f3;
        small_ld(f0, ap + 32 * s, bp + 32 * s, lda16, ldb16);
        if (s + 1 < nks) small_ld(f1, ap + 32 * (s + 1), bp + 32 * (s + 1), lda16, ldb16);
        if (s + 2 < nks) small_ld(f2, ap + 32 * (s + 2), bp + 32 * (s + 2), lda16, ldb16);
        if (s + 3 < nks) small_ld(f3, ap + 32 * (s + 3), bp + 32 * (s + 3), lda16, ldb16);
        __builtin_amdgcn_sched_barrier(0);
        small_mma(acc, f0);
        if (s + 1 < nks) small_mma(acc, f1);
        if (s + 2 < nks) small_mma(acc, f2);
        if (s + 3 < nks) small_mma(acc, f3);
    }
}
__device__ __forceinline__ void small_zero(f32x4 (&acc)[4][4]) { float z = 0.f; asm volatile("" : "+v"(z));
#pragma unroll
    for (int i = 0; i < 4; ++i)
#pragma unroll
        for (int j = 0; j < 4; ++j) acc[i][j] = (f32x4){z, z, z, z}; }
__device__ __forceinline__ void small_reduce(LAS unsigned char* ring, const f32x4 (&acc)[4][4], const Frame& F, float (&out)[8]) {
    LAS float* slab = (LAS float*)(ring + F.wave * 16384);
    const int rq = 4 * (F.lane >> 4), cl = F.lane & 15;
#pragma unroll
    for (int i = 0; i < 4; ++i)
#pragma unroll
        for (int j = 0; j < 4; ++j)
#pragma unroll
            for (int r = 0; r < 4; ++r) slab[(16 * i + rq + r) * 64 + 16 * j + cl] = acc[i][j][r];
    LDS_WAIT(); __syncthreads();
    const int row = F.tid >> 3, c8 = (F.tid & 7) * 8;
#pragma unroll
    for (int e = 0; e < 8; ++e) out[e] = 0.f;
#pragma unroll
    for (int w = 0; w < 8; ++w) { const f32x4 x = *(LAS const f32x4*)(ring + w * 16384 + (row * 64 + c8) * 4), y = *(LAS const f32x4*)(ring + w * 16384 + (row * 64 + c8) * 4 + 16);
        out[0] += x[0]; out[1] += x[1]; out[2] += x[2]; out[3] += x[3]; out[4] += y[0]; out[5] += y[1]; out[6] += y[2]; out[7] += y[3]; }
    LDS_WAIT(); __syncthreads();
}
__device__ __forceinline__ void small_resid(LAS unsigned char* lds_, const bf16_t* A, int K, const bf16_t* Bt, bf16_t* XB, float* xsq, int s_wave) {
    const Frame F = make_frame(lds_, s_wave);
    for (int t = F.vcu; t < 256; t += F.G) {
        const int rb = 4 * (t >> 6) + ((t >> 3) & 3), cb = 8 * ((t >> 5) & 1) + (t & 7);
        f32x4 acc[4][4]; small_zero(acc);
        small_kslice(acc, A + (size_t)(MP + 64 * rb) * K, K, Bt + (size_t)(64 * cb) * K, K, F.wave * (K / 8), K / 256, F.lane);
        float o[8]; small_reduce(lds_ + RING_OFF, acc, F, o);
        const int row = MP + 64 * rb + (F.tid >> 3), c8 = 64 * cb + (F.tid & 7) * 8;
        float xo[8]; ld8(XB + (size_t)row * DM + c8, xo);
        u32x4 w; float ss = 0.f;
        { const unsigned r0 = cvtpk(xo[0] + o[0], xo[1] + o[1]), r1 = cvtpk(xo[2] + o[2], xo[3] + o[3]), r2 = cvtpk(xo[4] + o[4], xo[5] + o[5]), r3 = cvtpk(xo[6] + o[6], xo[7] + o[7]);
          w.x = r0; w.y = r1; w.z = r2; w.w = r3;
          ss = (bflo(r0) * bflo(r0) + bfhi(r0) * bfhi(r0)) + (bflo(r1) * bflo(r1) + bfhi(r1) * bfhi(r1)) + (bflo(r2) * bflo(r2) + bfhi(r2) * bfhi(r2)) + (bflo(r3) * bflo(r3) + bfhi(r3) * bfhi(r3)); }
        *(u32x4*)(XB + (size_t)row * DM + c8) = w;
        ss = xadd<1>(ss); ss = xadd<2>(ss); ss = xadd<4>(ss);
        if ((F.tid & 7) == 0) xsq[(size_t)row * 16 + cb] = ss;
    }
}
__device__ __forceinline__ void small_merge(LAS unsigned char* lds_, const bf16_t* OS, const bf16_t* WMl, const bf16_t* Z, bf16_t* MG, int s_wave) {
    const Frame F = make_frame(lds_, s_wave);
    for (int t = F.vcu; t < 256; t += F.G) {
        const int rb = 4 * (t >> 6) + ((t >> 3) & 3), cb = 8 * ((t >> 5) & 1) + (t & 7);
        const bf16_t* A = OS + (size_t)(MP + 64 * rb) * KM; const bf16_t* Bt = WMl + (size_t)(64 * cb) * KM;
        float o[8], s[8];
        { f32x4 acc[4][4]; small_zero(acc); small_kslice(acc, A, KM, Bt, KM, F.wave * 128, 4, F.lane); small_reduce(lds_ + RING_OFF, acc, F, o); }
        { f32x4 acc[4][4]; small_zero(acc); small_kslice(acc, A, KM, Bt, KM, 1024 + F.wave * 96, 3, F.lane); small_reduce(lds_ + RING_OFF, acc, F, s); }
        const int row = MP + 64 * rb + (F.tid >> 3), c8 = 64 * cb + (F.tid & 7) * 8;
        float ga[8], gb[8]; { const int gc = C_GA + 256 * (c8 >> 7) + (c8 & 127); ld8(Z + (size_t)row * NIN + gc, ga); ld8(Z + (size_t)row * NIN + gc + 128, gb); }
        u32x4 w; w.x = cvtpk(gb[0] * (ga[0] * o[0] + s[0]), gb[1] * (ga[1] * o[1] + s[1])); w.y = cvtpk(gb[2] * (ga[2] * o[2] + s[2]), gb[3] * (ga[3] * o[3] + s[3]));
        w.z = cvtpk(gb[4] * (ga[4] * o[4] + s[4]), gb[5] * (ga[5] * o[5] + s[5])); w.w = cvtpk(gb[6] * (ga[6] * o[6] + s[6]), gb[7] * (ga[7] * o[7] + s[7]));
        *(u32x4*)(MG + (size_t)row * DM + c8) = w;
    }
}

struct Args { const float* in[21]; float* out; unsigned char* ws; int ph_lo, ph_hi; };
static_assert(offsetof(Args, out) == 21 * 8 && offsetof(Args, ws) == 22 * 8, "Args layout");
__global__ void __launch_bounds__(512, 2) mk_fwd(Args args) {
    extern __shared__ __attribute__((aligned(16))) unsigned char lds_raw[];
    LAS unsigned char* const lds = (LAS unsigned char*)lds_raw; const int G = gridDim.x;
    volatile LAS unsigned* MISC = (volatile LAS unsigned*)(lds + MISC_OFF);
    const int s_wave = __builtin_amdgcn_readfirstlane((int)threadIdx.x >> 6);
    for (int u = tid_from_wave(s_wave); u < (LDS_BYTES - LDSCTL_OFF) / 4; u += 512) ((LAS unsigned*)(lds + LDSCTL_OFF))[u] = 0u;
    __syncthreads();
    const int lo = args.ph_lo, hi = args.ph_hi;
    XcdBarrier bar; bar.bar = (unsigned*)(args.ws + WS_CTL) + 4096; bar.x = 0; bar.st = nullptr;
    if (hi - lo > 1) bar = xcd_barrier_post((unsigned*)(args.ws + WS_CTL) + 4096, MISC + 8, tid_from_wave(s_wave) == 0);
    LAS unsigned char* ring = lds + RING_OFF; LAS unsigned char* red = lds + RED_OFF;
    for (int ph = lo; ph < hi; ++ph) {
        int z_ = 0; asm volatile("" : "+s"(z_));
        Ptrs P; P.xp = args.in[0 + z_]; P.xs = args.in[1 + z_]; P.ck = args.in[2 + z_]; P.cv = args.in[3 + z_]; P.sc = args.in[4 + z_]; P.nmix = args.in[5 + z_]; P.w_in = args.in[6 + z_]; P.sinks = args.in[7 + z_];
        P.lng = args.in[8 + z_]; P.lnb = args.in[9 + z_]; P.gws = args.in[10 + z_]; P.gbs = args.in[11 + z_]; P.wpa = args.in[12 + z_]; P.wpb = args.in[13 + z_]; P.wout = args.in[14 + z_]; P.nffn = args.in[15 + z_];
        P.wup = args.in[16 + z_]; P.cw = args.in[17 + z_]; P.cb = args.in[18 + z_]; P.wdn = args.in[19 + z_]; P.nfin = args.in[20 + z_]; P.out = (float*)args.in[21 + z_]; P.ws = (unsigned char*)args.in[22 + z_];
        bf16_t* XB = (bf16_t*)(P.ws + WS_XB); float* xsq = (float*)(P.ws + WS_XSQ);
#if defined(MK_REP_K)
      const int nrep_ = ((ph == 0 && MK_REP_K == 100) || (ph > 0 && ph < NPH - 1 && (ph - 1) % 6 == MK_REP_K)) ? MK_REP_N : 1;
      for (int rep_ = 0; rep_ < nrep_; ++rep_) {
        if (rep_ > 0) xcd_barrier(bar, tid_from_wave(s_wave) == 0);
#endif
#if defined(MK_REP_K)
        bf16_t* XBo = rep_ > 0 ? (bf16_t*)(P.ws + ((size_t)460 << 20)) : XB; float* xsqo = rep_ > 0 ? (float*)(P.ws + ((size_t)500 << 20)) : xsq;
#else
        bf16_t* XBo = XB; float* xsqo = xsq;
#endif
        if (ph == 0) p0_prologue(lds, P, s_wave);
        else if (ph == NPH - 1) p_final(lds, P, s_wave);
        else {
            const int l = (ph - 1) / 6, k = (ph - 1) % 6;
            if (k == 0) { const int NGm = G - NWORKERS;
                if ((int)blockIdx.x < NGm) { pg8::Gemm g{XB, (const bf16_t*)(P.ws + WS_WIN) + (size_t)l * NIN * DM, M, NIN, DM}; pg8::StaticOrder S; S.init(M, NIN, NGm, (int)blockIdx.x);
                    pg8::EpiAct E{(bf16_t*)(P.ws + WS_RA), NIN, xsq, (float*)(P.ws + WS_GVST), 1}; pg8::gemm_phase(ring, red, g, S, E, s_wave); }
#if defined(MK_REP_K) && defined(MK_WORK_ONCE)
                else if (rep_ == 0) p1_workers(lds, P, l, (int)blockIdx.x - NGm, NWORKERS, s_wave); }
#else
                else p1_workers(lds, P, l, (int)blockIdx.x - NGm, NWORKERS, s_wave); }
#endif
            else if (k == 1) p2_mixer(lds, P, l, s_wave);
            else if (k == 2) { pg8::Gemm g{(const bf16_t*)(P.ws + WS_RB), (const bf16_t*)(P.ws + WS_WM) + (size_t)l * DM * KM, MP, DM, KM}; pg8::StaticOrder S; S.init(MP, DM, G, (int)blockIdx.x);
                pg8::EpiMerge E{(const bf16_t*)(P.ws + WS_RA), (bf16_t*)(P.ws + WS_MG)};
                if (G == 256) { pg8::Unit u; S.next(0, u); pg8::gemm_phase_x(ring, red, g, u, E, s_wave); }
                else { pg8::gemm_phase(ring, red, g, S, E, s_wave);
                    small_merge(lds, (const bf16_t*)(P.ws + WS_RB), (const bf16_t*)(P.ws + WS_WM) + (size_t)l * DM * KM, (const bf16_t*)(P.ws + WS_RA), (bf16_t*)(P.ws + WS_MG), s_wave); } }
            else if (k == 3) { pg8::Gemm g{(const bf16_t*)(P.ws + WS_MG), (const bf16_t*)(P.ws + WS_WOUT) + (size_t)l * DM * DM, MP, DM, DM}; pg8::StaticOrder S; S.init(MP, DM, G, (int)blockIdx.x);
                pg8::EpiResid E{XBo, xsqo};
                if (G == 256) { pg8::Unit u; S.next(0, u); pg8::gemm_phase_x(ring, red, g, u, E, s_wave); }
                else { pg8::gemm_phase(ring, red, g, S, E, s_wave); small_resid(lds, (const bf16_t*)(P.ws + WS_MG), DM, (const bf16_t*)(P.ws + WS_WOUT) + (size_t)l * DM * DM, XBo, xsqo, s_wave); } }
            else if (k == 4) { pg8::Gemm g{XB, (const bf16_t*)(P.ws + WS_WUP) + (size_t)l * NUP * DM, M, NUP, DM}; pg8::StaticOrder S; S.init(M, NUP, G, (int)blockIdx.x);
                pg8::EpiUp E{P.ws, P.cw + (size_t)l * 3 * NUP, P.cb + (size_t)l * NUP, P.out + O_CVP + (size_t)l * NB * 2 * NUP};
                pg8::gemm_phase(ring, red, g, S, E, s_wave); }
            else { if (G == 256) { pg8::StaticOrder S0; S0.init(MP, DM, G, (int)blockIdx.x); pg8::Unit u0; S0.next(0, u0); p7_pre(lds, P, l, u0.pm, u0.pm + 1, s_wave); } else p7_pre(lds, P, l, 0, MP / 256, s_wave);
                VM_WAIT(); __syncthreads();
                pg8::Gemm g{(const bf16_t*)(P.ws + WS_RB), (const bf16_t*)(P.ws + WS_WDN) + (size_t)l * DM * DFF, MP, DM, DFF}; pg8::StaticOrder S; S.init(MP, DM, G, (int)blockIdx.x);
                pg8::EpiResid E{XBo, xsqo};
                if (G == 256) { pg8::Unit u; S.next(0, u); pg8::gemm_phase_x(ring, red, g, u, E, s_wave); }
                else { pg8::gemm_phase(ring, red, g, S, E, s_wave); small_resid(lds, (const bf16_t*)(P.ws + WS_RB), DFF, (const bf16_t*)(P.ws + WS_WDN) + (size_t)l * DM * DFF, XBo, xsqo, s_wave); } }
        }
#if defined(MK_REP_K)
      }
#endif
        if (ph + 1 < hi) xcd_barrier(bar, tid_from_wave(s_wave) == 0);
#if defined(MK_BAR_TWICE)
        for (int bb_ = 1; bb_ < MK_BAR_TWICE; ++bb_) if (ph + 1 < hi) xcd_barrier(bar, tid_from_wave(s_wave) == 0);
#endif
    }
}

extern "C" void kernel_launch(void* const* d_in, const int* in_sizes, int n_in, void* d_out, int out_size, void* d_ws, size_t ws_size, hipStream_t stream) {
    static int grid = 0;
    if (grid == 0) {
        if (n_in != 21 || out_size != (int)O_END || ws_size < WS_END) { fprintf(stderr, "kernel_launch: unexpected shapes: n_in %d out %d ws %zu (need %zu)\n", n_in, out_size, ws_size, (size_t)WS_END); grid = -1; return; }
        int dev = 0, cus = 0, per_cu = 0;
        if (hipGetDevice(&dev) != hipSuccess || hipDeviceGetAttribute(&cus, hipDeviceAttributeMultiprocessorCount, dev) != hipSuccess) { grid = -1; return; }
        if (hipFuncSetAttribute((const void*)mk_fwd, hipFuncAttributeMaxDynamicSharedMemorySize, LDS_BYTES) != hipSuccess) { fprintf(stderr, "kernel_launch: hipFuncSetAttribute failed\n"); grid = -1; return; }
        if (hipOccupancyMaxActiveBlocksPerMultiprocessor(&per_cu, (const void*)mk_fwd, 512, LDS_BYTES) != hipSuccess || per_cu < 1) { fprintf(stderr, "kernel_launch: occupancy query says %d blocks/CU\n", per_cu); per_cu = 1; }
        (void)hipGetLastError();
        grid = cus;
    }
    if (grid < 0) return;
    (void)hipMemsetAsync((char*)d_ws + WS_CTL, 0, CTL_ZERO_BYTES, stream);
    Args a{};
    for (int i = 0; i < 21; ++i) a.in[i] = (const float*)d_in[i];
    a.out = (float*)d_out; a.ws = (unsigned char*)d_ws;
#if MK_ONE_LAUNCH
    a.ph_lo = 0; a.ph_hi = NPH;
    void* kargs[] = {&a};
    hipError_t e = hipLaunchCooperativeKernel((const void*)mk_fwd, dim3(grid), dim3(512), kargs, LDS_BYTES, stream);
    if (e != hipSuccess) fprintf(stderr, "kernel_launch: cooperative launch failed: %s\n", hipGetErrorString(e));
#else
    for (int ph = 0; ph < NPH; ++ph) { a.ph_lo = ph; a.ph_hi = ph + 1; hipLaunchKernelGGL(mk_fwd, dim3(grid), dim3(512), LDS_BYTES, stream, a); }
#endif
}
```
